# Optimizing an MI355X kernel written in HIP

```python
import math
import jax
import jax.numpy as jnp
from jax import lax
import numpy as np

D_MODEL = 1024
BATCH = 8
SEQ = 4096
DEPTH = 2

PLE_DIM = 256
HEAD_DIM = 64
RMS_EPS = 1e-6
SSM_WIDTH = D_MODEL // 2
SSM_GROUP = 16
SSM_GROUPS = SSM_WIDTH // SSM_GROUP
SSM_STATE = 64
DT_MIN = 1e-3
DT_MAX = 1e-1
MOBA_WIDTH = D_MODEL - SSM_WIDTH
MOBA_HEADS = MOBA_WIDTH // HEAD_DIM
MOBA_BLOCK = 256
MOBA_TOPK = 3
MOBA_QCHUNK = 32
REL_BUCKETS = 32
REL_MAX_DIST = 128
SB_HEADS = D_MODEL // HEAD_DIM
SB_QBLOCK = 128
N_EXPERTS = 32
TOP_K = 4
D_FF = D_MODEL
SWIGLU_LIMIT = 7.0
SWIGLU_ALPHA = 1.702
MOE_BLOCK = 128
N_EVEN = (DEPTH + 1) // 2
N_ODD = DEPTH // 2

kernel_name = 'hybrid_s5_moba_stickbreak_moe'


def rmsnorm(x, g):
    xf = x.astype(jnp.float32)
    y = xf * lax.rsqrt(jnp.mean(xf * xf, axis=-1, keepdims=True) + RMS_EPS)
    return (y * g.astype(jnp.float32)).astype(x.dtype)


def split_heads(t, n_heads):
    b, l, _ = t.shape
    return t.reshape(b, l, n_heads, HEAD_DIM).transpose(0, 2, 1, 3)


def merge_heads(t):
    b, h, l, d = t.shape
    return t.transpose(0, 2, 1, 3).reshape(b, l, h * d)


def rel_bucket(dist):
    exact = REL_BUCKETS // 2
    n = jnp.maximum(dist, 0)
    nf = jnp.maximum(n, 1).astype(jnp.float32)
    log_ratio = jnp.log(nf / exact) / math.log(REL_MAX_DIST / exact)
    large = exact + (log_ratio * (REL_BUCKETS - exact)).astype(jnp.int32)
    large = jnp.minimum(large, REL_BUCKETS - 1)
    return jnp.where(n < exact, n, large)


def s5_mixer(u, a_re, a_im, b_re, b_im, c_re, c_im, d_skip, log_step, glu_w, glu_b):
    bsz, seq, _ = u.shape
    f32 = jnp.float32
    ug = u.astype(f32).reshape(bsz, seq, SSM_GROUPS, SSM_GROUP)
    lam = lax.complex(a_re.astype(f32), a_im.astype(f32))
    step = jnp.exp(log_step.astype(f32))[:, None]
    lam_bar = jnp.exp(lam * step)
    b_mat = lax.complex(b_re.astype(f32), b_im.astype(f32))
    b_bar = ((lam_bar - 1.0) / lam)[:, :, None] * b_mat
    bu = jnp.einsum('blgh,gnh->lbgn', ug.astype(jnp.complex64), b_bar)
    a_elems = jnp.broadcast_to(lam_bar[None, None], (seq, 1) + lam_bar.shape)

    def combine(left, right):
        a_l, b_l = left
        a_r, b_r = right
        return a_r * a_l, a_r * b_l + b_r

    _, states = lax.associative_scan(combine, (a_elems, bu), axis=0)
    c_mat = lax.complex(c_re.astype(f32), c_im.astype(f32))
    y = jnp.real(jnp.einsum('lbgn,ghn->blgh', states, c_mat)) + d_skip.astype(f32) * ug
    z = jax.nn.gelu(y.reshape(bsz, seq, SSM_WIDTH))
    out = z * jax.nn.sigmoid(z @ glu_w.astype(f32) + glu_b.astype(f32))
    return out.astype(u.dtype)


def moba_mixer(q, k, v, rel_bias):
    bsz, nh, seq, dh = q.shape
    f32 = jnp.float32
    n_blk = -(-seq // MOBA_BLOCK)
    pad = n_blk * MOBA_BLOCK - seq
    k_pad = jnp.pad(k, ((0, 0), (0, 0), (0, pad), (0, 0)))
    v_pad = jnp.pad(v, ((0, 0), (0, 0), (0, pad), (0, 0)))
    k_blocks = k_pad.reshape(bsz, nh, n_blk, MOBA_BLOCK, dh)
    v_blocks = v_pad.reshape(bsz, nh, n_blk, MOBA_BLOCK, dh)
    k_mean = jnp.mean(k_blocks.astype(f32), axis=3)
    gate = jnp.einsum('bhld,bhnd->bhln', q.astype(f32), k_mean)
    q_blk = jnp.arange(seq) // MOBA_BLOCK
    fully_past = jnp.arange(n_blk)[None, :] < q_blk[:, None]
    gate = jnp.where(fully_past, gate, -jnp.inf)
    n_sel = min(MOBA_TOPK, n_blk)
    _, sel = lax.top_k(gate, n_sel)
    sel_valid = jnp.arange(n_sel)[None, :] < q_blk[:, None]

    n_chunk = seq // MOBA_QCHUNK
    q_ch = q.reshape(bsz, nh, n_chunk, MOBA_QCHUNK, dh).transpose(2, 0, 1, 3, 4)
    sel_ch = sel.reshape(bsz, nh, n_chunk, MOBA_QCHUNK, n_sel).transpose(2, 0, 1, 3, 4)
    valid_ch = sel_valid.reshape(n_chunk, MOBA_QCHUNK, n_sel)
    bias_hb = rel_bias.astype(f32).T
    b_idx = jnp.arange(bsz)[:, None, None, None]
    h_idx = jnp.arange(nh)[None, :, None, None]
    h_idx5 = jnp.arange(nh)[None, :, None, None, None]
    offs = jnp.arange(MOBA_BLOCK)
    scale = dh ** -0.5

    def chunk(args):
        c, q_c, sel_c, valid_c = args
        t = c * MOBA_QCHUNK + jnp.arange(MOBA_QCHUNK)
        k_sel = k_blocks[b_idx, h_idx, sel_c]
        v_sel = v_blocks[b_idx, h_idx, sel_c]
        s_sel = jnp.einsum('bhqd,bhqnkd->bhqnk', q_c, k_sel).astype(f32) * scale
        dist_sel = t[:, None, None] - (sel_c[..., None] * MOBA_BLOCK + offs)
        s_sel = s_sel + bias_hb[h_idx5, rel_bucket(dist_sel)]
        s_sel = jnp.where(valid_c[None, None, :, :, None], s_sel, -jnp.inf)
        own = (c * MOBA_QCHUNK) // MOBA_BLOCK
        k_own = lax.dynamic_slice_in_dim(k_pad, own * MOBA_BLOCK, MOBA_BLOCK, axis=2)
        v_own = lax.dynamic_slice_in_dim(v_pad, own * MOBA_BLOCK, MOBA_BLOCK, axis=2)
        s_own = jnp.einsum('bhqd,bhkd->bhqk', q_c, k_own).astype(f32) * scale
        dist_own = t[:, None] - (own * MOBA_BLOCK + offs)[None, :]
        s_own = s_own + bias_hb[:, rel_bucket(dist_own)]
        s_own = jnp.where(dist_own >= 0, s_own, -jnp.inf)
        logits = jnp.concatenate(
            [s_sel.reshape(bsz, nh, MOBA_QCHUNK, n_sel * MOBA_BLOCK), s_own], axis=-1)
        w = jax.nn.softmax(logits, axis=-1).astype(v.dtype)
        w_sel = w[..., :n_sel * MOBA_BLOCK].reshape(bsz, nh, MOBA_QCHUNK, n_sel, MOBA_BLOCK)
        w_own = w[..., n_sel * MOBA_BLOCK:]
        return (jnp.einsum('bhqnk,bhqnkd->bhqd', w_sel, v_sel)
                + jnp.einsum('bhqk,bhkd->bhqd', w_own, v_own))

    out = lax.map(chunk, (jnp.arange(n_chunk), q_ch, sel_ch, valid_ch))
    return out.transpose(1, 2, 0, 3, 4).reshape(bsz, nh, seq, dh)


def stick_breaking_mixer(q, k, v):
    bsz, nh, seq, dh = q.shape
    f32 = jnp.float32
    n_qb = seq // SB_QBLOCK
    q_bl = q.reshape(bsz, nh, n_qb, SB_QBLOCK, dh).transpose(2, 0, 1, 3, 4)
    k_pos = jnp.arange(seq)
    scale = dh ** -0.5

    def block(args):
        c, q_c = args
        t = c * SB_QBLOCK + jnp.arange(SB_QBLOCK)
        z = jnp.einsum('bhqd,bhkd->bhqk', q_c, k).astype(f32) * scale
        past = k_pos[None, :] < t[:, None]
        log_keep = jnp.where(past, jax.nn.log_sigmoid(-z), 0.0)
        later = lax.cumsum(log_keep, axis=3, reverse=True) - log_keep
        w = jnp.where(past, jnp.exp(jax.nn.log_sigmoid(z) + later), 0.0)
        return jnp.einsum('bhqk,bhkd->bhqd', w.astype(v.dtype), v)

    out = lax.map(block, (jnp.arange(n_qb), q_bl))
    return out.transpose(1, 2, 0, 3, 4).reshape(bsz, nh, seq, dh)


def moe_ffn(h, router_w, router_b, w_gate, b_gate, w_up, b_up, w_down, b_down):
    bsz, seq, d = h.shape
    n_tok = bsz * seq
    xt = h.reshape(n_tok, d)
    logits = (xt @ router_w + router_b).astype(jnp.float32)
    top_val, top_idx = lax.top_k(logits, TOP_K)
    gates = jax.nn.softmax(top_val, axis=-1)
    n_assign = n_tok * TOP_K
    flat_e = top_idx.reshape(-1)
    order = jnp.argsort(flat_e)
    sorted_e = flat_e[order]
    sorted_tok = order // TOP_K
    sorted_gate = gates.reshape(-1)[order]
    counts = jnp.bincount(flat_e, length=N_EXPERTS)
    padded = (counts + MOE_BLOCK - 1) // MOE_BLOCK * MOE_BLOCK
    pad_end = jnp.cumsum(padded)
    pad_start = pad_end - padded
    start = jnp.cumsum(counts) - counts
    dest = pad_start[sorted_e] + jnp.arange(n_assign) - start[sorted_e]
    n_blocks = -(-n_assign // MOE_BLOCK) + N_EXPERTS
    n_slots = n_blocks * MOE_BLOCK
    slot_tok = jnp.full((n_slots,), n_tok, jnp.int32).at[dest].set(sorted_tok)
    block_e = jnp.minimum(
        jnp.searchsorted(pad_end, jnp.arange(n_blocks) * MOE_BLOCK, side='right'), N_EXPERTS - 1)
    x_pad = jnp.concatenate([xt, jnp.zeros((1, d), xt.dtype)], axis=0)
    xs = x_pad[slot_tok].reshape(n_blocks, MOE_BLOCK, d)

    def expert_block(args):
        xb, e = args
        g = jnp.minimum(xb @ w_gate[e] + b_gate[e], SWIGLU_LIMIT)
        u = jnp.clip(xb @ w_up[e] + b_up[e], -SWIGLU_LIMIT, SWIGLU_LIMIT)
        act = g * jax.nn.sigmoid(SWIGLU_ALPHA * g) * (u + 1.0)
        return act @ w_down[e] + b_down[e]

    ys = lax.map(expert_block, (xs, block_e)).reshape(n_slots, d)
    out = jnp.zeros((n_tok, d), jnp.float32).at[sorted_tok].add(
        ys[dest].astype(jnp.float32) * sorted_gate[:, None])
    return out.astype(h.dtype).reshape(bsz, seq, d)


def per_layer_embed(p_i, r, g_norm, w_ple, w_ple_gate):
    proj = p_i @ w_ple
    gate = jax.nn.sigmoid(rmsnorm(r, g_norm) @ w_ple_gate)
    return proj * gate


def mixer_ab(h, w_in, a_re, a_im, b_re, b_im, c_re, c_im, d_skip, log_step,
             glu_w, glu_b, w_out, rel_bias):
    proj = h @ w_in
    u = proj[..., :SSM_WIDTH]
    o = SSM_WIDTH
    q = split_heads(proj[..., o:o + MOBA_WIDTH], MOBA_HEADS)
    k = split_heads(proj[..., o + MOBA_WIDTH:o + 2 * MOBA_WIDTH], MOBA_HEADS)
    v = split_heads(proj[..., o + 2 * MOBA_WIDTH:o + 3 * MOBA_WIDTH], MOBA_HEADS)
    y_a = s5_mixer(u, a_re, a_im, b_re, b_im, c_re, c_im, d_skip, log_step, glu_w, glu_b)
    y_b = merge_heads(moba_mixer(q, k, v, rel_bias))
    return jnp.concatenate([y_a, y_b], axis=-1) @ w_out


def mixer_c(h, w_in, w_out):
    proj = h @ w_in
    q = split_heads(proj[..., :D_MODEL], SB_HEADS)
    k = split_heads(proj[..., D_MODEL:2 * D_MODEL], SB_HEADS)
    v = split_heads(proj[..., 2 * D_MODEL:], SB_HEADS)
    return merge_heads(stick_breaking_mixer(q, k, v)) @ w_out


def setup_inputs(seed: int = 0) -> dict:
    key = jax.random.key(seed)
    ks = iter(jax.random.split(key, 48))
    f32 = jnp.float32

    def nrm(shape, scale):
        return jax.random.normal(next(ks), shape, f32) * scale

    ssm_shape = (N_EVEN, SSM_GROUPS, SSM_STATE)
    n_idx = jnp.arange(SSM_STATE, dtype=f32)
    return {
        'x': nrm((BATCH, SEQ, D_MODEL), 1.0),
        'p': nrm((DEPTH, BATCH, SEQ, PLE_DIM), 1.0),
        'norm_mix': 1.0 + nrm((DEPTH, D_MODEL), 0.02),
        'norm_ffn': 1.0 + nrm((DEPTH, D_MODEL), 0.02),
        'norm_ple': 1.0 + nrm((DEPTH, D_MODEL), 0.02),
        'norm_final': 1.0 + nrm((D_MODEL,), 0.02),
        'w_in_ab': nrm((N_EVEN, D_MODEL, SSM_WIDTH + 3 * MOBA_WIDTH), D_MODEL ** -0.5),
        'ssm_a_re': -0.5 * jnp.exp(nrm(ssm_shape, 0.05)),
        'ssm_a_im': math.pi * n_idx + nrm(ssm_shape, 0.01),
        'ssm_b_re': nrm((N_EVEN, SSM_GROUPS, SSM_STATE, SSM_GROUP), (2 * SSM_GROUP) ** -0.5),
        'ssm_b_im': nrm((N_EVEN, SSM_GROUPS, SSM_STATE, SSM_GROUP), (2 * SSM_GROUP) ** -0.5),
        'ssm_c_re': nrm((N_EVEN, SSM_GROUPS, SSM_GROUP, SSM_STATE), SSM_STATE ** -0.5),
        'ssm_c_im': nrm((N_EVEN, SSM_GROUPS, SSM_GROUP, SSM_STATE), SSM_STATE ** -0.5),
        'ssm_d': nrm((N_EVEN, SSM_GROUPS, SSM_GROUP), 1.0),
        'ssm_log_step': jax.random.uniform(next(ks), (N_EVEN, SSM_GROUPS), f32,
                                           math.log(DT_MIN), math.log(DT_MAX)),
        'glu_w': nrm((N_EVEN, SSM_WIDTH, SSM_WIDTH), SSM_WIDTH ** -0.5),
        'glu_b': nrm((N_EVEN, SSM_WIDTH), 0.01),
        'w_out_ab': nrm((N_EVEN, SSM_WIDTH + MOBA_WIDTH, D_MODEL), D_MODEL ** -0.5),
        'rel_bias': nrm((REL_BUCKETS, MOBA_HEADS), 0.1),
        'w_in_c': nrm((N_ODD, D_MODEL, 3 * D_MODEL), D_MODEL ** -0.5),
        'w_out_c': nrm((N_ODD, D_MODEL, D_MODEL), D_MODEL ** -0.5),
        'router_w': nrm((DEPTH, D_MODEL, N_EXPERTS), D_MODEL ** -0.5),
        'router_b': nrm((DEPTH, N_EXPERTS), 0.01),
        'w_gate': nrm((DEPTH, N_EXPERTS, D_MODEL, D_FF), D_MODEL ** -0.5),
        'b_gate': nrm((DEPTH, N_EXPERTS, D_FF), 0.01),
        'w_up': nrm((DEPTH, N_EXPERTS, D_MODEL, D_FF), D_MODEL ** -0.5),
        'b_up': nrm((DEPTH, N_EXPERTS, D_FF), 0.01),
        'w_down': nrm((DEPTH, N_EXPERTS, D_FF, D_MODEL), D_FF ** -0.5),
        'b_down': nrm((DEPTH, N_EXPERTS, D_MODEL), 0.01),
        'w_ple': nrm((DEPTH, PLE_DIM, D_MODEL), PLE_DIM ** -0.5),
        'w_ple_gate': nrm((DEPTH, D_MODEL, D_MODEL), D_MODEL ** -0.5),
    }


def reference(x, p, norm_mix, norm_ffn, norm_ple, norm_final, w_in_ab, ssm_a_re, ssm_a_im,
              ssm_b_re, ssm_b_im, ssm_c_re, ssm_c_im, ssm_d, ssm_log_step, glu_w, glu_b,
              w_out_ab, rel_bias, w_in_c, w_out_c, router_w, router_b, w_gate, b_gate,
              w_up, b_up, w_down, b_down, w_ple, w_ple_gate):
    r = x
    for i in range(DEPTH):
        j = i // 2
        h = rmsnorm(r, norm_mix[i])
        if i % 2 == 0:
            r = r + mixer_ab(h, w_in_ab[j], ssm_a_re[j], ssm_a_im[j], ssm_b_re[j], ssm_b_im[j],
                             ssm_c_re[j], ssm_c_im[j], ssm_d[j], ssm_log_step[j],
                             glu_w[j], glu_b[j], w_out_ab[j], rel_bias)
        else:
            r = r + mixer_c(h, w_in_c[j], w_out_c[j])
        h = rmsnorm(r, norm_ffn[i])
        r = r + moe_ffn(h, router_w[i], router_b[i], w_gate[i], b_gate[i],
                        w_up[i], b_up[i], w_down[i], b_down[i])
        r = r + per_layer_embed(p[i], r, norm_ple[i], w_ple[i], w_ple_gate[i])
    return rmsnorm(r, norm_final)
```

```cpp
#include <hip/hip_runtime.h>
#include <cstdio>
#include <cstdint>
#include <cmath>

#define LAS __attribute__((address_space(3)))
typedef unsigned short bf16_t;
typedef short bf16x8 __attribute__((ext_vector_type(8)));
typedef short bf16x4 __attribute__((ext_vector_type(4)));
typedef float f32x4 __attribute__((ext_vector_type(4)));
typedef float f32x2 __attribute__((ext_vector_type(2)));
typedef float f32x16 __attribute__((ext_vector_type(16)));
typedef unsigned u32x4 __attribute__((ext_vector_type(4)));
typedef unsigned u32x2 __attribute__((ext_vector_type(2)));

constexpr int NTOK = 32768, DM = 1024, SEQ = 4096, NBATCH = 8, PLE = 256;
constexpr int SSMW = 512, NGRP = 32, GH = 16, NST = 64, TCH = 32, NCH = SEQ / TCH  , A2LD = 640;
constexpr int MOBW = 512, MH = 8, MBLK = 256, NMB = 16;
constexpr int NEXP = 32;
constexpr float RMS_EPS = 1e-6f;
constexpr float LOG2E = 1.4426950408889634f;
constexpr float QSCALE = 0.125f * LOG2E;
constexpr float SB_THR = 150.0f;

constexpr size_t MiB = (size_t)1 << 20;
constexpr size_t WS_CTL = 0;
constexpr size_t WS_WINAB = 1 * MiB;
constexpr size_t WS_GLU = WS_WINAB + 4 * MiB;
constexpr size_t WS_WOUTAB = WS_GLU + MiB / 2;
constexpr size_t WS_WINC = WS_WOUTAB + 2 * MiB;
constexpr size_t WS_WOUTC = WS_WINC + 6 * MiB;
constexpr size_t WS_WPLE = WS_WOUTC + 2 * MiB;
constexpr size_t WS_WPLEG = WS_WPLE + 1 * MiB;
constexpr size_t WS_WBT = WS_WPLEG + 4 * MiB;
constexpr size_t WS_MY = WS_WBT + 8 * MiB;
constexpr size_t WS_MOEW = WS_MY + 20 * MiB;
constexpr size_t WS_H = WS_MOEW + 192 * MiB;
constexpr size_t WS_PB = WS_H + 64 * MiB;
constexpr size_t WS_MLIST = WS_PB + 32 * MiB;
constexpr size_t WS_TOKEP = WS_MLIST + 4 * MiB;
constexpr size_t WS_TOKG = WS_TOKEP + MiB / 2;
constexpr size_t WS_RA = WS_TOKG + MiB / 2;
constexpr size_t WS_RB = WS_RA + 272 * MiB;
constexpr size_t WS_END = WS_RB + 272 * MiB;
constexpr size_t RA_A2 = WS_RA;
constexpr size_t RA_Q0 = RA_A2 + 40 * MiB;
constexpr size_t RA_K0 = RA_Q0 + 32 * MiB;
constexpr size_t RA_VT0 = RA_K0 + 32 * MiB;
constexpr size_t RA_Z = RA_VT0 + 32 * MiB;
constexpr size_t RA_SS = RA_Z + 32 * MiB;
constexpr size_t RA_Q1 = WS_RA;
constexpr size_t RA_K1 = RA_Q1 + 64 * MiB;
constexpr size_t RA_VT1 = RA_K1 + 64 * MiB;
constexpr size_t RA_ACT = WS_RA;
constexpr size_t RA_PROJ = WS_RA;
constexpr size_t RB_PARTO = WS_RB;
constexpr size_t RB_PARTML = RB_PARTO + 128 * MiB;
constexpr size_t RB_MOBALIST = RB_PARTML + 8 * MiB;
constexpr size_t RB_KMEAN = RB_MOBALIST + 16 * MiB;
constexpr size_t RB_YCAT = RB_KMEAN + 1 * MiB;
constexpr size_t RB_Y1 = WS_RB;
constexpr size_t RB_YS = WS_RB;
constexpr int CW_BAR = 0;
constexpr int CW_GCNT = 4096;
constexpr int CW_MOBACNT = 8192;

constexpr int LDS_BYTES = 155648;
constexpr int LDS_AUX = 131072;
constexpr int LDS_MISC = 155648 - 64;

typedef __bf16 bf16x2_t __attribute__((ext_vector_type(2)));
__device__ __forceinline__ unsigned cvt_pk_bf16(float lo, float hi) { const f32x2 v = {lo, hi}; return __builtin_bit_cast(unsigned, __builtin_convertvector(v, bf16x2_t)); }
__device__ __forceinline__ bf16_t f2bf(float x) { return (bf16_t)(cvt_pk_bf16(x, 0.f) & 0xffffu); }
__device__ __forceinline__ float bf_lo(unsigned w) { return __uint_as_float(w << 16); }
__device__ __forceinline__ float bf_hi(unsigned w) { return __uint_as_float(w & 0xffff0000u); }
__device__ __forceinline__ float ex2(float x) { return __builtin_amdgcn_exp2f(x); }
__device__ __forceinline__ float lg2(float x) { return __builtin_amdgcn_logf(x); }
__device__ __forceinline__ float rcp(float x) { return __builtin_amdgcn_rcpf(x); }
__device__ __forceinline__ float sigmoidf_(float x) { return rcp(1.0f + ex2(-LOG2E * x)); }
__device__ __forceinline__ float wave_sum(float v) { v += __shfl_xor(v, 32); v += __shfl_xor(v, 16); v += __shfl_xor(v, 8); v += __shfl_xor(v, 4); v += __shfl_xor(v, 2); v += __shfl_xor(v, 1); return v; }
__device__ __forceinline__ f32x16 mfma32(bf16x8 a, bf16x8 b, f32x16 c) { return __builtin_amdgcn_mfma_f32_32x32x16_bf16(a, b, c, 0, 0, 0); }

#define XB_TMO      128
#define XB_XCNT(j)  (256  + 64 * (j))
#define XB_XSUB(j)  (1280 + 64 * (j))
#define XB_XGEN(j)  (2304 + 64 * (j))
#define XB_TOP      3328
#define XB_TOPGEN   3392
#define XCD_BAR_WORDS 3456
#define XB_SPIN_CAP (1u << 18)
__device__ __forceinline__ unsigned xb_ld(unsigned* p)              { return __hip_atomic_load(p, __ATOMIC_RELAXED, __HIP_MEMORY_SCOPE_AGENT); }
__device__ __forceinline__ unsigned xb_add(unsigned* p, unsigned v) { return __hip_atomic_fetch_add(p, v, __ATOMIC_RELAXED, __HIP_MEMORY_SCOPE_AGENT); }
__device__ __forceinline__ unsigned xb_xcc_id() { return (unsigned)__builtin_amdgcn_s_getreg((3 << 11) | 20) & 0xFu; }
#define XB_SPIN(cond, bar) do { unsigned _sp = 0; while (cond) { __builtin_amdgcn_s_sleep(1); \
    if ((++_sp & 255u) == 0u) { if (xb_ld(&(bar)[XB_TMO])) break; if (_sp > XB_SPIN_CAP) { atomicAdd(&(bar)[XB_TMO], 1u); break; } } } } while (0)
struct XcdBarrier { unsigned* bar; unsigned x; volatile LAS unsigned* st; };
__device__ __forceinline__ XcdBarrier xcd_barrier_post(unsigned* bar, volatile LAS unsigned* st) {
    XcdBarrier b; b.bar = bar; b.x = xb_xcc_id(); b.st = st;
    if (threadIdx.x == 0) (void)xb_add(&bar[XB_XCNT(b.x)], 1u);
    return b;
}
__device__ __forceinline__ void xcd_barrier_complete(unsigned* bar, unsigned x, unsigned& nloc, unsigned& nx) {
    const unsigned G = gridDim.x * gridDim.y * gridDim.z;
    unsigned sum, cnt, mine, sp = 0u;
    for (;;) {
        sum = 0u; cnt = 0u; mine = 0u;
#pragma unroll
        for (unsigned j = 0; j < 16; ++j) { const unsigned c = xb_ld(&bar[XB_XCNT(j)]); sum += c; cnt += (c > 0u) ? 1u : 0u; mine = (j == x) ? c : mine; }
        if (sum == G) break;
        __builtin_amdgcn_s_sleep(1);
        if ((++sp & 255u) == 0u) { if (xb_ld(&bar[XB_TMO])) break; if (sp > XB_SPIN_CAP) { atomicAdd(&bar[XB_TMO], 1u); break; } }
    }
    nloc = mine > 0u ? mine : 1u; nx = cnt > 0u ? cnt : 1u;
}
__device__ __forceinline__ void xcd_barrier(const XcdBarrier& b) {
    asm volatile("s_waitcnt vmcnt(0)" ::: "memory");
    __syncthreads();
    if (threadIdx.x == 0) {
        unsigned* bar = b.bar;
        __builtin_amdgcn_s_waitcnt(0);
        unsigned nloc = b.st[0], nx = b.st[1];
        if (nloc == 0u) { xcd_barrier_complete(bar, b.x, nloc, nx); b.st[0] = nloc; b.st[1] = nx; }
        const unsigned old = xb_add(&bar[XB_XSUB(b.x)], 1u);
        const unsigned gen = old / nloc;
        if (old + 1u == (gen + 1u) * nloc) {
            __builtin_amdgcn_fence(__ATOMIC_RELEASE, "agent");
            asm volatile("s_waitcnt vmcnt(0)" ::: "memory");
            const unsigned og = xb_add(&bar[XB_TOP], 1u);
            const unsigned tg = og / nx;
            if (og + 1u == (tg + 1u) * nx) xb_add(&bar[XB_TOPGEN], 1u);
            else XB_SPIN(xb_ld(&bar[XB_TOPGEN]) == tg, bar);
            __builtin_amdgcn_fence(__ATOMIC_ACQUIRE, "agent");
            xb_add(&bar[XB_XGEN(b.x)], 1u);
            asm volatile("s_waitcnt vmcnt(0)" ::: "memory");
        } else {
            XB_SPIN(xb_ld(&bar[XB_XGEN(b.x)]) == gen, bar);
            __builtin_amdgcn_fence(__ATOMIC_ACQUIRE, "agent");
            asm volatile("s_waitcnt vmcnt(0)" ::: "memory");
        }
    }
    __syncthreads();
}

namespace g8 {
constexpr int BM = 256, BK = 64, HALF = 128, HTB = HALF * BK * 2, STAGE_BYTES = 8 * HTB, NXCD = 8, WGM = 8;
__host__ __device__ __forceinline__ int lds_byte(int r, int c) { const int st = (r >> 4) * 2 + (c >> 5), rr = r & 15, cc = c & 31, ob = rr * 64 + cc * 2; return st * 1024 + (ob ^ (((ob >> 9) & 1) << 5)); }
__host__ __device__ __forceinline__ void stage_rc(int b, int& R, int& C) { const int st = b / 1024, sb = b % 1024, swz = sb ^ (((sb >> 9) & 1) << 5); R = (st >> 1) * 16 + swz / 64; C = (st & 1) * 32 + (swz % 64) / 2; }
__host__ __device__ __forceinline__ int perm32(int rho) { const int n = rho >> 4, i = rho & 15; return 8 * (i >> 2) + 4 * n + (i & 3); }

struct GU { const char *a0, *a1, *b0, *b1; int p0, p1, p2, p3; };

__device__ __forceinline__ bool static_tile(int i, int G, int c, int nM, int nN, int& pm, int& pn) {
    const int nwg = nM * nN; const long L = (long)i * G + c; if (L >= nwg) return false;
    int wgid = (int)L; { const int q = nwg / NXCD, r = nwg % NXCD, xcd = wgid % NXCD, off = wgid / NXCD; wgid = (xcd < r ? xcd * (q + 1) : r * (q + 1) + (xcd - r) * q) + off; }
    const int nig = WGM * nN, gid = wgid / nig, fm = gid * WGM, gsz = (nM - fm) < WGM ? (nM - fm) : WGM;
    pm = fm + ((wgid % nig) % gsz); pn = (wgid % nig) / gsz; return true;
}
struct DenseSched {
    const char* A; const char* B; unsigned lda2, ldb2; int nM, nN, G, c;
    static constexpr bool GATHER = false;
    __device__ __forceinline__ bool next(int i, GU& u) const {
        int pm, pn; if (!static_tile(i, G, c, nM, nN, pm, pn)) return false;
        u.a0 = A + (size_t)pm * 256 * lda2; u.a1 = u.a0 + (size_t)128 * lda2; u.b0 = B + (size_t)pn * 256 * ldb2; u.b1 = u.b0 + (size_t)128 * ldb2;
        u.p0 = pm; u.p1 = pn; u.p2 = 0; u.p3 = 0; return true;
    }
    __device__ __forceinline__ const LAS int* rows(int) const { return nullptr; }
};
struct BatchSched {
    const char* A; const char* B; unsigned lda2, ldb2; size_t sA, sB; int nM, nN, nb, G, c;
    static constexpr bool GATHER = false;
    __device__ __forceinline__ bool next(int i, GU& u) const {
        const long L = (long)i * G + c; const int per = nM * nN; if (L >= (long)per * nb) return false;
        const int g = (int)(L / per), rem = (int)(L % per), pm = rem / nN, pn = rem % nN;
        u.a0 = A + (size_t)g * sA + (size_t)pm * 256 * lda2; u.a1 = u.a0 + (size_t)128 * lda2; u.b0 = B + (size_t)g * sB + (size_t)pn * 256 * ldb2; u.b1 = u.b0 + (size_t)128 * ldb2;
        u.p0 = pm; u.p1 = pn; u.p2 = g; u.p3 = 0; return true;
    }
    __device__ __forceinline__ const LAS int* rows(int) const { return nullptr; }
};

#define G8_WAIT_V(n) asm volatile("s_waitcnt vmcnt(" #n ")" ::: "memory")
#define G8_WAIT_L(n) asm volatile("s_waitcnt lgkmcnt(" #n ")" ::: "memory")
#define G8_BAR __builtin_amdgcn_s_barrier()
#define G8_SCHED __builtin_amdgcn_sched_barrier(0)

template <class Epi, class Sched>
__device__ __forceinline__ void gemm_run(LAS unsigned char* lds, const int K, const unsigned lda2, const unsigned ldb2, const Sched& S, const Epi& E) {
    constexpr bool GATHER = Sched::GATHER;
    const int tid = threadIdx.x, wid = __builtin_amdgcn_readfirstlane(tid >> 6), lane = tid & 63, wr = wid >> 2, wc = wid & 3, fr = lane & 15, fq = lane >> 4;
    const int nt = K / BK;
    int sR[2], sC[2];
    unsigned voffB[2], vc[2][2], vn[2][2];
#pragma unroll
    for (int i = 0; i < 2; ++i) { stage_rc(tid * 16 + i * 8192, sR[i], sC[i]); const int Rb = Epi::PERM ? ((sR[i] & ~31) + perm32(sR[i] & 31)) : sR[i];
        voffB[i] = (unsigned)Rb * ldb2 + (unsigned)sC[i] * 2u; vc[0][i] = vc[1][i] = vn[0][i] = vn[1][i] = (unsigned)sR[i] * lda2 + (unsigned)sC[i] * 2u; }
    const size_t kstep = (size_t)(BK * 2);
    const unsigned ldsw = (unsigned)wid * 1024u;
    const int aoff = lds_byte(wr * 64 + fr, fq * 8), boff = lds_byte(wc * 32 + fr, fq * 8);
#define G8_SA(b, h) (((b) * 2 + (h)) * HTB)
#define G8_SB(b, h) ((4 + (b) * 2 + (h)) * HTB)
#define G8_STAGE(bufoff, gbase, v0, v1) do { \
        __builtin_amdgcn_global_load_lds((const unsigned*)((const char*)(gbase) + (v0)), (LAS unsigned*)(lds + (bufoff) + ldsw), 16, 0, 0); \
        __builtin_amdgcn_global_load_lds((const unsigned*)((const char*)(gbase) + (v1)), (LAS unsigned*)(lds + (bufoff) + ldsw + 8192), 16, 0, 0); } while (0)
#define G8_LDA(dst, b, h) do { _Pragma("unroll") for (int m = 0; m < 4; ++m) _Pragma("unroll") for (int k = 0; k < 2; ++k) dst[m][k] = *(const LAS bf16x8*)(lds + G8_SA(b, h) + aoff + m * 2048 + k * 1024); } while (0)
#define G8_LDB(dst, b, h) do { _Pragma("unroll") for (int n = 0; n < 2; ++n) _Pragma("unroll") for (int k = 0; k < 2; ++k) dst[n][k] = *(const LAS bf16x8*)(lds + G8_SB(b, h) + boff + n * 2048 + k * 1024); } while (0)
#define G8_MMA(ai, bj, At, Bt) do { __builtin_amdgcn_s_setprio(1); _Pragma("unroll") for (int m = 0; m < 4; ++m) _Pragma("unroll") for (int n = 0; n < 2; ++n) _Pragma("unroll") for (int k = 0; k < 2; ++k) \
        acc[ai][bj][m][n] = __builtin_amdgcn_mfma_f32_16x16x32_bf16(Bt[n][k], At[m][k], acc[ai][bj][m][n], 0, 0, 0); __builtin_amdgcn_s_setprio(0); } while (0)
    GU cur, nxt; int ui = 0;
    if (!S.next(0, cur)) return;
    if constexpr (GATHER) { const LAS int* rw = S.rows(0);
#pragma unroll
        for (int h = 0; h < 2; ++h)
#pragma unroll
            for (int i = 0; i < 2; ++i) vc[h][i] = (unsigned)rw[h * 128 + sR[i]] * lda2 + (unsigned)sC[i] * 2u; }
    f32x4 acc[2][2][4][2];
#pragma unroll
    for (int a = 0; a < 2; ++a)
#pragma unroll
        for (int b = 0; b < 2; ++b)
#pragma unroll
            for (int m = 0; m < 4; ++m)
#pragma unroll
                for (int n = 0; n < 2; ++n) acc[a][b][m][n] = (f32x4){0.f, 0.f, 0.f, 0.f};
    bf16x8 At[4][2], B0[2][2], B1[2][2];
    const char* cA0 = cur.a0; const char* cA1 = cur.a1; const char* cB0 = cur.b0; const char* cB1 = cur.b1;
    G8_STAGE(G8_SB(0, 0), cB0, voffB[0], voffB[1]); G8_STAGE(G8_SA(0, 0), cA0, vc[0][0], vc[0][1]); G8_STAGE(G8_SB(0, 1), cB1, voffB[0], voffB[1]); G8_STAGE(G8_SA(0, 1), cA1, vc[1][0], vc[1][1]);
    if (wr == 1) G8_BAR;
    G8_WAIT_V(4); G8_BAR;
    G8_STAGE(G8_SB(1, 0), cB0 + kstep, voffB[0], voffB[1]); G8_STAGE(G8_SA(1, 0), cA0 + kstep, vc[0][0], vc[0][1]); G8_STAGE(G8_SB(1, 1), cB1 + kstep, voffB[0], voffB[1]);
    G8_WAIT_V(6); G8_BAR;
    for (;;) {
        const bool has_next = S.next(ui + 1, nxt);
        const char* nA0 = has_next ? nxt.a0 : cA0; const char* nA1 = has_next ? nxt.a1 : cA1; const char* nB0 = has_next ? nxt.b0 : cB0; const char* nB1 = has_next ? nxt.b1 : cB1;
        if constexpr (GATHER) {
            if (has_next) { const LAS int* rw = S.rows(ui + 1);
#pragma unroll
                for (int h = 0; h < 2; ++h)
#pragma unroll
                    for (int i = 0; i < 2; ++i) vn[h][i] = (unsigned)rw[h * 128 + sR[i]] * lda2 + (unsigned)sC[i] * 2u; }
            else {
#pragma unroll
                for (int h = 0; h < 2; ++h)
#pragma unroll
                    for (int i = 0; i < 2; ++i) vn[h][i] = vc[h][i]; }
        }
        for (int t = 0; t < nt; t += 2) {
            const bool last = (t == nt - 2);
            const char* a1_1 = cA1 + (size_t)(t + 1) * kstep;
            const char* a2_0 = last ? nA0 : cA0 + (size_t)(t + 2) * kstep; const char* a2_1 = last ? nA1 : cA1 + (size_t)(t + 2) * kstep;
            const char* b2_0 = last ? nB0 : cB0 + (size_t)(t + 2) * kstep; const char* b2_1 = last ? nB1 : cB1 + (size_t)(t + 2) * kstep;
            unsigned w00 = vc[0][0], w01 = vc[0][1], w10 = vc[1][0], w11 = vc[1][1];
            if constexpr (GATHER) { if (last) { w00 = vn[0][0]; w01 = vn[0][1]; w10 = vn[1][0]; w11 = vn[1][1]; } }
            G8_LDB(B0, 0, 0); G8_SCHED; G8_LDA(At, 0, 0); G8_STAGE(G8_SA(1, 1), a1_1, vc[1][0], vc[1][1]);
            G8_WAIT_L(8); G8_BAR; G8_WAIT_L(0); G8_MMA(0, 0, At, B0); G8_BAR; G8_SCHED;
            G8_LDB(B1, 0, 1); G8_STAGE(G8_SB(0, 0), b2_0, voffB[0], voffB[1]);
            G8_BAR; G8_WAIT_L(0); G8_MMA(0, 1, At, B1); G8_BAR;
            G8_LDA(At, 0, 1); G8_STAGE(G8_SA(0, 0), a2_0, w00, w01);
            G8_BAR; G8_WAIT_L(0); G8_MMA(1, 0, At, B0); G8_BAR; G8_SCHED;
            G8_STAGE(G8_SB(0, 1), b2_1, voffB[0], voffB[1]);
            G8_WAIT_V(6); G8_BAR; G8_MMA(1, 1, At, B1); G8_BAR;
            G8_LDB(B0, 1, 0); G8_SCHED; G8_LDA(At, 1, 0); G8_STAGE(G8_SA(0, 1), a2_1, w10, w11);
            G8_WAIT_L(8); G8_BAR; G8_WAIT_L(0); G8_MMA(0, 0, At, B0); G8_BAR; G8_SCHED;
            G8_LDB(B1, 1, 1); G8_STAGE(G8_SB(1, 0), b2_0 + kstep, voffB[0], voffB[1]);
            G8_BAR; G8_WAIT_L(0); G8_MMA(0, 1, At, B1); G8_BAR;
            G8_LDA(At, 1, 1); G8_STAGE(G8_SA(1, 0), a2_0 + kstep, w00, w01);
            G8_BAR; G8_WAIT_L(0); G8_MMA(1, 0, At, B0); G8_BAR; G8_SCHED;
            G8_STAGE(G8_SB(1, 1), b2_1 + kstep, voffB[0], voffB[1]);
            G8_WAIT_V(6); G8_BAR; G8_MMA(1, 1, At, B1); G8_BAR;
        }
        E(acc, cur, wr, wc, fr, fq);
        if (!has_next) break;
#pragma unroll
        for (int a = 0; a < 2; ++a)
#pragma unroll
            for (int b = 0; b < 2; ++b)
#pragma unroll
                for (int m = 0; m < 4; ++m)
#pragma unroll
                    for (int n = 0; n < 2; ++n) acc[a][b][m][n] = (f32x4){0.f, 0.f, 0.f, 0.f};
        cur = nxt; cA0 = nA0; cA1 = nA1; cB0 = nB0; cB1 = nB1; ++ui;
        if constexpr (GATHER) {
#pragma unroll
            for (int h = 0; h < 2; ++h)
#pragma unroll
                for (int i = 0; i < 2; ++i) vc[h][i] = vn[h][i]; }
    }
    G8_WAIT_V(0);
    if (wr == 0) G8_BAR;
    G8_BAR;
#undef G8_SA
#undef G8_SB
#undef G8_STAGE
#undef G8_LDA
#undef G8_LDB
#undef G8_MMA
}
}
using g8::GU;

#define EPI_ARGS const f32x4 (&acc)[2][2][4][2], const GU& u, int wr, int wc, int fr, int fq

struct EpiStoreBf16 {
    static constexpr bool PERM = true;
    bf16_t* O; size_t ld; float scale;
    __device__ __forceinline__ void operator()(EPI_ARGS) const {
        const int row0 = u.p0 * 256 + wr * 64 + fr, col0 = u.p1 * 256 + wc * 32 + 8 * fq;
#pragma unroll
        for (int ai = 0; ai < 2; ++ai)
#pragma unroll
            for (int m = 0; m < 4; ++m) { bf16_t* rowp = O + (size_t)(row0 + ai * 128 + m * 16) * ld + col0;
#pragma unroll
                for (int bj = 0; bj < 2; ++bj) { const f32x4 v0 = acc[ai][bj][m][0] * scale, v1 = acc[ai][bj][m][1] * scale;
                    u32x4 w; w.x = cvt_pk_bf16(v0[0], v0[1]); w.y = cvt_pk_bf16(v0[2], v0[3]); w.z = cvt_pk_bf16(v1[0], v1[1]); w.w = cvt_pk_bf16(v1[2], v1[3]);
                    *(u32x4*)(rowp + bj * 128) = w; } }
    }
};
struct EpiInAB {
    static constexpr bool PERM = true;
    bf16_t* A2; bf16_t* Q; bf16_t* Kk;
    __device__ __forceinline__ void operator()(EPI_ARGS) const {
        const int row0 = u.p0 * 256 + wr * 64 + fr, colt = u.p1 * 256 + wc * 32 + 8 * fq; const int kind = u.p1 >> 1;
        const float sc = (kind == 1) ? QSCALE : 1.0f;
#pragma unroll
        for (int ai = 0; ai < 2; ++ai)
#pragma unroll
            for (int m = 0; m < 4; ++m) { const int row = row0 + ai * 128 + m * 16;
#pragma unroll
                for (int bj = 0; bj < 2; ++bj) { const f32x4 v0 = acc[ai][bj][m][0] * sc, v1 = acc[ai][bj][m][1] * sc; const int col = colt + bj * 128;
                    u32x4 w; w.x = cvt_pk_bf16(v0[0], v0[1]); w.y = cvt_pk_bf16(v0[2], v0[3]); w.z = cvt_pk_bf16(v1[0], v1[1]); w.w = cvt_pk_bf16(v1[2], v1[3]);
                    bf16_t* p;
                    if (kind == 0) { const int g = col >> 4, hp = col & 15, b = row >> 12, l = row & 4095; p = A2 + ((size_t)(g * 1024 + b * NCH + (l >> 5)) * A2LD + (l & 31) * 16 + hp); }
                    else if (kind == 1) p = Q + (size_t)row * 512 + (col - 512);
                    else p = Kk + (size_t)row * 512 + (col - 1024);
                    *(u32x4*)p = w; } }
    }
};
struct EpiInC {
    static constexpr bool PERM = true;
    bf16_t* Q; bf16_t* Kk;
    __device__ __forceinline__ void operator()(EPI_ARGS) const {
        const int row0 = u.p0 * 256 + wr * 64 + fr; const bool isq = u.p1 < 4; const int col0 = (u.p1 & 3) * 256 + wc * 32 + 8 * fq;
        const float sc = isq ? QSCALE : 1.0f; bf16_t* base = isq ? Q : Kk;
#pragma unroll
        for (int ai = 0; ai < 2; ++ai)
#pragma unroll
            for (int m = 0; m < 4; ++m) { bf16_t* rowp = base + (size_t)(row0 + ai * 128 + m * 16) * 1024 + col0;
#pragma unroll
                for (int bj = 0; bj < 2; ++bj) { const f32x4 v0 = acc[ai][bj][m][0] * sc, v1 = acc[ai][bj][m][1] * sc;
                    u32x4 w; w.x = cvt_pk_bf16(v0[0], v0[1]); w.y = cvt_pk_bf16(v0[2], v0[3]); w.z = cvt_pk_bf16(v1[0], v1[1]); w.w = cvt_pk_bf16(v1[2], v1[3]);
                    *(u32x4*)(rowp + bj * 128) = w; } }
    }
};
struct EpiS {
    static constexpr bool PERM = false;
    float* S;
    __device__ __forceinline__ void operator()(EPI_ARGS) const {
        const int row0 = u.p0 * 256 + wr * 64 + fr, col0 = wc * 32 + 4 * fq; float* base = S + (size_t)u.p2 * 1024 * 128;
#pragma unroll
        for (int ai = 0; ai < 2; ++ai)
#pragma unroll
            for (int m = 0; m < 4; ++m) { float* rowp = base + (size_t)(row0 + ai * 128 + m * 16) * 128 + col0;
#pragma unroll
                for (int n = 0; n < 2; ++n) *(f32x4*)(rowp + n * 16) = acc[ai][0][m][n]; }
    }
};
__device__ __forceinline__ float gelu_tanh(float x) { const float a = 0.7978845608f * (x + 0.044715f * x * x * x); return x * rcp(1.0f + ex2(-2.0f * LOG2E * a)); }
struct EpiY {
    static constexpr bool PERM = true;
    bf16_t* Z;
    __device__ __forceinline__ void operator()(EPI_ARGS) const {
        const int row0 = u.p0 * 256 + wr * 64 + fr, col0 = u.p1 * 256 + wc * 32 + 8 * fq, g = u.p2;
#pragma unroll
        for (int ai = 0; ai < 2; ++ai)
#pragma unroll
            for (int m = 0; m < 4; ++m) { const int row = row0 + ai * 128 + m * 16, b = row >> 7, ch = row & 127;
#pragma unroll
                for (int bj = 0; bj < 2; ++bj) { const int col = col0 + bj * 128, t = col >> 4, h = col & 15; const f32x4 v0 = acc[ai][bj][m][0], v1 = acc[ai][bj][m][1];
                    u32x4 w; w.x = cvt_pk_bf16(gelu_tanh(v0[0]), gelu_tanh(v0[1])); w.y = cvt_pk_bf16(gelu_tanh(v0[2]), gelu_tanh(v0[3]));
                    w.z = cvt_pk_bf16(gelu_tanh(v1[0]), gelu_tanh(v1[1])); w.w = cvt_pk_bf16(gelu_tanh(v1[2]), gelu_tanh(v1[3]));
                    *(u32x4*)(Z + (size_t)(b * SEQ + ch * TCH + t) * 512 + g * 16 + h) = w; } }
    }
};
struct EpiGlu {
    static constexpr bool PERM = true;
    const bf16_t* Z; const float* bias; bf16_t* Y;
    __device__ __forceinline__ void operator()(EPI_ARGS) const {
        const int row0 = u.p0 * 256 + wr * 64 + fr, col0 = u.p1 * 256 + wc * 32 + 8 * fq;
#pragma unroll
        for (int bj = 0; bj < 2; ++bj) { const int col = col0 + bj * 128; const f32x4 b0 = *(const f32x4*)(bias + col), b1 = *(const f32x4*)(bias + col + 4);
#pragma unroll
            for (int ai = 0; ai < 2; ++ai)
#pragma unroll
                for (int m = 0; m < 4; ++m) { const int row = row0 + ai * 128 + m * 16; const u32x4 zz = *(const u32x4*)(Z + (size_t)row * 512 + col);
                    const f32x4 v0 = acc[ai][bj][m][0] + b0, v1 = acc[ai][bj][m][1] + b1;
                    u32x4 w; w.x = cvt_pk_bf16(bf_lo(zz.x) * sigmoidf_(v0[0]), bf_hi(zz.x) * sigmoidf_(v0[1])); w.y = cvt_pk_bf16(bf_lo(zz.y) * sigmoidf_(v0[2]), bf_hi(zz.y) * sigmoidf_(v0[3]));
                    w.z = cvt_pk_bf16(bf_lo(zz.z) * sigmoidf_(v1[0]), bf_hi(zz.z) * sigmoidf_(v1[1])); w.w = cvt_pk_bf16(bf_lo(zz.w) * sigmoidf_(v1[2]), bf_hi(zz.w) * sigmoidf_(v1[3]));
                    *(u32x4*)(Y + (size_t)row * 1024 + col) = w; } }
    }
};
struct EpiRes {
    static constexpr bool PERM = false;
    const float* res; float* out;
    __device__ __forceinline__ void operator()(EPI_ARGS) const {
        const int row0 = u.p0 * 256 + wr * 64 + fr, col0 = u.p1 * 256 + wc * 32 + 4 * fq;
#pragma unroll
        for (int ai = 0; ai < 2; ++ai)
#pragma unroll
            for (int m = 0; m < 4; ++m) { const size_t ro = (size_t)(row0 + ai * 128 + m * 16) * 1024 + col0;
#pragma unroll
                for (int bj = 0; bj < 2; ++bj)
#pragma unroll
                    for (int n = 0; n < 2; ++n) { const size_t o = ro + bj * 128 + n * 16; *(f32x4*)(out + o) = *(const f32x4*)(res + o) + acc[ai][bj][m][n]; } }
    }
};
struct EpiSwiglu {
    static constexpr bool PERM = true;
    const float* bg; const float* bu; bf16_t* act;
    __device__ __forceinline__ void operator()(EPI_ARGS) const {
        const int row0 = u.p0 + wr * 64 + fr, col = u.p1 + wc * 32 + 8 * fq; const float* pg = bg + (size_t)u.p2 * 1024 + col; const float* pu = bu + (size_t)u.p2 * 1024 + col;
        const f32x4 g0 = *(const f32x4*)pg, g1 = *(const f32x4*)(pg + 4), u0 = *(const f32x4*)pu, u1 = *(const f32x4*)(pu + 4);
#pragma unroll
        for (int ai = 0; ai < 2; ++ai)
#pragma unroll
            for (int m = 0; m < 4; ++m) { float r[8];
#pragma unroll
                for (int n = 0; n < 2; ++n)
#pragma unroll
                    for (int j = 0; j < 4; ++j) { const float gg = fminf(acc[ai][0][m][n][j] + (n ? g1[j] : g0[j]), 7.0f); const float uu = fminf(fmaxf(acc[ai][1][m][n][j] + (n ? u1[j] : u0[j]), -7.0f), 7.0f);
                        r[n * 4 + j] = gg * sigmoidf_(1.702f * gg) * (uu + 1.0f); }
                u32x4 w; w.x = cvt_pk_bf16(r[0], r[1]); w.y = cvt_pk_bf16(r[2], r[3]); w.z = cvt_pk_bf16(r[4], r[5]); w.w = cvt_pk_bf16(r[6], r[7]);
                *(u32x4*)(act + (size_t)(row0 + ai * 128 + m * 16) * 1024 + col) = w; }
    }
};
struct EpiDown {
    static constexpr bool PERM = true;
    const float* bd; bf16_t* ys;
    __device__ __forceinline__ void operator()(EPI_ARGS) const {
        const int row0 = u.p0 + wr * 64 + fr, col0 = u.p1 + wc * 32 + 8 * fq;
#pragma unroll
        for (int bj = 0; bj < 2; ++bj) { const int col = col0 + bj * 128; const float* pb = bd + (size_t)u.p2 * 1024 + col; const f32x4 b0 = *(const f32x4*)pb, b1 = *(const f32x4*)(pb + 4);
#pragma unroll
            for (int ai = 0; ai < 2; ++ai)
#pragma unroll
                for (int m = 0; m < 4; ++m) { const f32x4 v0 = acc[ai][bj][m][0] + b0, v1 = acc[ai][bj][m][1] + b1;
                    u32x4 w; w.x = cvt_pk_bf16(v0[0], v0[1]); w.y = cvt_pk_bf16(v0[2], v0[3]); w.z = cvt_pk_bf16(v1[0], v1[1]); w.w = cvt_pk_bf16(v1[2], v1[3]);
                    *(u32x4*)(ys + (size_t)(row0 + ai * 128 + m * 16) * 1024 + col) = w; } }
    }
};
struct EpiPle {
    static constexpr bool PERM = true;
    const bf16_t* proj; float* r;
    __device__ __forceinline__ void operator()(EPI_ARGS) const {
        const int row0 = u.p0 * 256 + wr * 64 + fr, col0 = u.p1 * 256 + wc * 32 + 8 * fq;
#pragma unroll
        for (int ai = 0; ai < 2; ++ai)
#pragma unroll
            for (int m = 0; m < 4; ++m) { const size_t ro = (size_t)(row0 + ai * 128 + m * 16) * 1024 + col0;
#pragma unroll
                for (int bj = 0; bj < 2; ++bj) { const size_t o = ro + bj * 128; const u32x4 pp = *(const u32x4*)(proj + o); const f32x4 r0 = *(const f32x4*)(r + o), r1 = *(const f32x4*)(r + o + 4);
                    const f32x4 v0 = acc[ai][bj][m][0], v1 = acc[ai][bj][m][1];
                    f32x4 o0, o1;
                    o0[0] = r0[0] + bf_lo(pp.x) * sigmoidf_(v0[0]); o0[1] = r0[1] + bf_hi(pp.x) * sigmoidf_(v0[1]); o0[2] = r0[2] + bf_lo(pp.y) * sigmoidf_(v0[2]); o0[3] = r0[3] + bf_hi(pp.y) * sigmoidf_(v0[3]);
                    o1[0] = r1[0] + bf_lo(pp.z) * sigmoidf_(v1[0]); o1[1] = r1[1] + bf_hi(pp.z) * sigmoidf_(v1[1]); o1[2] = r1[2] + bf_lo(pp.w) * sigmoidf_(v1[2]); o1[3] = r1[3] + bf_hi(pp.w) * sigmoidf_(v1[3]);
                    *(f32x4*)(r + o) = o0; *(f32x4*)(r + o + 4) = o1; } }
    }
};

struct Args { const float* in[31]; float* out; unsigned char* ws; int ph_lo, ph_hi; unsigned char btab[128]; };
struct Frame {
    LAS unsigned char* lds; int tid, lane, wave, G, bid, gw, GW;
    unsigned char* ws; unsigned* ctl;
};
enum { I_X = 0, I_P, I_NMIX, I_NFFN, I_NPLE, I_NFINAL, I_WINAB, I_ARE, I_AIM, I_BRE, I_BIM, I_CRE, I_CIM, I_SSMD, I_LOGSTEP, I_GLUW, I_GLUB, I_WOUTAB, I_RELB, I_WINC, I_WOUTC,
       I_RW, I_RB, I_WG, I_BG, I_WU, I_BU, I_WD, I_BD, I_WPLE, I_WPLEG };

__device__ __forceinline__ void tconv(const Frame& F, const float* __restrict__ src, bf16_t* __restrict__ dst, int K, int N, int nmat) {
    LAS unsigned* T = (LAS unsigned*)(F.lds + F.wave * 8192);
    const int tk = K >> 6, tn = N >> 6; const long ntiles = (long)nmat * tk * tn;
    const int lane = F.lane, nq = lane & 15, kk = lane >> 4;
    for (long tt = F.gw; tt < ntiles; tt += F.GW) {
        const int mat = (int)(tt / (tk * tn)), rem = (int)(tt % (tk * tn)), kt = rem / tn, ntl = rem % tn;
        const float* s = src + (size_t)mat * K * N + (size_t)(kt * 64) * N + ntl * 64;
        bf16_t* d = dst + (size_t)mat * N * K + (size_t)(ntl * 64) * K + kt * 64;
#pragma unroll
        for (int it = 0; it < 8; ++it) { const int k0 = 8 * it + 2 * kk;
            const f32x4 a = *(const f32x4*)(s + (size_t)k0 * N + 4 * nq), b = *(const f32x4*)(s + (size_t)(k0 + 1) * N + 4 * nq);
#pragma unroll
            for (int j = 0; j < 4; ++j) { const int n = 4 * nq + j, kp = 4 * it + kk; T[32 * n + (kp ^ (4 * (nq & 7)))] = cvt_pk_bf16(a[j], b[j]); } }
        __builtin_amdgcn_fence(__ATOMIC_RELEASE, "wavefront"); __builtin_amdgcn_wave_barrier(); __builtin_amdgcn_fence(__ATOMIC_ACQUIRE, "wavefront");
#pragma unroll
        for (int it = 0; it < 8; ++it) { const int n = 8 * it + (lane >> 3), c = lane & 7;
            const u32x4 v = *(const LAS u32x4*)(T + 32 * n + 4 * (c ^ ((n >> 2) & 7)));
            *(u32x4*)(d + (size_t)n * K + 8 * c) = v; }
        __builtin_amdgcn_fence(__ATOMIC_RELEASE, "wavefront"); __builtin_amdgcn_wave_barrier(); __builtin_amdgcn_fence(__ATOMIC_ACQUIRE, "wavefront");
    }
}
__device__ __forceinline__ void conv_plain(const Frame& F, const float* __restrict__ src, bf16_t* __restrict__ dst, size_t n) {
    const size_t nth = (size_t)F.G * 512;
    for (size_t i = ((size_t)F.bid * 512 + F.tid) * 8; i < n; i += nth * 8) { const f32x4 a = *(const f32x4*)(src + i), b = *(const f32x4*)(src + i + 4);
        u32x4 w; w.x = cvt_pk_bf16(a[0], a[1]); w.y = cvt_pk_bf16(a[2], a[3]); w.z = cvt_pk_bf16(b[0], b[1]); w.w = cvt_pk_bf16(b[2], b[3]); *(u32x4*)(dst + i) = w; }
}
template <bool F32OUT>
__device__ __forceinline__ void rmsnorm_rows(const Frame& F, const float* __restrict__ src, const float* __restrict__ gain, bf16_t* __restrict__ dst, float* outf, int nrows) {
    const int lane = F.lane;
    f32x4 gv[4];
#pragma unroll
    for (int j = 0; j < 4; ++j) gv[j] = *(const f32x4*)(gain + 4 * (lane + 64 * j));
    for (int row = F.gw; row < nrows; row += F.GW) {
        const float* s = src + (size_t)row * 1024; f32x4 v[4]; float ss = 0.f;
#pragma unroll
        for (int j = 0; j < 4; ++j) { v[j] = *(const f32x4*)(s + 4 * (lane + 64 * j)); ss += v[j][0] * v[j][0] + v[j][1] * v[j][1] + v[j][2] * v[j][2] + v[j][3] * v[j][3]; }
        ss = wave_sum(ss); const float rstd = rsqrtf(ss * (1.0f / 1024.0f) + RMS_EPS);
#pragma unroll
        for (int j = 0; j < 4; ++j) { const f32x4 y = v[j] * rstd * gv[j];
            if (F32OUT) *(f32x4*)(outf + (size_t)row * 1024 + 4 * (lane + 64 * j)) = y;
            else { u32x2 w; w.x = cvt_pk_bf16(y[0], y[1]); w.y = cvt_pk_bf16(y[2], y[3]); *(u32x2*)(dst + (size_t)row * 1024 + 4 * (lane + 64 * j)) = w; } }
    }
}

__device__ __forceinline__ void s5_matrices(const Frame& F, const Args& a) {
    LAS float* Pr = (LAS float*)F.lds;
    LAS float* Pi = Pr + 33 * 64;
    LAS float* Br = Pi + 33 * 64;
    LAS float* Bi = Br + 1024;
    LAS float* Cr = Bi + 1024;
    LAS float* Ci = Cr + 1024;
    LAS float* Kf = Ci + 1024;
    LAS float* coefr = Kf + 8192; LAS float* coefi = coefr + 64;
    bf16_t* WbT = (bf16_t*)(F.ws + WS_WBT); bf16_t* My = (bf16_t*)(F.ws + WS_MY);
    const int t = F.tid;
    for (int g = F.bid; g < NGRP; g += F.G) {
        __syncthreads();
        if (t < 64) { const int n = t; const float are = a.in[I_ARE][g * 64 + n], aim = a.in[I_AIM][g * 64 + n], step = __expf(a.in[I_LOGSTEP][g]);
            for (int d = 0; d <= 32; ++d) { const float mag = __expf(are * step * (float)d); float rev = aim * step * (float)d * 0.15915494309189535f; rev -= rintf(rev);
                Pr[d * 64 + n] = mag * __builtin_amdgcn_cosf(rev); Pi[d * 64 + n] = mag * __builtin_amdgcn_sinf(rev); }
            const float lr = Pr[64 + n] - 1.0f, li = Pi[64 + n], den = 1.0f / (are * are + aim * aim);
            coefr[n] = (lr * are + li * aim) * den; coefi[n] = (li * are - lr * aim) * den; }
        __syncthreads();
        for (int idx = t; idx < 1024; idx += 512) { const int n = idx >> 4; const float br = a.in[I_BRE][g * 1024 + idx], bi = a.in[I_BIM][g * 1024 + idx];
            Br[idx] = coefr[n] * br - coefi[n] * bi; Bi[idx] = coefr[n] * bi + coefi[n] * br;
            Cr[idx] = a.in[I_CRE][g * 1024 + idx]; Ci[idx] = a.in[I_CIM][g * 1024 + idx]; }
        __syncthreads();
        { const int hh = t & 255, h = hh >> 4, hp = hh & 15;
          for (int d = t >> 8; d < 32; d += 2) { float s = 0.f;
              for (int n = 0; n < 64; ++n) { const float cr = Cr[h * 64 + n], ci = Ci[h * 64 + n], pr = Pr[d * 64 + n], pi = Pi[d * 64 + n];
                  const float mr = cr * pr - ci * pi, mi = cr * pi + ci * pr; s += mr * Br[n * 16 + hp] - mi * Bi[n * 16 + hp]; }
              if (d == 0 && h == hp) s += a.in[I_SSMD][g * 16 + h];
              Kf[d * 256 + hh] = s; } }
        __syncthreads();
        for (int ch = t; ch < 256 * 64; ch += 512) { const int row = ch >> 6, k0 = (ch & 63) * 8, s = k0 >> 4, hp0 = k0 & 15; float v[8];
            if (row < 128) { const int n = row & 63; const float pr = Pr[(31 - s) * 64 + n], pi = Pi[(31 - s) * 64 + n];
#pragma unroll
                for (int j = 0; j < 8; ++j) { const float br = Br[n * 16 + hp0 + j], bi = Bi[n * 16 + hp0 + j]; v[j] = (row < 64) ? (pr * br - pi * bi) : (pr * bi + pi * br); } }
            else {
#pragma unroll
                for (int j = 0; j < 8; ++j) v[j] = 0.f; }
            u32x4 w; w.x = cvt_pk_bf16(v[0], v[1]); w.y = cvt_pk_bf16(v[2], v[3]); w.z = cvt_pk_bf16(v[4], v[5]); w.w = cvt_pk_bf16(v[6], v[7]);
            *(u32x4*)(WbT + ((size_t)g * 256 + row) * 512 + k0) = w; }
        for (int ch = t; ch < 512 * 80; ch += 512) { const int row = ch / 80, k0 = (ch % 80) * 8, tt = row >> 4, h = row & 15; float v[8];
            if (k0 < 512) { const int s = k0 >> 4, hp0 = k0 & 15;
#pragma unroll
                for (int j = 0; j < 8; ++j) v[j] = (s <= tt) ? Kf[(tt - s) * 256 + h * 16 + hp0 + j] : 0.f; }
            else { const int n0 = (k0 - 512) & 63; const bool im = k0 >= 576;
#pragma unroll
                for (int j = 0; j < 8; ++j) { const int n = n0 + j; const float cr = Cr[h * 64 + n], ci = Ci[h * 64 + n], pr = Pr[(tt + 1) * 64 + n], pi = Pi[(tt + 1) * 64 + n];
                    v[j] = im ? -(cr * pi + ci * pr) : (cr * pr - ci * pi); } }
            u32x4 w; w.x = cvt_pk_bf16(v[0], v[1]); w.y = cvt_pk_bf16(v[2], v[3]); w.z = cvt_pk_bf16(v[4], v[5]); w.w = cvt_pk_bf16(v[6], v[7]);
            *(u32x4*)(My + ((size_t)g * 512 + row) * A2LD + k0) = w; }
    }
    __syncthreads();
}

__device__ __forceinline__ void conv_moe_weights(const Frame& F, const Args& a, int layer) {
    bf16_t* W = (bf16_t*)(F.ws + WS_MOEW); const size_t L = (size_t)NEXP * 1024 * 1024;
    tconv(F, a.in[I_WG] + layer * L, W, 1024, 1024, NEXP);
    tconv(F, a.in[I_WU] + layer * L, W + L, 1024, 1024, NEXP);
    tconv(F, a.in[I_WD] + layer * L, W + 2 * L, 1024, 1024, NEXP);
}

__device__ __forceinline__ void p0_prologue(const Frame& F, const Args& a) {
    s5_matrices(F, a);
    tconv(F, a.in[I_WINAB], (bf16_t*)(F.ws + WS_WINAB), 1024, 2048, 1);
    tconv(F, a.in[I_GLUW], (bf16_t*)(F.ws + WS_GLU), 512, 512, 1);
    tconv(F, a.in[I_WOUTAB], (bf16_t*)(F.ws + WS_WOUTAB), 1024, 1024, 1);
    tconv(F, a.in[I_WINC], (bf16_t*)(F.ws + WS_WINC), 1024, 3072, 1);
    tconv(F, a.in[I_WOUTC], (bf16_t*)(F.ws + WS_WOUTC), 1024, 1024, 1);
    tconv(F, a.in[I_WPLE], (bf16_t*)(F.ws + WS_WPLE), 256, 1024, 2);
    tconv(F, a.in[I_WPLEG], (bf16_t*)(F.ws + WS_WPLEG), 1024, 1024, 2);
    conv_moe_weights(F, a, 0);
    conv_plain(F, a.in[I_P], (bf16_t*)(F.ws + WS_PB), (size_t)2 * NTOK * PLE);
    rmsnorm_rows<false>(F, a.in[I_X], a.in[I_NMIX], (bf16_t*)(F.ws + WS_H), nullptr, NTOK);
}

__device__ __forceinline__ void s5_scan(const Frame& F, const Args& a) {
    const float* S = (const float*)(F.ws + RA_SS); bf16_t* A2 = (bf16_t*)(F.ws + RA_A2);
    const int n = F.lane;
    for (int item = F.gw; item < NGRP * NBATCH; item += F.GW) {
        const int g = item >> 3, b = item & 7;
        const float are = a.in[I_ARE][g * 64 + n], aim = a.in[I_AIM][g * 64 + n], step = __expf(a.in[I_LOGSTEP][g]);
        const float mag = __expf(are * step * 32.0f); float rev = aim * step * 32.0f * 0.15915494309189535f; rev -= rintf(rev);
        const float lr = mag * __builtin_amdgcn_cosf(rev), li = mag * __builtin_amdgcn_sinf(rev);
        float xr = 0.f, xi = 0.f;
        const float* sp = S + ((size_t)g * 1024 + b * NCH) * 128 + n; bf16_t* xp = A2 + ((size_t)g * 1024 + b * NCH) * A2LD + 512 + n;
        for (int c0 = 0; c0 < NCH; c0 += 16) {
            float sr[16], si[16];
#pragma unroll
            for (int j = 0; j < 16; ++j) { sr[j] = sp[(size_t)(c0 + j) * 128]; si[j] = sp[(size_t)(c0 + j) * 128 + 64]; }
#pragma unroll
            for (int j = 0; j < 16; ++j) { xp[(size_t)(c0 + j) * A2LD] = f2bf(xr); xp[(size_t)(c0 + j) * A2LD + 64] = f2bf(xi);
                const float nr = lr * xr - li * xi + sr[j], ni = lr * xi + li * xr + si[j]; xr = nr; xi = ni; }
        }
    }
}

__device__ __forceinline__ void moba_kmean(const Frame& F) {
    const bf16_t* Kk = (const bf16_t*)(F.ws + RA_K0); float* KM = (float*)(F.ws + RB_KMEAN);
    const int lane = F.lane, sub = lane >> 3, d8 = lane & 7;
    for (int item = F.gw; item < NBATCH * MH * NMB; item += F.GW) {
        const int j = item & 15, h = (item >> 4) & 7, b = item >> 7;
        const bf16_t* p = Kk + ((size_t)b * SEQ + j * MBLK + sub) * 512 + h * 64 + d8 * 8;
        float s[8];
#pragma unroll
        for (int i = 0; i < 8; ++i) s[i] = 0.f;
        for (int it = 0; it < 32; ++it) { const u32x4 v = *(const u32x4*)(p + (size_t)it * 8 * 512);
            s[0] += bf_lo(v.x); s[1] += bf_hi(v.x); s[2] += bf_lo(v.y); s[3] += bf_hi(v.y); s[4] += bf_lo(v.z); s[5] += bf_hi(v.z); s[6] += bf_lo(v.w); s[7] += bf_hi(v.w); }
#pragma unroll
        for (int i = 0; i < 8; ++i) { s[i] += __shfl_xor(s[i], 8); s[i] += __shfl_xor(s[i], 16); s[i] += __shfl_xor(s[i], 32); }
        if (lane < 8) {
#pragma unroll
            for (int i = 0; i < 8; ++i) KM[(size_t)item * 64 + lane * 8 + i] = s[i] * (1.0f / 256.0f); }
    }
}
__device__ __forceinline__ void moba_gate(const Frame& F) {
    const bf16_t* Q = (const bf16_t*)(F.ws + RA_Q0); const float* KM = (const float*)(F.ws + RB_KMEAN); int* LIST = (int*)(F.ws + RB_MOBALIST); unsigned* CNT = F.ctl + CW_MOBACNT;
    const int t = F.tid, sub = t >> 8, tq = t & 255;
    LAS float* km = (LAS float*)F.lds + sub * 1024;
    LAS int* lcnt = (LAS int*)(F.lds + 8192) + sub * 32;
    const int nitem = NBATCH * MH * 15;
    for (int it0 = F.bid * 2; it0 < nitem; it0 += F.G * 2) {
        const int item = it0 + sub; const bool act = item < nitem;
        const int i = act ? 1 + item % 15 : 1, bh = act ? item / 15 : 0, b = bh >> 3, h = bh & 7;
        __syncthreads();
        for (int x = tq; x < i * 64; x += 256) km[x] = KM[(size_t)bh * 1024 + x];
        if (tq < 32) lcnt[tq] = 0;
        __syncthreads();
        int sel[3] = {0, 0, 0}, lpos[3] = {0, 0, 0}; const int nsel = i < 3 ? i : 3;
        if (act) {
            const bf16_t* qp = Q + ((size_t)b * SEQ + i * MBLK + tq) * 512 + h * 64; float qv[64];
#pragma unroll
            for (int c = 0; c < 8; ++c) { const u32x4 v = *(const u32x4*)(qp + c * 8); qv[c * 8 + 0] = bf_lo(v.x); qv[c * 8 + 1] = bf_hi(v.x); qv[c * 8 + 2] = bf_lo(v.y); qv[c * 8 + 3] = bf_hi(v.y);
                qv[c * 8 + 4] = bf_lo(v.z); qv[c * 8 + 5] = bf_hi(v.z); qv[c * 8 + 6] = bf_lo(v.w); qv[c * 8 + 7] = bf_hi(v.w); }
            float v0 = -3.0e38f, v1 = -3.0e38f, v2 = -3.0e38f; int i0 = 0, i1 = 0, i2 = 0;
            for (int j = 0; j < i; ++j) { float gsum = 0.f;
#pragma unroll
                for (int d = 0; d < 64; ++d) gsum += qv[d] * km[j * 64 + d];
                if (gsum > v0) { v2 = v1; i2 = i1; v1 = v0; i1 = i0; v0 = gsum; i0 = j; } else if (gsum > v1) { v2 = v1; i2 = i1; v1 = gsum; i1 = j; } else if (gsum > v2) { v2 = gsum; i2 = j; } }
            sel[0] = i0; sel[1] = i1; sel[2] = i2;
#pragma unroll
            for (int s = 0; s < 3; ++s) if (s < nsel) lpos[s] = atomicAdd((int*)&lcnt[sel[s]], 1);
        }
        __syncthreads();
        if (act && tq < 16 && lcnt[tq] > 0) lcnt[16 + tq] = (int)__hip_atomic_fetch_add(CNT + bh * 16 + tq, (unsigned)lcnt[tq], __ATOMIC_RELAXED, __HIP_MEMORY_SCOPE_AGENT);
        __syncthreads();
        if (act) {
#pragma unroll
            for (int s = 0; s < 3; ++s) if (s < nsel) LIST[((size_t)bh * 16 + sel[s]) * 4096 + lcnt[16 + sel[s]] + lpos[s]] = (i * MBLK + tq) | (s << 12); }
    }
    __syncthreads();
}

template <bool OWN>
__device__ __forceinline__ void moba_task(const bf16_t* __restrict__ Q, const bf16_t* __restrict__ Kk, const bf16_t* __restrict__ Vt, bf16_t* __restrict__ PO, float* __restrict__ PML,
                                          const LAS float* tab, int b, int h, int tq, bool valid, int slot, int key_base, int ntile, int tmin, int lane) {
    const int r = lane & 31, hf = lane >> 5; const size_t tokb = (size_t)b * SEQ;
    bf16x8 qf[4];
    { const bf16_t* qp = Q + (tokb + tq) * 512 + h * 64 + 8 * hf;
#pragma unroll
      for (int s = 0; s < 4; ++s) qf[s] = *(const bf16x8*)(qp + 16 * s); }
    f32x16 o0, o1;
#pragma unroll
    for (int i = 0; i < 16; ++i) { o0[i] = 0.f; o1[i] = 0.f; }
    float m = -1.0e30f, l = 0.f; const float b31 = tab[h * 128 + 127];
    for (int kt = 0; kt < ntile; ++kt) {
        const int key0 = key_base + 32 * kt;
        const bf16_t* kp = Kk + (tokb + key0 + r) * 512 + h * 64 + 8 * hf;
        f32x16 x;
#pragma unroll
        for (int i = 0; i < 16; ++i) x[i] = 0.f;
#pragma unroll
        for (int s = 0; s < 4; ++s) x = mfma32(*(const bf16x8*)(kp + 16 * s), qf[s], x);
        const bf16_t* vp = Vt + (size_t)(h * 64 + r) * NTOK + tokb + key0 + 4 * hf;
        bf16x4 va[2][2][2];
#pragma unroll
        for (int db = 0; db < 2; ++db)
#pragma unroll
            for (int s = 0; s < 2; ++s) { va[db][s][0] = *(const bf16x4*)(vp + (size_t)db * 32 * NTOK + 16 * s); va[db][s][1] = *(const bf16x4*)(vp + (size_t)db * 32 * NTOK + 16 * s + 8); }
        if (tmin - (key0 + 31) < 113) {
#pragma unroll
            for (int i = 0; i < 16; ++i) { const int row = (i & 3) + 8 * (i >> 2) + 4 * hf; const int dist = tq - (key0 + row); const int idx = dist < 0 ? 0 : (dist > 127 ? 127 : dist);
                x[i] += tab[h * 128 + idx]; if (OWN && dist < 0) x[i] = -1.0e30f; }
        } else {
#pragma unroll
            for (int i = 0; i < 16; ++i) x[i] += b31;
        }
        float mx = x[0];
#pragma unroll
        for (int i = 1; i < 16; ++i) mx = fmaxf(mx, x[i]);
        mx = fmaxf(mx, __shfl_xor(mx, 32));
        const float mn = fmaxf(m, mx), alpha = ex2(m - mn); m = mn;
        float ps = 0.f; unsigned pw[8];
#pragma unroll
        for (int i = 0; i < 8; ++i) { const float p0 = ex2(x[2 * i] - mn), p1 = ex2(x[2 * i + 1] - mn); ps += p0 + p1; pw[i] = cvt_pk_bf16(p0, p1); }
        l = l * alpha + ps;
        o0 *= alpha; o1 *= alpha;
#pragma unroll
        for (int s = 0; s < 2; ++s) { u32x4 pf; pf.x = pw[4 * s]; pf.y = pw[4 * s + 1]; pf.z = pw[4 * s + 2]; pf.w = pw[4 * s + 3];
            const bf16x8 pb = __builtin_bit_cast(bf16x8, pf);
            bf16x8 v0 = __builtin_shufflevector(va[0][s][0], va[0][s][1], 0, 1, 2, 3, 4, 5, 6, 7), v1 = __builtin_shufflevector(va[1][s][0], va[1][s][1], 0, 1, 2, 3, 4, 5, 6, 7);
            o0 = mfma32(v0, pb, o0); o1 = mfma32(v1, pb, o1); }
    }
    l += __shfl_xor(l, 32);
    if (valid) { const float inv = 1.0f / l; const size_t pi = ((tokb + tq) * 8 + h) * 4 + slot; bf16_t* po = PO + pi * 64 + 4 * hf;
#pragma unroll
        for (int g = 0; g < 4; ++g) { u32x2 w0, w1; w0.x = cvt_pk_bf16(o0[4 * g] * inv, o0[4 * g + 1] * inv); w0.y = cvt_pk_bf16(o0[4 * g + 2] * inv, o0[4 * g + 3] * inv);
            w1.x = cvt_pk_bf16(o1[4 * g] * inv, o1[4 * g + 1] * inv); w1.y = cvt_pk_bf16(o1[4 * g + 2] * inv, o1[4 * g + 3] * inv);
            *(u32x2*)(po + 8 * g) = w0; *(u32x2*)(po + 32 + 8 * g) = w1; }
        if (hf == 0) { f32x2 ml; ml.x = m; ml.y = l; *(f32x2*)(PML + pi * 2) = ml; } }
}

__device__ __forceinline__ void moba_attn(const Frame& F, const Args& a) {
    const bf16_t* Q = (const bf16_t*)(F.ws + RA_Q0); const bf16_t* Kk = (const bf16_t*)(F.ws + RA_K0); const bf16_t* Vt = (const bf16_t*)(F.ws + RA_VT0);
    bf16_t* PO = (bf16_t*)(F.ws + RB_PARTO); float* PML = (float*)(F.ws + RB_PARTML); const int* LIST = (const int*)(F.ws + RB_MOBALIST); unsigned* CNT = F.ctl + CW_MOBACNT;
    LAS float* tab = (LAS float*)F.lds;
    LAS int* pre = (LAS int*)(F.lds + 4096);
    LAS int* cnts = (LAS int*)(F.lds + 4096 + 4128);
    LAS int* wsum = (LAS int*)(F.lds + 4096 + 4128 + 4096);
    const int t = F.tid, lane = F.lane;
    __syncthreads();
    for (int x = t; x < 1024; x += 512) { const int hh = x >> 7, dd = x & 127; tab[x] = a.in[I_RELB][a.btab[dd] * 8 + hh] * LOG2E; }
    { const int c0 = (int)__hip_atomic_load(CNT + 2 * t, __ATOMIC_RELAXED, __HIP_MEMORY_SCOPE_AGENT), c1 = (int)__hip_atomic_load(CNT + 2 * t + 1, __ATOMIC_RELAXED, __HIP_MEMORY_SCOPE_AGENT);
      cnts[2 * t] = c0; cnts[2 * t + 1] = c1; const int t0 = (c0 + 31) >> 5, t1 = (c1 + 31) >> 5; int s = t0 + t1, inc = s;
#pragma unroll
      for (int o = 1; o < 64; o <<= 1) { const int v = __shfl_up(inc, o); if (lane >= o) inc += v; }
      if (lane == 63) wsum[F.wave] = inc;
      __syncthreads();
      int base = 0; for (int w = 0; w < F.wave; ++w) base += wsum[w];
      const int ex = base + inc - s; pre[2 * t] = ex; pre[2 * t + 1] = ex + t0; if (t == 511) pre[1024] = ex + s; }
    __syncthreads();
    const int nsel = pre[1024], ntask = nsel + NBATCH * MH * NMB * 8;
    for (int task = F.gw; task < ntask; task += F.GW) {
        if (task < nsel) {
            int lo = 0, hi = 1023;
            while (lo < hi) { const int mid = (lo + hi + 1) >> 1; if (pre[mid] <= task) lo = mid; else hi = mid - 1; }
            const int list = lo, chunk = task - pre[list], cnt = cnts[list], bh = list >> 4, j = list & 15;
            const int idx = chunk * 32 + (lane & 31); const bool valid = idx < cnt; const int e = valid ? LIST[(size_t)list * 4096 + idx] : 4095;
            const int tq = e & 4095, slot = valid ? (e >> 12) : 0; int tmin = tq;
#pragma unroll
            for (int o = 32; o >= 1; o >>= 1) tmin = min(tmin, __shfl_xor(tmin, o));
            moba_task<false>(Q, Kk, Vt, PO, PML, tab, bh >> 3, bh & 7, tq, valid, slot, j * MBLK, 8, tmin, lane);
        } else {
            const int o = task - nsel, qg = o & 7, i = (o >> 3) & 15, bh = o >> 7; const int t0 = i * MBLK + 32 * qg;
            moba_task<true>(Q, Kk, Vt, PO, PML, tab, bh >> 3, bh & 7, t0 + (lane & 31), true, 3, i * MBLK, qg + 1, t0, lane);
        }
    }
    __syncthreads();
}
__device__ __forceinline__ void moba_combine(const Frame& F) {
    const bf16_t* PO = (const bf16_t*)(F.ws + RB_PARTO); const float* PML = (const float*)(F.ws + RB_PARTML); bf16_t* Y = (bf16_t*)(F.ws + RB_YCAT);
    const int lane = F.lane, h = lane >> 3, dc = lane & 7;
    for (int tok = F.gw; tok < NTOK; tok += F.GW) {
        const int i = (tok & 4095) >> 8, nsel = i < 3 ? i : 3; const size_t pb = ((size_t)tok * 8 + h) * 4;
        float mm[4], ll[4]; float M = -3.0e38f;
#pragma unroll
        for (int s = 0; s < 4; ++s) { const bool v = (s == 3) || (s < nsel); if (v) { const f32x2 ml = *(const f32x2*)(PML + (pb + s) * 2); mm[s] = ml.x; ll[s] = ml.y; M = fmaxf(M, ml.x); } else { mm[s] = -3.0e38f; ll[s] = 0.f; } }
        float acc[8], den = 0.f;
#pragma unroll
        for (int j = 0; j < 8; ++j) acc[j] = 0.f;
#pragma unroll
        for (int s = 0; s < 4; ++s) { const bool v = (s == 3) || (s < nsel); if (v) { const float w = ll[s] * ex2(mm[s] - M); den += w; const u32x4 o = *(const u32x4*)(PO + (pb + s) * 64 + dc * 8);
            acc[0] += w * bf_lo(o.x); acc[1] += w * bf_hi(o.x); acc[2] += w * bf_lo(o.y); acc[3] += w * bf_hi(o.y); acc[4] += w * bf_lo(o.z); acc[5] += w * bf_hi(o.z); acc[6] += w * bf_lo(o.w); acc[7] += w * bf_hi(o.w); } }
        const float inv = 1.0f / den;
        u32x4 w; w.x = cvt_pk_bf16(acc[0] * inv, acc[1] * inv); w.y = cvt_pk_bf16(acc[2] * inv, acc[3] * inv); w.z = cvt_pk_bf16(acc[4] * inv, acc[5] * inv); w.w = cvt_pk_bf16(acc[6] * inv, acc[7] * inv);
        *(u32x4*)(Y + (size_t)tok * 1024 + 512 + h * 64 + dc * 8) = w;
    }
}

__device__ __forceinline__ void sb_attn(const Frame& F) {
    const bf16_t* Q = (const bf16_t*)(F.ws + RA_Q1); const bf16_t* Kk = (const bf16_t*)(F.ws + RA_K1); const bf16_t* Vt = (const bf16_t*)(F.ws + RA_VT1); bf16_t* Y = (bf16_t*)(F.ws + RB_Y1);
    const int lane = F.lane, r = lane & 31, hf = lane >> 5;
    bf16x8 tri[2];
#pragma unroll
    for (int s = 0; s < 2; ++s)
#pragma unroll
        for (int j = 0; j < 8; ++j) { const int kap = 16 * s + 8 * (j >> 2) + 4 * hf + (j & 3); tri[s][j] = (kap >= r) ? (short)0x3F80 : (short)0; }
    const int ntask = NBATCH * 16 * (SEQ / 32);
    for (int task = F.gw; task < ntask; task += F.GW) {
        const int qt = task & 127, head = (task >> 7) & 15, b = task >> 11; const int t0 = qt * 32; const size_t tokb = (size_t)b * SEQ;
        bf16x8 qf[4];
        { const bf16_t* qp = Q + (tokb + t0 + r) * 1024 + head * 64 + 8 * hf;
#pragma unroll
          for (int s = 0; s < 4; ++s) qf[s] = *(const bf16x8*)(qp + 16 * s); }
        f32x16 o0, o1;
#pragma unroll
        for (int i = 0; i < 16; ++i) { o0[i] = 0.f; o1[i] = 0.f; }
        float carry = 0.f;
        for (int key0 = t0; key0 >= 0; key0 -= 32) {
            const bool diag = (key0 == t0);
            const bf16_t* kp = Kk + (tokb + key0 + r) * 1024 + head * 64 + 8 * hf;
            f32x16 x;
#pragma unroll
            for (int i = 0; i < 16; ++i) x[i] = 0.f;
#pragma unroll
            for (int s = 0; s < 4; ++s) x = mfma32(*(const bf16x8*)(kp + 16 * s), qf[s], x);
            const bf16_t* vp = Vt + (size_t)(head * 64 + r) * NTOK + tokb + key0 + 4 * hf;
            bf16x4 va[2][2][2];
#pragma unroll
            for (int db = 0; db < 2; ++db)
#pragma unroll
                for (int s = 0; s < 2; ++s) { va[db][s][0] = *(const bf16x4*)(vp + (size_t)db * 32 * NTOK + 16 * s); va[db][s][1] = *(const bf16x4*)(vp + (size_t)db * 32 * NTOK + 16 * s + 8); }
            float sp[16];
#pragma unroll
            for (int i = 0; i < 16; ++i) { const int row = (i & 3) + 8 * (i >> 2) + 4 * hf; const float zl = x[i];
                float v = fmaxf(zl, 0.f) + lg2(1.0f + ex2(-fabsf(zl))); if (diag && row >= r) v = 0.f; sp[i] = v; }
            unsigned hw[8], lw[8];
#pragma unroll
            for (int i = 0; i < 8; ++i) { hw[i] = cvt_pk_bf16(sp[2 * i], sp[2 * i + 1]); lw[i] = cvt_pk_bf16(sp[2 * i] - bf_lo(hw[i]), sp[2 * i + 1] - bf_hi(hw[i])); }
            f32x16 y;
#pragma unroll
            for (int i = 0; i < 16; ++i) y[i] = 0.f;
#pragma unroll
            for (int s = 0; s < 2; ++s) { u32x4 a, c; a.x = hw[4 * s]; a.y = hw[4 * s + 1]; a.z = hw[4 * s + 2]; a.w = hw[4 * s + 3]; c.x = lw[4 * s]; c.y = lw[4 * s + 1]; c.z = lw[4 * s + 2]; c.w = lw[4 * s + 3];
                y = mfma32(tri[s], __builtin_bit_cast(bf16x8, a), y); y = mfma32(tri[s], __builtin_bit_cast(bf16x8, c), y); }
            unsigned pw[8];
#pragma unroll
            for (int i = 0; i < 8; ++i) { const int i0 = 2 * i, i1 = 2 * i + 1; const int row0 = (i0 & 3) + 8 * (i0 >> 2) + 4 * hf, row1 = (i1 & 3) + 8 * (i1 >> 2) + 4 * hf;
                float w0 = ex2(x[i0] - y[i0] - carry), w1 = ex2(x[i1] - y[i1] - carry); if (diag && row0 >= r) w0 = 0.f; if (diag && row1 >= r) w1 = 0.f; pw[i] = cvt_pk_bf16(w0, w1); }
#pragma unroll
            for (int s = 0; s < 2; ++s) { u32x4 pf; pf.x = pw[4 * s]; pf.y = pw[4 * s + 1]; pf.z = pw[4 * s + 2]; pf.w = pw[4 * s + 3];
                const bf16x8 pb = __builtin_bit_cast(bf16x8, pf);
                bf16x8 v0 = __builtin_shufflevector(va[0][s][0], va[0][s][1], 0, 1, 2, 3, 4, 5, 6, 7), v1 = __builtin_shufflevector(va[1][s][0], va[1][s][1], 0, 1, 2, 3, 4, 5, 6, 7);
                o0 = mfma32(v0, pb, o0); o1 = mfma32(v1, pb, o1); }
            carry += __shfl(y[0], r);
            if (__all(carry >= SB_THR)) break;
        }
        bf16_t* yo = Y + (tokb + t0 + r) * 1024 + head * 64 + 4 * hf;
#pragma unroll
        for (int g = 0; g < 4; ++g) { u32x2 w0, w1; w0.x = cvt_pk_bf16(o0[4 * g], o0[4 * g + 1]); w0.y = cvt_pk_bf16(o0[4 * g + 2], o0[4 * g + 3]);
            w1.x = cvt_pk_bf16(o1[4 * g], o1[4 * g + 1]); w1.y = cvt_pk_bf16(o1[4 * g + 2], o1[4 * g + 3]);
            *(u32x2*)(yo + 8 * g) = w0; *(u32x2*)(yo + 32 + 8 * g) = w1; }
    }
}

__device__ __forceinline__ void moe_router(const Frame& F, const Args& a, int layer, const float* __restrict__ r) {
    bf16_t* H = (bf16_t*)(F.ws + WS_H); int* MLIST = (int*)(F.ws + WS_MLIST); int* TOKEP = (int*)(F.ws + WS_TOKEP); float* TOKG = (float*)(F.ws + WS_TOKG); unsigned* GCNT = F.ctl + CW_GCNT + layer * 64;
    const float* rw = a.in[I_RW] + (size_t)layer * 1024 * 32; const float* rb = a.in[I_RB] + layer * 32; const float* gain = a.in[I_NFFN] + layer * 1024;
    LAS float* hs = (LAS float*)F.lds;
    LAS float* part = (LAS float*)(F.lds + 32768);
    LAS float* logit = (LAS float*)(F.lds + 49152);
    LAS int* lcnt = (LAS int*)(F.lds + 50176);
    LAS int* tinfo = (LAS int*)(F.lds + 50432);
    const int t = F.tid, lane = F.lane, wave = F.wave, e = t & 31, ks = t >> 5;
    const int per = (NTOK + F.G - 1) / F.G, tok0 = F.bid * per, tok1 = min(NTOK, tok0 + per);
    float rwr[64];
#pragma unroll
    for (int i = 0; i < 64; ++i) rwr[i] = rw[(size_t)(ks * 64 + i) * 32 + e];
    f32x4 gv[4];
#pragma unroll
    for (int j = 0; j < 4; ++j) gv[j] = *(const f32x4*)(gain + 4 * (lane + 64 * j));
    __syncthreads();
    if (t < 64) lcnt[t] = 0;
    for (int base = tok0; base < tok1; base += 8) {
        const int tok = base + wave;
        if (tok < tok1) { const float* s = r + (size_t)tok * 1024; f32x4 v[4]; float ss = 0.f;
#pragma unroll
            for (int j = 0; j < 4; ++j) { v[j] = *(const f32x4*)(s + 4 * (lane + 64 * j)); ss += v[j][0] * v[j][0] + v[j][1] * v[j][1] + v[j][2] * v[j][2] + v[j][3] * v[j][3]; }
            ss = wave_sum(ss); const float rstd = rsqrtf(ss * (1.0f / 1024.0f) + RMS_EPS);
#pragma unroll
            for (int j = 0; j < 4; ++j) { const f32x4 y = v[j] * rstd * gv[j]; *(LAS f32x4*)(hs + wave * 1024 + 4 * (lane + 64 * j)) = y;
                u32x2 w; w.x = cvt_pk_bf16(y[0], y[1]); w.y = cvt_pk_bf16(y[2], y[3]); *(u32x2*)(H + (size_t)tok * 1024 + 4 * (lane + 64 * j)) = w; } }
        __syncthreads();
#pragma unroll
        for (int tk = 0; tk < 8; ++tk) { float acc = 0.f;
#pragma unroll
            for (int i4 = 0; i4 < 16; ++i4) { const f32x4 hv = *(const LAS f32x4*)(hs + tk * 1024 + ks * 64 + 4 * i4); acc += hv[0] * rwr[4 * i4] + hv[1] * rwr[4 * i4 + 1] + hv[2] * rwr[4 * i4 + 2] + hv[3] * rwr[4 * i4 + 3]; }
            part[(tk * 16 + ks) * 32 + e] = acc; }
        __syncthreads();
        if (t < 256) { const int tk = t >> 5; float s = rb[e];
#pragma unroll
            for (int k = 0; k < 16; ++k) s += part[(tk * 16 + k) * 32 + e];
            logit[tk * 32 + e] = s; }
        __syncthreads();
        if (t < 8 && base + t < tok1) { const int tk = t, tokk = base + t; float v0 = -3.0e38f, v1 = -3.0e38f, v2 = -3.0e38f, v3 = -3.0e38f; int i0 = 0, i1 = 0, i2 = 0, i3 = 0;
            for (int j = 0; j < 32; ++j) { const float g = logit[tk * 32 + j];
                if (g > v0) { v3 = v2; i3 = i2; v2 = v1; i2 = i1; v1 = v0; i1 = i0; v0 = g; i0 = j; } else if (g > v1) { v3 = v2; i3 = i2; v2 = v1; i2 = i1; v1 = g; i1 = j; }
                else if (g > v2) { v3 = v2; i3 = i2; v2 = g; i2 = j; } else if (g > v3) { v3 = g; i3 = j; } }
            const float e1 = __expf(v1 - v0), e2 = __expf(v2 - v0), e3 = __expf(v3 - v0), inv = 1.0f / (1.0f + e1 + e2 + e3);
            f32x4 gg; gg[0] = inv; gg[1] = e1 * inv; gg[2] = e2 * inv; gg[3] = e3 * inv; *(f32x4*)(TOKG + (size_t)tokk * 4) = gg;
            const int lt = tokk - tok0;
            tinfo[lt * 4 + 0] = (i0 << 20) | atomicAdd((int*)&lcnt[i0], 1); tinfo[lt * 4 + 1] = (i1 << 20) | atomicAdd((int*)&lcnt[i1], 1);
            tinfo[lt * 4 + 2] = (i2 << 20) | atomicAdd((int*)&lcnt[i2], 1); tinfo[lt * 4 + 3] = (i3 << 20) | atomicAdd((int*)&lcnt[i3], 1); }
    }
    __syncthreads();
    if (t < 32) lcnt[32 + t] = (int)__hip_atomic_fetch_add(GCNT + t, (unsigned)lcnt[t], __ATOMIC_RELAXED, __HIP_MEMORY_SCOPE_AGENT);
    __syncthreads();
    for (int x = t; x < (tok1 - tok0) * 4; x += 512) { const int v = tinfo[x], ee = v >> 20, pos = lcnt[32 + ee] + (v & 0xfffff), tokk = tok0 + (x >> 2);
        MLIST[(size_t)ee * NTOK + pos] = tokk; TOKEP[(size_t)tokk * 4 + (x & 3)] = (ee << 20) | pos; }
    __syncthreads();
}

struct MoeTab { LAS int* cnt; LAS int* tb; LAS int* rte; int NT; };
__device__ __forceinline__ MoeTab moe_tables(const Frame& F, int layer) {
    MoeTab T; T.cnt = (LAS int*)(F.lds + LDS_AUX + 18432); T.tb = T.cnt + 32; T.rte = T.tb + 40;
    unsigned* GCNT = F.ctl + CW_GCNT + layer * 64; const int t = F.tid;
    __syncthreads();
    if (t < 32) T.cnt[t] = (int)__hip_atomic_load(GCNT + t, __ATOMIC_RELAXED, __HIP_MEMORY_SCOPE_AGENT);
    __syncthreads();
    if (t == 0) { int s = 0; for (int e = 0; e < 32; ++e) { T.tb[e] = s; s += (T.cnt[e] + 255) >> 8; } T.tb[32] = s; }
    __syncthreads();
    T.NT = T.tb[32];
    for (int x = t; x < T.NT; x += 512) { int e = 0; for (int k = 1; k < 32; ++k) if (T.tb[k] <= x) e = k; T.rte[x] = e; }
    __syncthreads();
    return T;
}
__device__ __forceinline__ bool moe_unit(int i, int G, int c, int NT, int NPN, int& rt, int& pn) {
    const long L = (long)i * G + c;
    if ((G & 7) == 0) { const int xcd = (int)(L & 7); const long idx = L >> 3; rt = (int)(idx / NPN) * 8 + xcd; pn = (int)(idx % NPN); }
    else { rt = (int)(L / NPN); pn = (int)(L % NPN); }
    return rt < NT;
}
struct MoeUpSched {
    static constexpr bool GATHER = true;
    MoeTab T; const char* H; const char* Wg; const char* Wu; LAS int* rowtab; int G, c;
    __device__ __forceinline__ bool next(int i, GU& u) const {
        int rt, pn; if (!moe_unit(i, G, c, T.NT, 8, rt, pn)) return false;
        const int e = T.rte[rt];
        u.a0 = H; u.a1 = H; u.b0 = Wg + ((size_t)e * 1024 + pn * 128) * 2048; u.b1 = Wu + ((size_t)e * 1024 + pn * 128) * 2048;
        u.p0 = rt * 256; u.p1 = pn * 128; u.p2 = e; u.p3 = 0; return true;
    }
    __device__ __forceinline__ const LAS int* rows(int i) const { return rowtab + i * 256; }
};
struct MoeDownSched {
    static constexpr bool GATHER = false;
    MoeTab T; const char* A; const char* Wd; int G, c;
    __device__ __forceinline__ bool next(int i, GU& u) const {
        int rt, pn; if (!moe_unit(i, G, c, T.NT, 4, rt, pn)) return false;
        const int e = T.rte[rt];
        u.a0 = A + (size_t)rt * 256 * 2048; u.a1 = u.a0 + (size_t)128 * 2048; u.b0 = Wd + ((size_t)e * 1024 + pn * 256) * 2048; u.b1 = u.b0 + (size_t)128 * 2048;
        u.p0 = rt * 256; u.p1 = pn * 256; u.p2 = e; u.p3 = 0; return true;
    }
    __device__ __forceinline__ const LAS int* rows(int) const { return nullptr; }
};
__device__ __forceinline__ void moe_up(const Frame& F, const Args& a, int layer) {
    const MoeTab T = moe_tables(F, layer); const int* MLIST = (const int*)(F.ws + WS_MLIST);
    LAS int* rowtab = (LAS int*)(F.lds + LDS_AUX);
    for (int i = 0; i < 18; ++i) { int rt, pn; if (!moe_unit(i, F.G, F.bid, T.NT, 8, rt, pn)) break;
        const int e = T.rte[rt], tile = rt - T.tb[e], cnt = T.cnt[e];
        if (F.tid < 256) { const int pos = tile * 256 + F.tid; rowtab[i * 256 + F.tid] = pos < cnt ? MLIST[(size_t)e * NTOK + pos] : 0; } }
    __syncthreads();
    const bf16_t* W = (const bf16_t*)(F.ws + WS_MOEW); const size_t L = (size_t)NEXP * 1024 * 1024;
    MoeUpSched S{T, (const char*)(F.ws + WS_H), (const char*)W, (const char*)(W + L), rowtab, F.G, F.bid};
    EpiSwiglu E{a.in[I_BG] + (size_t)layer * NEXP * 1024, a.in[I_BU] + (size_t)layer * NEXP * 1024, (bf16_t*)(F.ws + RA_ACT)};
    g8::gemm_run<EpiSwiglu, MoeUpSched>(F.lds, 1024, 2048u, 2048u, S, E);
}
__device__ __forceinline__ void moe_down(const Frame& F, const Args& a, int layer) {
    const MoeTab T = moe_tables(F, layer);
    const bf16_t* W = (const bf16_t*)(F.ws + WS_MOEW); const size_t L = (size_t)NEXP * 1024 * 1024;
    MoeDownSched S{T, (const char*)(F.ws + RA_ACT), (const char*)(W + 2 * L), F.G, F.bid};
    EpiDown E{a.in[I_BD] + (size_t)layer * NEXP * 1024, (bf16_t*)(F.ws + RB_YS)};
    g8::gemm_run<EpiDown, MoeDownSched>(F.lds, 1024, 2048u, 2048u, S, E);
}
__device__ __forceinline__ void moe_combine(const Frame& F, const Args& a, int layer, float* __restrict__ r) {
    const MoeTab T = moe_tables(F, layer);
    const bf16_t* YS = (const bf16_t*)(F.ws + RB_YS); const int* TOKEP = (const int*)(F.ws + WS_TOKEP); const float* TOKG = (const float*)(F.ws + WS_TOKG); bf16_t* H = (bf16_t*)(F.ws + WS_H);
    const float* gain = a.in[I_NPLE] + layer * 1024; const int lane = F.lane;
    f32x4 gv[2][2];
#pragma unroll
    for (int c = 0; c < 2; ++c) { gv[c][0] = *(const f32x4*)(gain + c * 512 + lane * 8); gv[c][1] = *(const f32x4*)(gain + c * 512 + lane * 8 + 4); }
    for (int tok = F.gw; tok < NTOK; tok += F.GW) {
        int slot[4]; float gt[4];
#pragma unroll
        for (int k = 0; k < 4; ++k) { const int v = TOKEP[(size_t)tok * 4 + k]; slot[k] = T.tb[v >> 20] * 256 + (v & 0xfffff); gt[k] = TOKG[(size_t)tok * 4 + k]; }
        f32x4 v[2][2]; float ss = 0.f;
#pragma unroll
        for (int c = 0; c < 2; ++c) { const size_t o = (size_t)tok * 1024 + c * 512 + lane * 8; v[c][0] = *(const f32x4*)(r + o); v[c][1] = *(const f32x4*)(r + o + 4);
#pragma unroll
            for (int k = 0; k < 4; ++k) { const u32x4 y = *(const u32x4*)(YS + (size_t)slot[k] * 1024 + c * 512 + lane * 8);
                v[c][0][0] += gt[k] * bf_lo(y.x); v[c][0][1] += gt[k] * bf_hi(y.x); v[c][0][2] += gt[k] * bf_lo(y.y); v[c][0][3] += gt[k] * bf_hi(y.y);
                v[c][1][0] += gt[k] * bf_lo(y.z); v[c][1][1] += gt[k] * bf_hi(y.z); v[c][1][2] += gt[k] * bf_lo(y.w); v[c][1][3] += gt[k] * bf_hi(y.w); }
            *(f32x4*)(r + o) = v[c][0]; *(f32x4*)(r + o + 4) = v[c][1];
#pragma unroll
            for (int q = 0; q < 2; ++q) ss += v[c][q][0] * v[c][q][0] + v[c][q][1] * v[c][q][1] + v[c][q][2] * v[c][q][2] + v[c][q][3] * v[c][q][3]; }
        ss = wave_sum(ss); const float rstd = rsqrtf(ss * (1.0f / 1024.0f) + RMS_EPS);
#pragma unroll
        for (int c = 0; c < 2; ++c) { const f32x4 y0 = v[c][0] * rstd * gv[c][0], y1 = v[c][1] * rstd * gv[c][1];
            u32x4 w; w.x = cvt_pk_bf16(y0[0], y0[1]); w.y = cvt_pk_bf16(y0[2], y0[3]); w.z = cvt_pk_bf16(y1[0], y1[1]); w.w = cvt_pk_bf16(y1[2], y1[3]);
            *(u32x4*)(H + (size_t)tok * 1024 + c * 512 + lane * 8) = w; }
    }
}

constexpr int N_PHASES = 22;
#ifndef DBG_NPH
#define DBG_NPH 22
#endif
#ifndef MK_ONE_LAUNCH
#define MK_ONE_LAUNCH 1
#endif

__device__ __forceinline__ void moe_ple_phases(const Frame& F, const Args& a, int layer, int ph, float* out) {
    if (ph == 0) moe_router(F, a, layer, out);
    else if (ph == 1) moe_up(F, a, layer);
    else if (ph == 2) moe_down(F, a, layer);
    else if (ph == 3) {
        g8::DenseSched S{(const char*)(F.ws + WS_PB) + (size_t)layer * NTOK * PLE * 2, (const char*)(F.ws + WS_WPLE) + (size_t)layer * 1024 * PLE * 2, 512u, 512u, 128, 4, F.G, F.bid};
        EpiStoreBf16 E{(bf16_t*)(F.ws + RA_PROJ), 1024, 1.0f};
        g8::gemm_run<EpiStoreBf16, g8::DenseSched>(F.lds, 256, 512u, 512u, S, E);
        moe_combine(F, a, layer, out);
    } else {
        g8::DenseSched S{(const char*)(F.ws + WS_H), (const char*)(F.ws + WS_WPLEG) + (size_t)layer * 1024 * 1024 * 2, 2048u, 2048u, 128, 4, F.G, F.bid};
        EpiPle E{(const bf16_t*)(F.ws + RA_PROJ), out};
        g8::gemm_run<EpiPle, g8::DenseSched>(F.lds, 1024, 2048u, 2048u, S, E);
    }
}

__global__ void __launch_bounds__(512, 2) fwd(Args a) {
    extern __shared__ __attribute__((aligned(16))) unsigned char lds_raw[];
    Frame F;
    F.lds = (LAS unsigned char*)lds_raw; F.tid = threadIdx.x; F.lane = F.tid & 63; F.wave = __builtin_amdgcn_readfirstlane(F.tid >> 6);
    F.G = gridDim.x; F.bid = blockIdx.x; F.gw = F.bid * 8 + F.wave; F.GW = F.G * 8; F.ws = a.ws; F.ctl = (unsigned*)(a.ws + WS_CTL);
    volatile LAS unsigned* misc = (volatile LAS unsigned*)(F.lds + LDS_MISC);
    if (F.tid < 16) misc[F.tid] = 0u;
    __syncthreads();
    XcdBarrier bar; bar.bar = F.ctl + CW_BAR; bar.x = 0; bar.st = misc;
    const int lo = a.ph_lo, hi = a.ph_hi;
    if (hi - lo > 1) bar = xcd_barrier_post(F.ctl + CW_BAR, misc);
#define IN(k) (lo <= (k) && (k) < hi)
#define SEAM(k) do { if (IN(k) && IN((k) + 1)) xcd_barrier(bar); } while (0)
    float* out = a.out;

    if (IN(0)) { p0_prologue(F, a); } SEAM(0);
    if (IN(1)) {
        { g8::DenseSched S{(const char*)(F.ws + WS_H), (const char*)(F.ws + WS_WINAB), 2048u, 2048u, 128, 6, F.G, F.bid};
          EpiInAB E{(bf16_t*)(F.ws + RA_A2), (bf16_t*)(F.ws + RA_Q0), (bf16_t*)(F.ws + RA_K0)};
          g8::gemm_run<EpiInAB, g8::DenseSched>(F.lds, 1024, 2048u, 2048u, S, E); }
        { g8::DenseSched S{(const char*)(F.ws + WS_WINAB) + (size_t)1536 * 2048, (const char*)(F.ws + WS_H), 2048u, 2048u, 2, 128, F.G, F.bid};
          EpiStoreBf16 E{(bf16_t*)(F.ws + RA_VT0), (size_t)NTOK, 1.0f};
          g8::gemm_run<EpiStoreBf16, g8::DenseSched>(F.lds, 1024, 2048u, 2048u, S, E); }
    } SEAM(1);
    if (IN(2)) {
        { g8::BatchSched S{(const char*)(F.ws + RA_A2), (const char*)(F.ws + WS_WBT), 1280u, 1024u, (size_t)1024 * 1280, (size_t)256 * 1024, 4, 1, NGRP, F.G, F.bid};
          EpiS E{(float*)(F.ws + RA_SS)};
          g8::gemm_run<EpiS, g8::BatchSched>(F.lds, 512, 1280u, 1024u, S, E); }
        moba_kmean(F);
    } SEAM(2);
    if (IN(3)) { s5_scan(F, a); moba_gate(F); } SEAM(3);
    if (IN(4)) {
        { g8::BatchSched S{(const char*)(F.ws + RA_A2), (const char*)(F.ws + WS_MY), 1280u, 1280u, (size_t)1024 * 1280, (size_t)512 * 1280, 4, 2, NGRP, F.G, F.bid};
          EpiY E{(bf16_t*)(F.ws + RA_Z)};
          g8::gemm_run<EpiY, g8::BatchSched>(F.lds, 640, 1280u, 1280u, S, E); }
        moba_attn(F, a);
    } SEAM(4);
    if (IN(5)) {
        { g8::DenseSched S{(const char*)(F.ws + RA_Z), (const char*)(F.ws + WS_GLU), 1024u, 1024u, 128, 2, F.G, F.bid};
          EpiGlu E{(const bf16_t*)(F.ws + RA_Z), a.in[I_GLUB], (bf16_t*)(F.ws + RB_YCAT)};
          g8::gemm_run<EpiGlu, g8::DenseSched>(F.lds, 512, 1024u, 1024u, S, E); }
        moba_combine(F);
    } SEAM(5);
    if (IN(6)) {
        g8::DenseSched S{(const char*)(F.ws + RB_YCAT), (const char*)(F.ws + WS_WOUTAB), 2048u, 2048u, 128, 4, F.G, F.bid};
        EpiRes E{a.in[I_X], out};
        g8::gemm_run<EpiRes, g8::DenseSched>(F.lds, 1024, 2048u, 2048u, S, E);
    } SEAM(6);
    if (IN(7)) moe_ple_phases(F, a, 0, 0, out); SEAM(7);
    if (IN(8)) moe_ple_phases(F, a, 0, 1, out); SEAM(8);
    if (IN(9)) moe_ple_phases(F, a, 0, 2, out); SEAM(9);
    if (IN(10)) moe_ple_phases(F, a, 0, 3, out); SEAM(10);
    if (IN(11)) moe_ple_phases(F, a, 0, 4, out); SEAM(11);
    if (IN(12)) { rmsnorm_rows<false>(F, out, a.in[I_NMIX] + 1024, (bf16_t*)(F.ws + WS_H), nullptr, NTOK); conv_moe_weights(F, a, 1); } SEAM(12);
    if (IN(13)) {
        { g8::DenseSched S{(const char*)(F.ws + WS_H), (const char*)(F.ws + WS_WINC), 2048u, 2048u, 128, 8, F.G, F.bid};
          EpiInC E{(bf16_t*)(F.ws + RA_Q1), (bf16_t*)(F.ws + RA_K1)};
          g8::gemm_run<EpiInC, g8::DenseSched>(F.lds, 1024, 2048u, 2048u, S, E); }
        { g8::DenseSched S{(const char*)(F.ws + WS_WINC) + (size_t)2048 * 2048, (const char*)(F.ws + WS_H), 2048u, 2048u, 4, 128, F.G, F.bid};
          EpiStoreBf16 E{(bf16_t*)(F.ws + RA_VT1), (size_t)NTOK, 1.0f};
          g8::gemm_run<EpiStoreBf16, g8::DenseSched>(F.lds, 1024, 2048u, 2048u, S, E); }
    } SEAM(13);
#ifdef DBG_NOSB
    if (IN(14)) { const bf16_t* Qd = (const bf16_t*)(F.ws + RA_Q1); bf16_t* Yd = (bf16_t*)(F.ws + RB_Y1); for (size_t i = ((size_t)F.bid * 512 + F.tid) * 8; i < (size_t)NTOK * 1024; i += (size_t)F.G * 512 * 8) *(u32x4*)(Yd + i) = *(const u32x4*)(Qd + i); } SEAM(14);
#else
    if (IN(14)) sb_attn(F); SEAM(14);
#endif
    if (IN(15)) {
        g8::DenseSched S{(const char*)(F.ws + RB_Y1), (const char*)(F.ws + WS_WOUTC), 2048u, 2048u, 128, 4, F.G, F.bid};
        EpiRes E{out, out};
        g8::gemm_run<EpiRes, g8::DenseSched>(F.lds, 1024, 2048u, 2048u, S, E);
    } SEAM(15);
    if (IN(16)) moe_ple_phases(F, a, 1, 0, out); SEAM(16);
    if (IN(17)) moe_ple_phases(F, a, 1, 1, out); SEAM(17);
    if (IN(18)) moe_ple_phases(F, a, 1, 2, out); SEAM(18);
    if (IN(19)) moe_ple_phases(F, a, 1, 3, out); SEAM(19);
    if (IN(20)) moe_ple_phases(F, a, 1, 4, out); SEAM(20);
    if (IN(21)) rmsnorm_rows<true>(F, out, a.in[I_NFINAL], nullptr, out, NTOK);
#undef IN
#undef SEAM
}

extern "C" void kernel_launch(void* const* d_in, const int* in_sizes, int n_in, void* d_out, int out_size, void* d_ws, size_t ws_size, hipStream_t stream) {
    static int grid = 0;
    if (grid == 0) {
        if (n_in != 31 || out_size != NTOK * DM || ws_size < WS_END) { fprintf(stderr, "kernel_launch: unexpected shapes (n_in %d, out %d, ws %zu < %zu)\n", n_in, out_size, ws_size, (size_t)WS_END); grid = -1; return; }
        int dev = 0, cus = 0, per_cu = 0;
        if (hipGetDevice(&dev) != hipSuccess || hipDeviceGetAttribute(&cus, hipDeviceAttributeMultiprocessorCount, dev) != hipSuccess) { grid = -1; return; }
        if (hipFuncSetAttribute((const void*)fwd, hipFuncAttributeMaxDynamicSharedMemorySize, LDS_BYTES) != hipSuccess) { fprintf(stderr, "kernel_launch: hipFuncSetAttribute failed\n"); grid = -1; return; }
        if (hipOccupancyMaxActiveBlocksPerMultiprocessor(&per_cu, (const void*)fwd, 512, LDS_BYTES) != hipSuccess || per_cu < 1) fprintf(stderr, "kernel_launch: occupancy query says %d\n", per_cu);
        (void)hipGetLastError();
        grid = cus;
        if (grid != 256) fprintf(stderr, "kernel_launch: %d CUs (built for 256)\n", grid);
    }
    if (grid < 0) return;
    (void)hipMemsetAsync((char*)d_ws + WS_CTL, 0, 1 * MiB, stream);
    Args a{};
    for (int i = 0; i < 31; ++i) a.in[i] = (const float*)d_in[i];
    a.out = (float*)d_out; a.ws = (unsigned char*)d_ws;
    for (int n = 0; n < 128; ++n) { int bk; if (n < 16) bk = n; else { bk = 16 + (int)(std::log((double)n / 16.0) / std::log(8.0) * 16.0); if (bk > 31) bk = 31; } a.btab[n] = (unsigned char)bk; }
#if MK_ONE_LAUNCH
    a.ph_lo = 0; a.ph_hi = N_PHASES;
    hipLaunchKernelGGL(fwd, dim3(grid), dim3(512), LDS_BYTES, stream, a);
#else
    for (int p = 0; p < DBG_NPH; ++p) { a.ph_lo = p; a.ph_hi = p + 1; hipLaunchKernelGGL(fwd, dim3(grid), dim3(512), LDS_BYTES, stream, a); }
#endif
}
```

```cpp
#include <hip/hip_runtime.h>
#include <cstdio>
#include <cstdint>
#include <cmath>

#define LAS __attribute__((address_space(3)))
typedef unsigned short bf16_t;
typedef short bf16x8 __attribute__((ext_vector_type(8)));
typedef short bf16x4 __attribute__((ext_vector_type(4)));
typedef float f32x4 __attribute__((ext_vector_type(4)));
typedef float f32x2 __attribute__((ext_vector_type(2)));
typedef float f32x16 __attribute__((ext_vector_type(16)));
typedef unsigned u32x4 __attribute__((ext_vector_type(4)));
typedef unsigned u32x2 __attribute__((ext_vector_type(2)));

constexpr int NTOK = 32768, DM = 1024, SEQ = 4096, NBATCH = 8, PLE = 256;
constexpr int SSMW = 512, NGRP = 32, GH = 16, NST = 64, TCH = 32, NCH = SEQ / TCH  , A2LD = 640;
constexpr int MOBW = 512, MH = 8, MBLK = 256, NMB = 16;
constexpr int NEXP = 32;
constexpr float RMS_EPS = 1e-6f;
constexpr float LOG2E = 1.4426950408889634f;
constexpr float QSCALE = 0.125f * LOG2E;
constexpr float SB_THR = 150.0f;

constexpr size_t MiB = (size_t)1 << 20;
constexpr size_t WS_CTL = 0;
constexpr size_t WS_WINAB = 1 * MiB;
constexpr size_t WS_GLU = WS_WINAB + 4 * MiB;
constexpr size_t WS_WOUTAB = WS_GLU + MiB / 2;
constexpr size_t WS_WINC = WS_WOUTAB + 2 * MiB;
constexpr size_t WS_WOUTC = WS_WINC + 6 * MiB;
constexpr size_t WS_WPLE = WS_WOUTC + 2 * MiB;
constexpr size_t WS_WPLEG = WS_WPLE + 1 * MiB;
constexpr size_t WS_WBT = WS_WPLEG + 4 * MiB;
constexpr size_t WS_MY = WS_WBT + 8 * MiB;
constexpr size_t WS_MOEW = WS_MY + 20 * MiB;
constexpr size_t WS_H = WS_MOEW + 192 * MiB;
constexpr size_t WS_PB = WS_H + 64 * MiB;
constexpr size_t WS_MLIST = WS_PB + 32 * MiB;
constexpr size_t WS_TOKEP = WS_MLIST + 4 * MiB;
constexpr size_t WS_TOKG = WS_TOKEP + MiB / 2;
constexpr size_t WS_RA = WS_TOKG + MiB / 2;
constexpr size_t WS_RB = WS_RA + 272 * MiB;
constexpr size_t WS_END = WS_RB + 272 * MiB;
constexpr size_t RA_A2 = WS_RA;
constexpr size_t RA_Q0 = RA_A2 + 40 * MiB;
constexpr size_t RA_K0 = RA_Q0 + 32 * MiB;
constexpr size_t RA_VT0 = RA_K0 + 32 * MiB;
constexpr size_t RA_Z = RA_VT0 + 32 * MiB;
constexpr size_t RA_SS = RA_Z + 32 * MiB;
constexpr size_t RA_Q1 = WS_RA;
constexpr size_t RA_K1 = RA_Q1 + 64 * MiB;
constexpr size_t RA_VT1 = RA_K1 + 64 * MiB;
constexpr size_t RA_ACT = WS_RA;
constexpr size_t RA_PROJ = WS_RA;
constexpr size_t RB_PARTO = WS_RB;
constexpr size_t RB_PARTML = RB_PARTO + 128 * MiB;
constexpr size_t RB_MOBALIST = RB_PARTML + 8 * MiB;
constexpr size_t RB_KMEAN = RB_MOBALIST + 16 * MiB;
constexpr size_t RB_YCAT = RB_KMEAN + 1 * MiB;
constexpr size_t RB_Y1 = WS_RB;
constexpr size_t RB_YS = WS_RB;
constexpr int CW_BAR = 0;
constexpr int CW_GCNT = 4096;
constexpr int CW_MOBACNT = 8192;

constexpr int LDS_BYTES = 155648;
constexpr int LDS_AUX = 131072;
constexpr int LDS_MISC = 155648 - 64;

typedef __bf16 bf16x2_t __attribute__((ext_vector_type(2)));
__device__ __forceinline__ unsigned cvt_pk_bf16(float lo, float hi) { const f32x2 v = {lo, hi}; return __builtin_bit_cast(unsigned, __builtin_convertvector(v, bf16x2_t)); }
__device__ __forceinline__ bf16_t f2bf(float x) { return (bf16_t)(cvt_pk_bf16(x, 0.f) & 0xffffu); }
__device__ __forceinline__ float bf_lo(unsigned w) { return __uint_as_float(w << 16); }
__device__ __forceinline__ float bf_hi(unsigned w) { return __uint_as_float(w & 0xffff0000u); }
__device__ __forceinline__ float ex2(float x) { return __builtin_amdgcn_exp2f(x); }
__device__ __forceinline__ float lg2(float x) { return __builtin_amdgcn_logf(x); }
__device__ __forceinline__ float rcp(float x) { return __builtin_amdgcn_rcpf(x); }
__device__ __forceinline__ float sigmoidf_(float x) { return rcp(1.0f + ex2(-LOG2E * x)); }
__device__ __forceinline__ float wave_sum(float v) { v += __shfl_xor(v, 32); v += __shfl_xor(v, 16); v += __shfl_xor(v, 8); v += __shfl_xor(v, 4); v += __shfl_xor(v, 2); v += __shfl_xor(v, 1); return v; }
__device__ __forceinline__ f32x16 mfma32(bf16x8 a, bf16x8 b, f32x16 c) { return __builtin_amdgcn_mfma_f32_32x32x16_bf16(a, b, c, 0, 0, 0); }

#define XB_TMO      128
#define XB_XCNT(j)  (256  + 64 * (j))
#define XB_XSUB(j)  (1280 + 64 * (j))
#define XB_XGEN(j)  (2304 + 64 * (j))
#define XB_TOP      3328
#define XB_TOPGEN   3392
#define XCD_BAR_WORDS 3456
#define XB_SPIN_CAP (1u << 18)
__device__ __forceinline__ unsigned xb_ld(unsigned* p)              { return __hip_atomic_load(p, __ATOMIC_RELAXED, __HIP_MEMORY_SCOPE_AGENT); }
__device__ __forceinline__ unsigned xb_add(unsigned* p, unsigned v) { return __hip_atomic_fetch_add(p, v, __ATOMIC_RELAXED, __HIP_MEMORY_SCOPE_AGENT); }
__device__ __forceinline__ unsigned xb_xcc_id() { return (unsigned)__builtin_amdgcn_s_getreg((3 << 11) | 20) & 0xFu; }
#define XB_SPIN(cond, bar) do { unsigned _sp = 0; while (cond) { __builtin_amdgcn_s_sleep(1); \
    if ((++_sp & 255u) == 0u) { if (xb_ld(&(bar)[XB_TMO])) break; if (_sp > XB_SPIN_CAP) { atomicAdd(&(bar)[XB_TMO], 1u); break; } } } } while (0)
struct XcdBarrier { unsigned* bar; unsigned x; volatile LAS unsigned* st; };
__device__ __forceinline__ XcdBarrier xcd_barrier_post(unsigned* bar, volatile LAS unsigned* st) {
    XcdBarrier b; b.bar = bar; b.x = xb_xcc_id(); b.st = st;
    if (threadIdx.x == 0) (void)xb_add(&bar[XB_XCNT(b.x)], 1u);
    return b;
}
__device__ __forceinline__ void xcd_barrier_complete(unsigned* bar, unsigned x, unsigned& nloc, unsigned& nx) {
    const unsigned G = gridDim.x * gridDim.y * gridDim.z;
    unsigned sum, cnt, mine, sp = 0u;
    for (;;) {
        sum = 0u; cnt = 0u; mine = 0u;
#pragma unroll
        for (unsigned j = 0; j < 16; ++j) { const unsigned c = xb_ld(&bar[XB_XCNT(j)]); sum += c; cnt += (c > 0u) ? 1u : 0u; mine = (j == x) ? c : mine; }
        if (sum == G) break;
        __builtin_amdgcn_s_sleep(1);
        if ((++sp & 255u) == 0u) { if (xb_ld(&bar[XB_TMO])) break; if (sp > XB_SPIN_CAP) { atomicAdd(&bar[XB_TMO], 1u); break; } }
    }
    nloc = mine > 0u ? mine : 1u; nx = cnt > 0u ? cnt : 1u;
}
__device__ __forceinline__ void xcd_barrier(const XcdBarrier& b) {
    asm volatile("s_waitcnt vmcnt(0)" ::: "memory");
    __syncthreads();
    if (threadIdx.x == 0) {
        unsigned* bar = b.bar;
        __builtin_amdgcn_s_waitcnt(0);
        unsigned nloc = b.st[0], nx = b.st[1];
        if (nloc == 0u) { xcd_barrier_complete(bar, b.x, nloc, nx); b.st[0] = nloc; b.st[1] = nx; }
        const unsigned old = xb_add(&bar[XB_XSUB(b.x)], 1u);
        const unsigned gen = old / nloc;
        if (old + 1u == (gen + 1u) * nloc) {
            __builtin_amdgcn_fence(__ATOMIC_RELEASE, "agent");
            asm volatile("s_waitcnt vmcnt(0)" ::: "memory");
            const unsigned og = xb_add(&bar[XB_TOP], 1u);
            const unsigned tg = og / nx;
            if (og + 1u == (tg + 1u) * nx) xb_add(&bar[XB_TOPGEN], 1u);
            else XB_SPIN(xb_ld(&bar[XB_TOPGEN]) == tg, bar);
            __builtin_amdgcn_fence(__ATOMIC_ACQUIRE, "agent");
            xb_add(&bar[XB_XGEN(b.x)], 1u);
            asm volatile("s_waitcnt vmcnt(0)" ::: "memory");
        } else {
            XB_SPIN(xb_ld(&bar[XB_XGEN(b.x)]) == gen, bar);
            __builtin_amdgcn_fence(__ATOMIC_ACQUIRE, "agent");
            asm volatile("s_waitcnt vmcnt(0)" ::: "memory");
        }
    }
    __syncthreads();
}

namespace g8 {
constexpr int BM = 256, BK = 64, HALF = 128, HTB = HALF * BK * 2, STAGE_BYTES = 8 * HTB, NXCD = 8, WGM = 8;
__host__ __device__ __forceinline__ int lds_byte(int r, int c) { const int st = (r >> 4) * 2 + (c >> 5), rr = r & 15, cc = c & 31, ob = rr * 64 + cc * 2; return st * 1024 + (ob ^ (((ob >> 9) & 1) << 5)); }
__host__ __device__ __forceinline__ void stage_rc(int b, int& R, int& C) { const int st = b / 1024, sb = b % 1024, swz = sb ^ (((sb >> 9) & 1) << 5); R = (st >> 1) * 16 + swz / 64; C = (st & 1) * 32 + (swz % 64) / 2; }
__host__ __device__ __forceinline__ int perm32(int rho) { const int n = rho >> 4, i = rho & 15; return 8 * (i >> 2) + 4 * n + (i & 3); }

struct GU { const char *a0, *a1, *b0, *b1; int p0, p1, p2, p3; };

__device__ __forceinline__ bool static_tile(int i, int G, int c, int nM, int nN, int& pm, int& pn) {
    const int nwg = nM * nN; const long L = (long)i * G + c; if (L >= nwg) return false;
    int wgid = (int)L; { const int q = nwg / NXCD, r = nwg % NXCD, xcd = wgid % NXCD, off = wgid / NXCD; wgid = (xcd < r ? xcd * (q + 1) : r * (q + 1) + (xcd - r) * q) + off; }
    const int nig = WGM * nN, gid = wgid / nig, fm = gid * WGM, gsz = (nM - fm) < WGM ? (nM - fm) : WGM;
    pm = fm + ((wgid % nig) % gsz); pn = (wgid % nig) / gsz; return true;
}
struct DenseSched {
    const char* A; const char* B; unsigned lda2, ldb2; int nM, nN, G, c;
    static constexpr bool GATHER = false;
    __device__ __forceinline__ bool next(int i, GU& u) const {
        int pm, pn; if (!static_tile(i, G, c, nM, nN, pm, pn)) return false;
        u.a0 = A + (size_t)pm * 256 * lda2; u.a1 = u.a0 + (size_t)128 * lda2; u.b0 = B + (size_t)pn * 256 * ldb2; u.b1 = u.b0 + (size_t)128 * ldb2;
        u.p0 = pm; u.p1 = pn; u.p2 = 0; u.p3 = 0; return true;
    }
    __device__ __forceinline__ const LAS int* rows(int) const { return nullptr; }
};
struct BatchSched {
    const char* A; const char* B; unsigned lda2, ldb2; size_t sA, sB; int nM, nN, nb, G, c;
    static constexpr bool GATHER = false;
    __device__ __forceinline__ bool next(int i, GU& u) const {
        const long L = (long)i * G + c; const int per = nM * nN; if (L >= (long)per * nb) return false;
        const int g = (int)(L / per), rem = (int)(L % per), pm = rem / nN, pn = rem % nN;
        u.a0 = A + (size_t)g * sA + (size_t)pm * 256 * lda2; u.a1 = u.a0 + (size_t)128 * lda2; u.b0 = B + (size_t)g * sB + (size_t)pn * 256 * ldb2; u.b1 = u.b0 + (size_t)128 * ldb2;
        u.p0 = pm; u.p1 = pn; u.p2 = g; u.p3 = 0; return true;
    }
    __device__ __forceinline__ const LAS int* rows(int) const { return nullptr; }
};

#define G8_WAIT_V(n) asm volatile("s_waitcnt vmcnt(" #n ")" ::: "memory")
#define G8_WAIT_L(n) asm volatile("s_waitcnt lgkmcnt(" #n ")" ::: "memory")
#define G8_BAR __builtin_amdgcn_s_barrier()
#define G8_SCHED __builtin_amdgcn_sched_barrier(0)

template <class Epi, class Sched>
__device__ __forceinline__ void gemm_run(LAS unsigned char* lds, const int K, const unsigned lda2, const unsigned ldb2, const Sched& S, const Epi& E) {
    constexpr bool GATHER = Sched::GATHER;
    const int tid = threadIdx.x, wid = __builtin_amdgcn_readfirstlane(tid >> 6), lane = tid & 63, wr = wid >> 2, wc = wid & 3, fr = lane & 15, fq = lane >> 4;
    const int nt = K / BK;
    int sR[2], sC[2];
    unsigned voffB[2], vc[2][2], vn[2][2];
#pragma unroll
    for (int i = 0; i < 2; ++i) { stage_rc(tid * 16 + i * 8192, sR[i], sC[i]); const int Rb = Epi::PERM ? ((sR[i] & ~31) + perm32(sR[i] & 31)) : sR[i];
        voffB[i] = (unsigned)Rb * ldb2 + (unsigned)sC[i] * 2u; vc[0][i] = vc[1][i] = vn[0][i] = vn[1][i] = (unsigned)sR[i] * lda2 + (unsigned)sC[i] * 2u; }
    const size_t kstep = (size_t)(BK * 2);
    const unsigned ldsw = (unsigned)wid * 1024u;
    const int aoff = lds_byte(wr * 64 + fr, fq * 8), boff = lds_byte(wc * 32 + fr, fq * 8);
#define G8_SA(b, h) (((b) * 2 + (h)) * HTB)
#define G8_SB(b, h) ((4 + (b) * 2 + (h)) * HTB)
#define G8_STAGE(bufoff, gbase, v0, v1) do { \
        __builtin_amdgcn_global_load_lds((const unsigned*)((const char*)(gbase) + (v0)), (LAS unsigned*)(lds + (bufoff) + ldsw), 16, 0, 0); \
        __builtin_amdgcn_global_load_lds((const unsigned*)((const char*)(gbase) + (v1)), (LAS unsigned*)(lds + (bufoff) + ldsw + 8192), 16, 0, 0); } while (0)
#define G8_LDA(dst, b, h) do { _Pragma("unroll") for (int m = 0; m < 4; ++m) _Pragma("unroll") for (int k = 0; k < 2; ++k) dst[m][k] = *(const LAS bf16x8*)(lds + G8_SA(b, h) + aoff + m * 2048 + k * 1024); } while (0)
#define G8_LDB(dst, b, h) do { _Pragma("unroll") for (int n = 0; n < 2; ++n) _Pragma("unroll") for (int k = 0; k < 2; ++k) dst[n][k] = *(const LAS bf16x8*)(lds + G8_SB(b, h) + boff + n * 2048 + k * 1024); } while (0)
#define G8_MMA(ai, bj, At, Bt) do { __builtin_amdgcn_s_setprio(1); _Pragma("unroll") for (int m = 0; m < 4; ++m) _Pragma("unroll") for (int n = 0; n < 2; ++n) _Pragma("unroll") for (int k = 0; k < 2; ++k) \
        acc[ai][bj][m][n] = __builtin_amdgcn_mfma_f32_16x16x32_bf16(Bt[n][k], At[m][k], acc[ai][bj][m][n], 0, 0, 0); __builtin_amdgcn_s_setprio(0); } while (0)
    GU cur, nxt; int ui = 0;
    if (!S.next(0, cur)) return;
    if constexpr (GATHER) { const LAS int* rw = S.rows(0);
#pragma unroll
        for (int h = 0; h < 2; ++h)
#pragma unroll
            for (int i = 0; i < 2; ++i) vc[h][i] = (unsigned)rw[h * 128 + sR[i]] * lda2 + (unsigned)sC[i] * 2u; }
    f32x4 acc[2][2][4][2];
#pragma unroll
    for (int a = 0; a < 2; ++a)
#pragma unroll
        for (int b = 0; b < 2; ++b)
#pragma unroll
            for (int m = 0; m < 4; ++m)
#pragma unroll
                for (int n = 0; n < 2; ++n) acc[a][b][m][n] = (f32x4){0.f, 0.f, 0.f, 0.f};
    bf16x8 At[4][2], B0[2][2], B1[2][2];
    const char* cA0 = cur.a0; const char* cA1 = cur.a1; const char* cB0 = cur.b0; const char* cB1 = cur.b1;
    G8_STAGE(G8_SB(0, 0), cB0, voffB[0], voffB[1]); G8_STAGE(G8_SA(0, 0), cA0, vc[0][0], vc[0][1]); G8_STAGE(G8_SB(0, 1), cB1, voffB[0], voffB[1]); G8_STAGE(G8_SA(0, 1), cA1, vc[1][0], vc[1][1]);
    if (wr == 1) G8_BAR;
    G8_WAIT_V(4); G8_BAR;
    G8_STAGE(G8_SB(1, 0), cB0 + kstep, voffB[0], voffB[1]); G8_STAGE(G8_SA(1, 0), cA0 + kstep, vc[0][0], vc[0][1]); G8_STAGE(G8_SB(1, 1), cB1 + kstep, voffB[0], voffB[1]);
    G8_WAIT_V(6); G8_BAR;
    for (;;) {
        const bool has_next = S.next(ui + 1, nxt);
        const char* nA0 = has_next ? nxt.a0 : cA0; const char* nA1 = has_next ? nxt.a1 : cA1; const char* nB0 = has_next ? nxt.b0 : cB0; const char* nB1 = has_next ? nxt.b1 : cB1;
        if constexpr (GATHER) {
            if (has_next) { const LAS int* rw = S.rows(ui + 1);
#pragma unroll
                for (int h = 0; h < 2; ++h)
#pragma unroll
                    for (int i = 0; i < 2; ++i) vn[h][i] = (unsigned)rw[h * 128 + sR[i]] * lda2 + (unsigned)sC[i] * 2u; }
            else {
#pragma unroll
                for (int h = 0; h < 2; ++h)
#pragma unroll
                    for (int i = 0; i < 2; ++i) vn[h][i] = vc[h][i]; }
        }
        for (int t = 0; t < nt; t += 2) {
            const bool last = (t == nt - 2);
            const char* a1_1 = cA1 + (size_t)(t + 1) * kstep;
            const char* a2_0 = last ? nA0 : cA0 + (size_t)(t + 2) * kstep; const char* a2_1 = last ? nA1 : cA1 + (size_t)(t + 2) * kstep;
            const char* b2_0 = last ? nB0 : cB0 + (size_t)(t + 2) * kstep; const char* b2_1 = last ? nB1 : cB1 + (size_t)(t + 2) * kstep;
            unsigned w00 = vc[0][0], w01 = vc[0][1], w10 = vc[1][0], w11 = vc[1][1];
            if constexpr (GATHER) { if (last) { w00 = vn[0][0]; w01 = vn[0][1]; w10 = vn[1][0]; w11 = vn[1][1]; } }
            G8_LDB(B0, 0, 0); G8_SCHED; G8_LDA(At, 0, 0); G8_STAGE(G8_SA(1, 1), a1_1, vc[1][0], vc[1][1]);
            G8_WAIT_L(8); G8_BAR; G8_WAIT_L(0); G8_MMA(0, 0, At, B0); G8_BAR; G8_SCHED;
            G8_LDB(B1, 0, 1); G8_STAGE(G8_SB(0, 0), b2_0, voffB[0], voffB[1]);
            G8_BAR; G8_WAIT_L(0); G8_MMA(0, 1, At, B1); G8_BAR;
            G8_LDA(At, 0, 1); G8_STAGE(G8_SA(0, 0), a2_0, w00, w01);
            G8_BAR; G8_WAIT_L(0); G8_MMA(1, 0, At, B0); G8_BAR; G8_SCHED;
            G8_STAGE(G8_SB(0, 1), b2_1, voffB[0], voffB[1]);
            G8_WAIT_V(6); G8_BAR; G8_MMA(1, 1, At, B1); G8_BAR;
            G8_LDB(B0, 1, 0); G8_SCHED; G8_LDA(At, 1, 0); G8_STAGE(G8_SA(0, 1), a2_1, w10, w11);
            G8_WAIT_L(8); G8_BAR; G8_WAIT_L(0); G8_MMA(0, 0, At, B0); G8_BAR; G8_SCHED;
            G8_LDB(B1, 1, 1); G8_STAGE(G8_SB(1, 0), b2_0 + kstep, voffB[0], voffB[1]);
            G8_BAR; G8_WAIT_L(0); G8_MMA(0, 1, At, B1); G8_BAR;
            G8_LDA(At, 1, 1); G8_STAGE(G8_SA(1, 0), a2_0 + kstep, w00, w01);
            G8_BAR; G8_WAIT_L(0); G8_MMA(1, 0, At, B0); G8_BAR; G8_SCHED;
            G8_STAGE(G8_SB(1, 1), b2_1 + kstep, voffB[0], voffB[1]);
            G8_WAIT_V(6); G8_BAR; G8_MMA(1, 1, At, B1); G8_BAR;
        }
        E(acc, cur, wr, wc, fr, fq);
        if (!has_next) break;
#pragma unroll
        for (int a = 0; a < 2; ++a)
#pragma unroll
            for (int b = 0; b < 2; ++b)
#pragma unroll
                for (int m = 0; m < 4; ++m)
#pragma unroll
                    for (int n = 0; n < 2; ++n) acc[a][b][m][n] = (f32x4){0.f, 0.f, 0.f, 0.f};
        cur = nxt; cA0 = nA0; cA1 = nA1; cB0 = nB0; cB1 = nB1; ++ui;
        if constexpr (GATHER) {
#pragma unroll
            for (int h = 0; h < 2; ++h)
#pragma unroll
                for (int i = 0; i < 2; ++i) vc[h][i] = vn[h][i]; }
    }
    G8_WAIT_V(0);
    if (wr == 0) G8_BAR;
    G8_BAR;
#undef G8_SA
#undef G8_SB
#undef G8_STAGE
#undef G8_LDA
#undef G8_LDB
#undef G8_MMA
}
}
using g8::GU;

#define EPI_ARGS const f32x4 (&acc)[2][2][4][2], const GU& u, int wr, int wc, int fr, int fq

__device__ __forceinline__ size_t qk_tile_off(int b, int h, int t, int NH) { return ((size_t)(b * NH + h) * 128 + (t >> 5)) * 2048 + (size_t)(t & 31) * 8; }
__device__ __forceinline__ size_t v_tile_off(int b, int h, int tile, int NH) { return ((size_t)(b * NH + h) * 128 + tile) * 2048; }
struct EpiVt {
    static constexpr bool PERM = true;
    bf16_t* V; int NH;
    __device__ __forceinline__ void operator()(EPI_ARGS) const {
        const int row0 = u.p0 * 256 + wr * 64 + fr, col0 = u.p1 * 256 + wc * 32 + 8 * fq;
#pragma unroll
        for (int ai = 0; ai < 2; ++ai)
#pragma unroll
            for (int m = 0; m < 4; ++m) { const int feat = row0 + ai * 128 + m * 16, h = feat >> 6, d = feat & 63, db = d >> 5, r = d & 31;
#pragma unroll
                for (int bj = 0; bj < 2; ++bj) { const int col = col0 + bj * 128, b = col >> 12, t = col & 4095, mm = (t & 31) >> 3, sI = mm >> 1, jg = mm & 1;
                    const f32x4 v0 = acc[ai][bj][m][0], v1 = acc[ai][bj][m][1];
                    bf16_t* p = V + v_tile_off(b, h, t >> 5, NH) + (size_t)((((db * 2 + sI) * 2) * 32 + r) * 8 + jg * 4);
                    u32x2 w0, w1; w0.x = cvt_pk_bf16(v0[0], v0[1]); w0.y = cvt_pk_bf16(v0[2], v0[3]); w1.x = cvt_pk_bf16(v1[0], v1[1]); w1.y = cvt_pk_bf16(v1[2], v1[3]);
                    *(u32x2*)p = w0; *(u32x2*)(p + 256) = w1; } }
    }
};

struct EpiStoreBf16 {
    static constexpr bool PERM = true;
    bf16_t* O; size_t ld; float scale;
    __device__ __forceinline__ void operator()(EPI_ARGS) const {
        const int row0 = u.p0 * 256 + wr * 64 + fr, col0 = u.p1 * 256 + wc * 32 + 8 * fq;
#pragma unroll
        for (int ai = 0; ai < 2; ++ai)
#pragma unroll
            for (int m = 0; m < 4; ++m) { bf16_t* rowp = O + (size_t)(row0 + ai * 128 + m * 16) * ld + col0;
#pragma unroll
                for (int bj = 0; bj < 2; ++bj) { const f32x4 v0 = acc[ai][bj][m][0] * scale, v1 = acc[ai][bj][m][1] * scale;
                    u32x4 w; w.x = cvt_pk_bf16(v0[0], v0[1]); w.y = cvt_pk_bf16(v0[2], v0[3]); w.z = cvt_pk_bf16(v1[0], v1[1]); w.w = cvt_pk_bf16(v1[2], v1[3]);
                    *(u32x4*)(rowp + bj * 128) = w; } }
    }
};
struct EpiInAB {
    static constexpr bool PERM = true;
    bf16_t* A2; bf16_t* Q; bf16_t* Kk;
    __device__ __forceinline__ void operator()(EPI_ARGS) const {
        const int row0 = u.p0 * 256 + wr * 64 + fr, colt = u.p1 * 256 + wc * 32 + 8 * fq; const int kind = u.p1 >> 1;
        const float sc = (kind == 1) ? QSCALE : 1.0f;
#pragma unroll
        for (int ai = 0; ai < 2; ++ai)
#pragma unroll
            for (int m = 0; m < 4; ++m) { const int row = row0 + ai * 128 + m * 16;
#pragma unroll
                for (int bj = 0; bj < 2; ++bj) { const f32x4 v0 = acc[ai][bj][m][0] * sc, v1 = acc[ai][bj][m][1] * sc; const int col = colt + bj * 128;
                    u32x4 w; w.x = cvt_pk_bf16(v0[0], v0[1]); w.y = cvt_pk_bf16(v0[2], v0[3]); w.z = cvt_pk_bf16(v1[0], v1[1]); w.w = cvt_pk_bf16(v1[2], v1[3]);
                    bf16_t* p;
                    if (kind == 0) { const int g = col >> 4, hp = col & 15, b = row >> 12, l = row & 4095; p = A2 + ((size_t)(g * 1024 + b * NCH + (l >> 5)) * A2LD + (l & 31) * 16 + hp); }
                    else { const int cc = col - (kind == 1 ? 512 : 1024); p = (kind == 1 ? Q : Kk) + qk_tile_off(row >> 12, cc >> 6, row & 4095, 8) + (size_t)((cc & 63) >> 3) * 256; }
                    *(u32x4*)p = w; } }
    }
};
struct EpiInC {
    static constexpr bool PERM = true;
    bf16_t* Q; bf16_t* Kk;
    __device__ __forceinline__ void operator()(EPI_ARGS) const {
        const int row0 = u.p0 * 256 + wr * 64 + fr; const bool isq = u.p1 < 4; const int col0 = (u.p1 & 3) * 256 + wc * 32 + 8 * fq;
        const float sc = isq ? QSCALE : 1.0f; bf16_t* base = isq ? Q : Kk;
#pragma unroll
        for (int ai = 0; ai < 2; ++ai)
#pragma unroll
            for (int m = 0; m < 4; ++m) { const int row = row0 + ai * 128 + m * 16;
#pragma unroll
                for (int bj = 0; bj < 2; ++bj) { const f32x4 v0 = acc[ai][bj][m][0] * sc, v1 = acc[ai][bj][m][1] * sc; const int col = col0 + bj * 128;
                    u32x4 w; w.x = cvt_pk_bf16(v0[0], v0[1]); w.y = cvt_pk_bf16(v0[2], v0[3]); w.z = cvt_pk_bf16(v1[0], v1[1]); w.w = cvt_pk_bf16(v1[2], v1[3]);
                    *(u32x4*)(base + qk_tile_off(row >> 12, col >> 6, row & 4095, 16) + (size_t)((col & 63) >> 3) * 256) = w; } }
    }
};
struct EpiS {
    static constexpr bool PERM = false;
    float* S;
    __device__ __forceinline__ void operator()(EPI_ARGS) const {
        const int row0 = u.p0 * 256 + wr * 64 + fr, col0 = wc * 32 + 4 * fq; float* base = S + (size_t)u.p2 * 1024 * 128;
#pragma unroll
        for (int ai = 0; ai < 2; ++ai)
#pragma unroll
            for (int m = 0; m < 4; ++m) { float* rowp = base + (size_t)(row0 + ai * 128 + m * 16) * 128 + col0;
#pragma unroll
                for (int n = 0; n < 2; ++n) *(f32x4*)(rowp + n * 16) = acc[ai][0][m][n]; }
    }
};
__device__ __forceinline__ float gelu_tanh(float x) { const float a = 0.7978845608f * (x + 0.044715f * x * x * x); return x * rcp(1.0f + ex2(-2.0f * LOG2E * a)); }
struct EpiY {
    static constexpr bool PERM = true;
    bf16_t* Z;
    __device__ __forceinline__ void operator()(EPI_ARGS) const {
        const int row0 = u.p0 * 256 + wr * 64 + fr, col0 = u.p1 * 256 + wc * 32 + 8 * fq, g = u.p2;
#pragma unroll
        for (int ai = 0; ai < 2; ++ai)
#pragma unroll
            for (int m = 0; m < 4; ++m) { const int row = row0 + ai * 128 + m * 16, b = row >> 7, ch = row & 127;
#pragma unroll
                for (int bj = 0; bj < 2; ++bj) { const int col = col0 + bj * 128, t = col >> 4, h = col & 15; const f32x4 v0 = acc[ai][bj][m][0], v1 = acc[ai][bj][m][1];
                    u32x4 w; w.x = cvt_pk_bf16(gelu_tanh(v0[0]), gelu_tanh(v0[1])); w.y = cvt_pk_bf16(gelu_tanh(v0[2]), gelu_tanh(v0[3]));
                    w.z = cvt_pk_bf16(gelu_tanh(v1[0]), gelu_tanh(v1[1])); w.w = cvt_pk_bf16(gelu_tanh(v1[2]), gelu_tanh(v1[3]));
                    *(u32x4*)(Z + (size_t)(b * SEQ + ch * TCH + t) * 512 + g * 16 + h) = w; } }
    }
};
struct EpiGlu {
    static constexpr bool PERM = true;
    const bf16_t* Z; const float* bias; bf16_t* Y;
    __device__ __forceinline__ void operator()(EPI_ARGS) const {
        const int row0 = u.p0 * 256 + wr * 64 + fr, col0 = u.p1 * 256 + wc * 32 + 8 * fq;
#pragma unroll
        for (int bj = 0; bj < 2; ++bj) { const int col = col0 + bj * 128; const f32x4 b0 = *(const f32x4*)(bias + col), b1 = *(const f32x4*)(bias + col + 4);
#pragma unroll
            for (int ai = 0; ai < 2; ++ai)
#pragma unroll
                for (int m = 0; m < 4; ++m) { const int row = row0 + ai * 128 + m * 16; const u32x4 zz = *(const u32x4*)(Z + (size_t)row * 512 + col);
                    const f32x4 v0 = acc[ai][bj][m][0] + b0, v1 = acc[ai][bj][m][1] + b1;
                    u32x4 w; w.x = cvt_pk_bf16(bf_lo(zz.x) * sigmoidf_(v0[0]), bf_hi(zz.x) * sigmoidf_(v0[1])); w.y = cvt_pk_bf16(bf_lo(zz.y) * sigmoidf_(v0[2]), bf_hi(zz.y) * sigmoidf_(v0[3]));
                    w.z = cvt_pk_bf16(bf_lo(zz.z) * sigmoidf_(v1[0]), bf_hi(zz.z) * sigmoidf_(v1[1])); w.w = cvt_pk_bf16(bf_lo(zz.w) * sigmoidf_(v1[2]), bf_hi(zz.w) * sigmoidf_(v1[3]));
                    *(u32x4*)(Y + (size_t)row * 1024 + col) = w; } }
    }
};
struct EpiRes {
    static constexpr bool PERM = false;
    const float* res; float* out;
    __device__ __forceinline__ void operator()(EPI_ARGS) const {
        const int row0 = u.p0 * 256 + wr * 64 + fr, col0 = u.p1 * 256 + wc * 32 + 4 * fq;
#pragma unroll
        for (int ai = 0; ai < 2; ++ai)
#pragma unroll
            for (int m = 0; m < 4; ++m) { const size_t ro = (size_t)(row0 + ai * 128 + m * 16) * 1024 + col0;
#pragma unroll
                for (int bj = 0; bj < 2; ++bj)
#pragma unroll
                    for (int n = 0; n < 2; ++n) { const size_t o = ro + bj * 128 + n * 16; *(f32x4*)(out + o) = *(const f32x4*)(res + o) + acc[ai][bj][m][n]; } }
    }
};
struct EpiSwiglu {
    static constexpr bool PERM = true;
    const float* bg; const float* bu; bf16_t* act;
    __device__ __forceinline__ void operator()(EPI_ARGS) const {
        const int row0 = u.p0 + wr * 64 + fr, col = u.p1 + wc * 32 + 8 * fq; const float* pg = bg + (size_t)u.p2 * 1024 + col; const float* pu = bu + (size_t)u.p2 * 1024 + col;
        const f32x4 g0 = *(const f32x4*)pg, g1 = *(const f32x4*)(pg + 4), u0 = *(const f32x4*)pu, u1 = *(const f32x4*)(pu + 4);
#pragma unroll
        for (int ai = 0; ai < 2; ++ai)
#pragma unroll
            for (int m = 0; m < 4; ++m) { float r[8];
#pragma unroll
                for (int n = 0; n < 2; ++n)
#pragma unroll
                    for (int j = 0; j < 4; ++j) { const float gg = fminf(acc[ai][0][m][n][j] + (n ? g1[j] : g0[j]), 7.0f); const float uu = fminf(fmaxf(acc[ai][1][m][n][j] + (n ? u1[j] : u0[j]), -7.0f), 7.0f);
                        r[n * 4 + j] = gg * sigmoidf_(1.702f * gg) * (uu + 1.0f); }
                u32x4 w; w.x = cvt_pk_bf16(r[0], r[1]); w.y = cvt_pk_bf16(r[2], r[3]); w.z = cvt_pk_bf16(r[4], r[5]); w.w = cvt_pk_bf16(r[6], r[7]);
                *(u32x4*)(act + (size_t)(row0 + ai * 128 + m * 16) * 1024 + col) = w; }
    }
};
struct EpiDown {
    static constexpr bool PERM = true;
    const float* bd; bf16_t* ys;
    __device__ __forceinline__ void operator()(EPI_ARGS) const {
        const int row0 = u.p0 + wr * 64 + fr, col0 = u.p1 + wc * 32 + 8 * fq;
#pragma unroll
        for (int bj = 0; bj < 2; ++bj) { const int col = col0 + bj * 128; const float* pb = bd + (size_t)u.p2 * 1024 + col; const f32x4 b0 = *(const f32x4*)pb, b1 = *(const f32x4*)(pb + 4);
#pragma unroll
            for (int ai = 0; ai < 2; ++ai)
#pragma unroll
                for (int m = 0; m < 4; ++m) { const f32x4 v0 = acc[ai][bj][m][0] + b0, v1 = acc[ai][bj][m][1] + b1;
                    u32x4 w; w.x = cvt_pk_bf16(v0[0], v0[1]); w.y = cvt_pk_bf16(v0[2], v0[3]); w.z = cvt_pk_bf16(v1[0], v1[1]); w.w = cvt_pk_bf16(v1[2], v1[3]);
                    *(u32x4*)(ys + (size_t)(row0 + ai * 128 + m * 16) * 1024 + col) = w; } }
    }
};
struct EpiPle {
    static constexpr bool PERM = true;
    const bf16_t* proj; float* r;
    __device__ __forceinline__ void operator()(EPI_ARGS) const {
        const int row0 = u.p0 * 256 + wr * 64 + fr, col0 = u.p1 * 256 + wc * 32 + 8 * fq;
#pragma unroll
        for (int ai = 0; ai < 2; ++ai)
#pragma unroll
            for (int m = 0; m < 4; ++m) { const size_t ro = (size_t)(row0 + ai * 128 + m * 16) * 1024 + col0;
#pragma unroll
                for (int bj = 0; bj < 2; ++bj) { const size_t o = ro + bj * 128; const u32x4 pp = *(const u32x4*)(proj + o); const f32x4 r0 = *(const f32x4*)(r + o), r1 = *(const f32x4*)(r + o + 4);
                    const f32x4 v0 = acc[ai][bj][m][0], v1 = acc[ai][bj][m][1];
                    f32x4 o0, o1;
                    o0[0] = r0[0] + bf_lo(pp.x) * sigmoidf_(v0[0]); o0[1] = r0[1] + bf_hi(pp.x) * sigmoidf_(v0[1]); o0[2] = r0[2] + bf_lo(pp.y) * sigmoidf_(v0[2]); o0[3] = r0[3] + bf_hi(pp.y) * sigmoidf_(v0[3]);
                    o1[0] = r1[0] + bf_lo(pp.z) * sigmoidf_(v1[0]); o1[1] = r1[1] + bf_hi(pp.z) * sigmoidf_(v1[1]); o1[2] = r1[2] + bf_lo(pp.w) * sigmoidf_(v1[2]); o1[3] = r1[3] + bf_hi(pp.w) * sigmoidf_(v1[3]);
                    *(f32x4*)(r + o) = o0; *(f32x4*)(r + o + 4) = o1; } }
    }
};

struct Args { const float* in[31]; float* out; unsigned char* ws; int ph_lo, ph_hi; unsigned char btab[128]; };
struct Frame {
    LAS unsigned char* lds; int tid, lane, wave, G, bid, gw, GW;
    unsigned char* ws; unsigned* ctl;
};
enum { I_X = 0, I_P, I_NMIX, I_NFFN, I_NPLE, I_NFINAL, I_WINAB, I_ARE, I_AIM, I_BRE, I_BIM, I_CRE, I_CIM, I_SSMD, I_LOGSTEP, I_GLUW, I_GLUB, I_WOUTAB, I_RELB, I_WINC, I_WOUTC,
       I_RW, I_RB, I_WG, I_BG, I_WU, I_BU, I_WD, I_BD, I_WPLE, I_WPLEG };

__device__ __forceinline__ void tconv(const Frame& F, const float* __restrict__ src, bf16_t* __restrict__ dst, int K, int N, int nmat) {
    LAS unsigned* T = (LAS unsigned*)(F.lds + F.wave * 8192);
    const int tk = K >> 6, tn = N >> 6; const long ntiles = (long)nmat * tk * tn;
    const int lane = F.lane, nq = lane & 15, kk = lane >> 4;
    for (long tt = F.gw; tt < ntiles; tt += F.GW) {
        const int mat = (int)(tt / (tk * tn)), rem = (int)(tt % (tk * tn)), kt = rem / tn, ntl = rem % tn;
        const float* s = src + (size_t)mat * K * N + (size_t)(kt * 64) * N + ntl * 64;
        bf16_t* d = dst + (size_t)mat * N * K + (size_t)(ntl * 64) * K + kt * 64;
#pragma unroll
        for (int it = 0; it < 8; ++it) { const int k0 = 8 * it + 2 * kk;
            const f32x4 a = *(const f32x4*)(s + (size_t)k0 * N + 4 * nq), b = *(const f32x4*)(s + (size_t)(k0 + 1) * N + 4 * nq);
#pragma unroll
            for (int j = 0; j < 4; ++j) { const int n = 4 * nq + j, kp = 4 * it + kk; T[32 * n + (kp ^ (4 * (nq & 7)))] = cvt_pk_bf16(a[j], b[j]); } }
        __builtin_amdgcn_fence(__ATOMIC_RELEASE, "wavefront"); __builtin_amdgcn_wave_barrier(); __builtin_amdgcn_fence(__ATOMIC_ACQUIRE, "wavefront");
#pragma unroll
        for (int it = 0; it < 8; ++it) { const int n = 8 * it + (lane >> 3), c = lane & 7;
            const u32x4 v = *(const LAS u32x4*)(T + 32 * n + 4 * (c ^ ((n >> 2) & 7)));
            *(u32x4*)(d + (size_t)n * K + 8 * c) = v; }
        __builtin_amdgcn_fence(__ATOMIC_RELEASE, "wavefront"); __builtin_amdgcn_wave_barrier(); __builtin_amdgcn_fence(__ATOMIC_ACQUIRE, "wavefront");
    }
}
__device__ __forceinline__ void conv_plain(const Frame& F, const float* __restrict__ src, bf16_t* __restrict__ dst, size_t n) {
    const size_t nth = (size_t)F.G * 512;
    for (size_t i = ((size_t)F.bid * 512 + F.tid) * 8; i < n; i += nth * 8) { const f32x4 a = *(const f32x4*)(src + i), b = *(const f32x4*)(src + i + 4);
        u32x4 w; w.x = cvt_pk_bf16(a[0], a[1]); w.y = cvt_pk_bf16(a[2], a[3]); w.z = cvt_pk_bf16(b[0], b[1]); w.w = cvt_pk_bf16(b[2], b[3]); *(u32x4*)(dst + i) = w; }
}
template <bool F32OUT>
__device__ __forceinline__ void rmsnorm_rows(const Frame& F, const float* __restrict__ src, const float* __restrict__ gain, bf16_t* __restrict__ dst, float* outf, int nrows) {
    const int lane = F.lane;
    f32x4 gv[4];
#pragma unroll
    for (int j = 0; j < 4; ++j) gv[j] = *(const f32x4*)(gain + 4 * (lane + 64 * j));
    for (int row = F.gw; row < nrows; row += F.GW) {
        const float* s = src + (size_t)row * 1024; f32x4 v[4]; float ss = 0.f;
#pragma unroll
        for (int j = 0; j < 4; ++j) { v[j] = *(const f32x4*)(s + 4 * (lane + 64 * j)); ss += v[j][0] * v[j][0] + v[j][1] * v[j][1] + v[j][2] * v[j][2] + v[j][3] * v[j][3]; }
        ss = wave_sum(ss); const float rstd = rsqrtf(ss * (1.0f / 1024.0f) + RMS_EPS);
#pragma unroll
        for (int j = 0; j < 4; ++j) { const f32x4 y = v[j] * rstd * gv[j];
            if (F32OUT) *(f32x4*)(outf + (size_t)row * 1024 + 4 * (lane + 64 * j)) = y;
            else { u32x2 w; w.x = cvt_pk_bf16(y[0], y[1]); w.y = cvt_pk_bf16(y[2], y[3]); *(u32x2*)(dst + (size_t)row * 1024 + 4 * (lane + 64 * j)) = w; } }
    }
}

__device__ __forceinline__ void s5_matrices(const Frame& F, const Args& a) {
    LAS float* Pr = (LAS float*)F.lds;
    LAS float* Pi = Pr + 33 * 64;
    LAS float* Br = Pi + 33 * 64;
    LAS float* Bi = Br + 1024;
    LAS float* Cr = Bi + 1024;
    LAS float* Ci = Cr + 1024;
    LAS float* Kf = Ci + 1024;
    LAS float* coefr = Kf + 8192; LAS float* coefi = coefr + 64;
    bf16_t* WbT = (bf16_t*)(F.ws + WS_WBT); bf16_t* My = (bf16_t*)(F.ws + WS_MY);
    const int t = F.tid;
    for (int g = F.bid; g < NGRP; g += F.G) {
        __syncthreads();
        if (t < 64) { const int n = t; const float are = a.in[I_ARE][g * 64 + n], aim = a.in[I_AIM][g * 64 + n], step = __expf(a.in[I_LOGSTEP][g]);
            for (int d = 0; d <= 32; ++d) { const float mag = __expf(are * step * (float)d); float rev = aim * step * (float)d * 0.15915494309189535f; rev -= rintf(rev);
                Pr[d * 64 + n] = mag * __builtin_amdgcn_cosf(rev); Pi[d * 64 + n] = mag * __builtin_amdgcn_sinf(rev); }
            const float lr = Pr[64 + n] - 1.0f, li = Pi[64 + n], den = 1.0f / (are * are + aim * aim);
            coefr[n] = (lr * are + li * aim) * den; coefi[n] = (li * are - lr * aim) * den; }
        __syncthreads();
        for (int idx = t; idx < 1024; idx += 512) { const int n = idx >> 4; const float br = a.in[I_BRE][g * 1024 + idx], bi = a.in[I_BIM][g * 1024 + idx];
            Br[idx] = coefr[n] * br - coefi[n] * bi; Bi[idx] = coefr[n] * bi + coefi[n] * br;
            Cr[idx] = a.in[I_CRE][g * 1024 + idx]; Ci[idx] = a.in[I_CIM][g * 1024 + idx]; }
        __syncthreads();
        { const int hh = t & 255, h = hh >> 4, hp = hh & 15;
          for (int d = t >> 8; d < 32; d += 2) { float s = 0.f;
              for (int n = 0; n < 64; ++n) { const float cr = Cr[h * 64 + n], ci = Ci[h * 64 + n], pr = Pr[d * 64 + n], pi = Pi[d * 64 + n];
                  const float mr = cr * pr - ci * pi, mi = cr * pi + ci * pr; s += mr * Br[n * 16 + hp] - mi * Bi[n * 16 + hp]; }
              if (d == 0 && h == hp) s += a.in[I_SSMD][g * 16 + h];
              Kf[d * 256 + hh] = s; } }
        __syncthreads();
        for (int ch = t; ch < 256 * 64; ch += 512) { const int row = ch >> 6, k0 = (ch & 63) * 8, s = k0 >> 4, hp0 = k0 & 15; float v[8];
            if (row < 128) { const int n = row & 63; const float pr = Pr[(31 - s) * 64 + n], pi = Pi[(31 - s) * 64 + n];
#pragma unroll
                for (int j = 0; j < 8; ++j) { const float br = Br[n * 16 + hp0 + j], bi = Bi[n * 16 + hp0 + j]; v[j] = (row < 64) ? (pr * br - pi * bi) : (pr * bi + pi * br); } }
            else {
#pragma unroll
                for (int j = 0; j < 8; ++j) v[j] = 0.f; }
            u32x4 w; w.x = cvt_pk_bf16(v[0], v[1]); w.y = cvt_pk_bf16(v[2], v[3]); w.z = cvt_pk_bf16(v[4], v[5]); w.w = cvt_pk_bf16(v[6], v[7]);
            *(u32x4*)(WbT + ((size_t)g * 256 + row) * 512 + k0) = w; }
        for (int ch = t; ch < 512 * 80; ch += 512) { const int row = ch / 80, k0 = (ch % 80) * 8, tt = row >> 4, h = row & 15; float v[8];
            if (k0 < 512) { const int s = k0 >> 4, hp0 = k0 & 15;
#pragma unroll
                for (int j = 0; j < 8; ++j) v[j] = (s <= tt) ? Kf[(tt - s) * 256 + h * 16 + hp0 + j] : 0.f; }
            else { const int n0 = (k0 - 512) & 63; const bool im = k0 >= 576;
#pragma unroll
                for (int j = 0; j < 8; ++j) { const int n = n0 + j; const float cr = Cr[h * 64 + n], ci = Ci[h * 64 + n], pr = Pr[(tt + 1) * 64 + n], pi = Pi[(tt + 1) * 64 + n];
                    v[j] = im ? -(cr * pi + ci * pr) : (cr * pr - ci * pi); } }
            u32x4 w; w.x = cvt_pk_bf16(v[0], v[1]); w.y = cvt_pk_bf16(v[2], v[3]); w.z = cvt_pk_bf16(v[4], v[5]); w.w = cvt_pk_bf16(v[6], v[7]);
            *(u32x4*)(My + ((size_t)g * 512 + row) * A2LD + k0) = w; }
    }
    __syncthreads();
}

__device__ __forceinline__ void conv_moe_weights(const Frame& F, const Args& a, int layer) {
    bf16_t* W = (bf16_t*)(F.ws + WS_MOEW); const size_t L = (size_t)NEXP * 1024 * 1024;
    tconv(F, a.in[I_WG] + layer * L, W, 1024, 1024, NEXP);
    tconv(F, a.in[I_WU] + layer * L, W + L, 1024, 1024, NEXP);
    tconv(F, a.in[I_WD] + layer * L, W + 2 * L, 1024, 1024, NEXP);
}

__device__ __forceinline__ void p0_prologue(const Frame& F, const Args& a) {
    s5_matrices(F, a);
    tconv(F, a.in[I_WINAB], (bf16_t*)(F.ws + WS_WINAB), 1024, 2048, 1);
    tconv(F, a.in[I_GLUW], (bf16_t*)(F.ws + WS_GLU), 512, 512, 1);
    tconv(F, a.in[I_WOUTAB], (bf16_t*)(F.ws + WS_WOUTAB), 1024, 1024, 1);
    tconv(F, a.in[I_WINC], (bf16_t*)(F.ws + WS_WINC), 1024, 3072, 1);
    tconv(F, a.in[I_WOUTC], (bf16_t*)(F.ws + WS_WOUTC), 1024, 1024, 1);
    tconv(F, a.in[I_WPLE], (bf16_t*)(F.ws + WS_WPLE), 256, 1024, 2);
    tconv(F, a.in[I_WPLEG], (bf16_t*)(F.ws + WS_WPLEG), 1024, 1024, 2);
    conv_moe_weights(F, a, 0);
    conv_plain(F, a.in[I_P], (bf16_t*)(F.ws + WS_PB), (size_t)2 * NTOK * PLE);
    rmsnorm_rows<false>(F, a.in[I_X], a.in[I_NMIX], (bf16_t*)(F.ws + WS_H), nullptr, NTOK);
}

__device__ __forceinline__ void s5_scan(const Frame& F, const Args& a) {
    const float* S = (const float*)(F.ws + RA_SS); bf16_t* A2 = (bf16_t*)(F.ws + RA_A2);
    const int n = F.lane;
    for (int item = F.gw; item < NGRP * NBATCH; item += F.GW) {
        const int g = item >> 3, b = item & 7;
        const float are = a.in[I_ARE][g * 64 + n], aim = a.in[I_AIM][g * 64 + n], step = __expf(a.in[I_LOGSTEP][g]);
        const float mag = __expf(are * step * 32.0f); float rev = aim * step * 32.0f * 0.15915494309189535f; rev -= rintf(rev);
        const float lr = mag * __builtin_amdgcn_cosf(rev), li = mag * __builtin_amdgcn_sinf(rev);
        float xr = 0.f, xi = 0.f;
        const float* sp = S + ((size_t)g * 1024 + b * NCH) * 128 + n; bf16_t* xp = A2 + ((size_t)g * 1024 + b * NCH) * A2LD + 512 + n;
        for (int c0 = 0; c0 < NCH; c0 += 16) {
            float sr[16], si[16];
#pragma unroll
            for (int j = 0; j < 16; ++j) { sr[j] = sp[(size_t)(c0 + j) * 128]; si[j] = sp[(size_t)(c0 + j) * 128 + 64]; }
#pragma unroll
            for (int j = 0; j < 16; ++j) { xp[(size_t)(c0 + j) * A2LD] = f2bf(xr); xp[(size_t)(c0 + j) * A2LD + 64] = f2bf(xi);
                const float nr = lr * xr - li * xi + sr[j], ni = lr * xi + li * xr + si[j]; xr = nr; xi = ni; }
        }
    }
}

__device__ __forceinline__ void moba_kmean(const Frame& F) {
    const bf16_t* Kk = (const bf16_t*)(F.ws + RA_K0); float* KM = (float*)(F.ws + RB_KMEAN);
    const int lane = F.lane;
    for (int item = F.gw; item < NBATCH * MH * NMB; item += F.GW) {
        const int j = item & 15, h = (item >> 4) & 7, b = item >> 7;
        const bf16_t* p = Kk + qk_tile_off(b, h, j * MBLK, 8) + (size_t)lane * 8;
        float s[4][8];
#pragma unroll
        for (int q = 0; q < 4; ++q)
#pragma unroll
            for (int i = 0; i < 8; ++i) s[q][i] = 0.f;
        for (int it4 = 0; it4 < 8; ++it4) {
#pragma unroll
            for (int q = 0; q < 4; ++q) { const u32x4 v = *(const u32x4*)(p + (size_t)(it4 * 4 + q) * 512);
                s[q][0] += bf_lo(v.x); s[q][1] += bf_hi(v.x); s[q][2] += bf_lo(v.y); s[q][3] += bf_hi(v.y); s[q][4] += bf_lo(v.z); s[q][5] += bf_hi(v.z); s[q][6] += bf_lo(v.w); s[q][7] += bf_hi(v.w); } }
#pragma unroll
        for (int q = 0; q < 4; ++q)
#pragma unroll
            for (int i = 0; i < 8; ++i) { float v = s[q][i]; v += __shfl_xor(v, 1); v += __shfl_xor(v, 2); v += __shfl_xor(v, 4); v += __shfl_xor(v, 8); v += __shfl_xor(v, 16); s[q][i] = v; }
        if ((lane & 31) == 0) { const int hf = lane >> 5;
#pragma unroll
            for (int q = 0; q < 4; ++q)
#pragma unroll
                for (int i = 0; i < 8; ++i) KM[(size_t)item * 64 + (hf + 2 * q) * 8 + i] = s[q][i] * (1.0f / 256.0f); }
    }
}
__device__ __forceinline__ void moba_gate(const Frame& F) {
    const bf16_t* Q = (const bf16_t*)(F.ws + RA_Q0); const float* KM = (const float*)(F.ws + RB_KMEAN); int* LIST = (int*)(F.ws + RB_MOBALIST); unsigned* CNT = F.ctl + CW_MOBACNT;
    const int t = F.tid, sub = t >> 8, tq = t & 255;
    LAS float* km = (LAS float*)F.lds + sub * 1024;
    LAS int* lcnt = (LAS int*)(F.lds + 8192) + sub * 32;
    const int nitem = NBATCH * MH * 15;
    for (int it0 = F.bid * 2; it0 < nitem; it0 += F.G * 2) {
        const int item = it0 + sub; const bool act = item < nitem;
        const int i = act ? 1 + item % 15 : 1, bh = act ? item / 15 : 0, b = bh >> 3, h = bh & 7;
        __syncthreads();
        for (int x = tq; x < i * 64; x += 256) km[x] = KM[(size_t)bh * 1024 + x];
        if (tq < 32) lcnt[tq] = 0;
        __syncthreads();
        int sel[3] = {0, 0, 0}, lpos[3] = {0, 0, 0}; const int nsel = i < 3 ? i : 3;
        if (act) {
            const bf16_t* qp = Q + qk_tile_off(b, h, i * MBLK + tq, 8); float qv[64];
#pragma unroll
            for (int c = 0; c < 8; ++c) { const u32x4 v = *(const u32x4*)(qp + c * 256); qv[c * 8 + 0] = bf_lo(v.x); qv[c * 8 + 1] = bf_hi(v.x); qv[c * 8 + 2] = bf_lo(v.y); qv[c * 8 + 3] = bf_hi(v.y);
                qv[c * 8 + 4] = bf_lo(v.z); qv[c * 8 + 5] = bf_hi(v.z); qv[c * 8 + 6] = bf_lo(v.w); qv[c * 8 + 7] = bf_hi(v.w); }
            float v0 = -3.0e38f, v1 = -3.0e38f, v2 = -3.0e38f; int i0 = 0, i1 = 0, i2 = 0;
            for (int j = 0; j < i; ++j) { float gsum = 0.f;
#pragma unroll
                for (int d = 0; d < 64; ++d) gsum += qv[d] * km[j * 64 + d];
                if (gsum > v0) { v2 = v1; i2 = i1; v1 = v0; i1 = i0; v0 = gsum; i0 = j; } else if (gsum > v1) { v2 = v1; i2 = i1; v1 = gsum; i1 = j; } else if (gsum > v2) { v2 = gsum; i2 = j; } }
            sel[0] = i0; sel[1] = i1; sel[2] = i2;
#pragma unroll
            for (int s = 0; s < 3; ++s) if (s < nsel) lpos[s] = atomicAdd((int*)&lcnt[sel[s]], 1);
        }
        __syncthreads();
        if (act && tq < 16 && lcnt[tq] > 0) lcnt[16 + tq] = (int)__hip_atomic_fetch_add(CNT + bh * 16 + tq, (unsigned)lcnt[tq], __ATOMIC_RELAXED, __HIP_MEMORY_SCOPE_AGENT);
        __syncthreads();
        if (act) {
#pragma unroll
            for (int s = 0; s < 3; ++s) if (s < nsel) LIST[((size_t)bh * 16 + sel[s]) * 4096 + lcnt[16 + sel[s]] + lpos[s]] = (i * MBLK + tq) | (s << 12); }
    }
    __syncthreads();
}

__device__ __forceinline__ void stage_o_rows(LAS unsigned char* wl, const f32x16& o0, const f32x16& o1, float sc, int r, int hf) {
#pragma unroll
    for (int g = 0; g < 4; ++g) { u32x2 w0, w1; w0.x = cvt_pk_bf16(o0[4 * g] * sc, o0[4 * g + 1] * sc); w0.y = cvt_pk_bf16(o0[4 * g + 2] * sc, o0[4 * g + 3] * sc);
        w1.x = cvt_pk_bf16(o1[4 * g] * sc, o1[4 * g + 1] * sc); w1.y = cvt_pk_bf16(o1[4 * g + 2] * sc, o1[4 * g + 3] * sc);
        *(LAS u32x2*)(wl + r * 128 + ((g ^ (r & 7)) << 4) + hf * 8) = w0; *(LAS u32x2*)(wl + r * 128 + (((4 + g) ^ (r & 7)) << 4) + hf * 8) = w1; }
    __builtin_amdgcn_fence(__ATOMIC_RELEASE, "wavefront"); __builtin_amdgcn_wave_barrier(); __builtin_amdgcn_fence(__ATOMIC_ACQUIRE, "wavefront");
}
__device__ __forceinline__ u32x4 read_o_row(const LAS unsigned char* wl, int q, int c) { return *(const LAS u32x4*)(wl + q * 128 + ((c ^ (q & 7)) << 4)); }
struct KFrag { bf16x8 f[4]; };
__device__ __forceinline__ KFrag load_kfrag(const bf16_t* kp) { KFrag k;
#pragma unroll
    for (int s = 0; s < 4; ++s) k.f[s] = *(const bf16x8*)(kp + 512 * s);
    return k; }
struct VFrag { bf16x8 f[2][2]; };
__device__ __forceinline__ VFrag load_vfrag(const bf16_t* vp) { VFrag v;
#pragma unroll
    for (int db = 0; db < 2; ++db)
#pragma unroll
        for (int s = 0; s < 2; ++s) v.f[db][s] = *(const bf16x8*)(vp + (db * 2 + s) * 512);
    return v; }
template <bool OWN>
__device__ __forceinline__ void moba_task(const bf16_t* __restrict__ Q, const bf16_t* __restrict__ Kk, const bf16_t* __restrict__ Vt, bf16_t* __restrict__ PO, float* __restrict__ PML,
                                          const LAS float* tab, LAS unsigned char* wl, int b, int h, int tq, bool valid, int slot, int key_base, int ntile, int tmin, int lane) {
    const int r = lane & 31, hf = lane >> 5; const size_t tokb = (size_t)b * SEQ;
    bf16x8 qf[4];
    { const bf16_t* qp = Q + qk_tile_off(b, h, tq, 8) + hf * 256;
#pragma unroll
      for (int s = 0; s < 4; ++s) qf[s] = *(const bf16x8*)(qp + 512 * s); }
    const bf16_t* kbase = Kk + qk_tile_off(b, h, key_base, 8) + hf * 256 + r * 8;
    const bf16_t* vbase = Vt + v_tile_off(b, h, key_base >> 5, 8) + hf * 256 + r * 8;
    KFrag k0 = load_kfrag(kbase);
    VFrag v0 = load_vfrag(vbase);
    f32x16 o0, o1;
#pragma unroll
    for (int i = 0; i < 16; ++i) { o0[i] = 0.f; o1[i] = 0.f; }
    float m = -1.0e30f, l = 0.f; const float b31 = tab[h * 128 + 127];
    for (int kt = 0; kt < ntile; ++kt) {
        const int key0 = key_base + 32 * kt;
        const int kn1 = (kt + 1 < ntile) ? kt + 1 : ntile - 1;
        const KFrag k1 = load_kfrag(kbase + (size_t)kn1 * 2048);
        const VFrag v1 = load_vfrag(vbase + (size_t)kn1 * 2048);
        f32x16 x;
#pragma unroll
        for (int i = 0; i < 16; ++i) x[i] = 0.f;
#pragma unroll
        for (int s = 0; s < 4; ++s) x = mfma32(k0.f[s], qf[s], x);
        if (tmin - (key0 + 31) < 113) {
#pragma unroll
            for (int i = 0; i < 16; ++i) { const int row = (i & 3) + 8 * (i >> 2) + 4 * hf; const int dist = tq - (key0 + row); const int idx = dist < 0 ? 0 : (dist > 127 ? 127 : dist);
                x[i] += tab[h * 128 + idx]; if (OWN && dist < 0) x[i] = -1.0e30f; }
        } else {
#pragma unroll
            for (int i = 0; i < 16; ++i) x[i] += b31;
        }
        float mx = x[0];
#pragma unroll
        for (int i = 1; i < 16; ++i) mx = fmaxf(mx, x[i]);
        mx = fmaxf(mx, __shfl_xor(mx, 32));
        const float mn = fmaxf(m, mx), alpha = ex2(m - mn); m = mn;
        float ps = 0.f; unsigned pw[8];
#pragma unroll
        for (int i = 0; i < 8; ++i) { const float p0 = ex2(x[2 * i] - mn), p1 = ex2(x[2 * i + 1] - mn); ps += p0 + p1; pw[i] = cvt_pk_bf16(p0, p1); }
        l = l * alpha + ps;
        o0 *= alpha; o1 *= alpha;
#pragma unroll
        for (int s = 0; s < 2; ++s) { u32x4 pf; pf.x = pw[4 * s]; pf.y = pw[4 * s + 1]; pf.z = pw[4 * s + 2]; pf.w = pw[4 * s + 3];
            const bf16x8 pb = __builtin_bit_cast(bf16x8, pf);
            o0 = mfma32(v0.f[0][s], pb, o0); o1 = mfma32(v0.f[1][s], pb, o1); }
        k0 = k1; v0 = v1;
    }
    l += __shfl_xor(l, 32);
    const int pi = valid ? (int)(((tokb + tq) * 8 + h) * 4 + slot) : -1;
    stage_o_rows(wl, o0, o1, 1.0f / l, r, hf);
#pragma unroll
    for (int it = 0; it < 4; ++it) { const int q = it * 8 + (lane >> 3), c = lane & 7; const int pq = __shfl(pi, q); const u32x4 v = read_o_row(wl, q, c);
        if (pq >= 0) *(u32x4*)(PO + (size_t)pq * 64 + c * 8) = v; }
    if (valid && hf == 0) { f32x2 ml; ml.x = m; ml.y = l; *(f32x2*)(PML + (size_t)pi * 2) = ml; }
    __builtin_amdgcn_fence(__ATOMIC_RELEASE, "wavefront"); __builtin_amdgcn_wave_barrier(); __builtin_amdgcn_fence(__ATOMIC_ACQUIRE, "wavefront");
}

__device__ __forceinline__ void moba_attn(const Frame& F, const Args& a) {
    const bf16_t* Q = (const bf16_t*)(F.ws + RA_Q0); const bf16_t* Kk = (const bf16_t*)(F.ws + RA_K0); const bf16_t* Vt = (const bf16_t*)(F.ws + RA_VT0);
    bf16_t* PO = (bf16_t*)(F.ws + RB_PARTO); float* PML = (float*)(F.ws + RB_PARTML); const int* LIST = (const int*)(F.ws + RB_MOBALIST); unsigned* CNT = F.ctl + CW_MOBACNT;
    LAS float* tab = (LAS float*)F.lds;
    LAS int* pre = (LAS int*)(F.lds + 4096);
    LAS int* cnts = (LAS int*)(F.lds + 4096 + 4128);
    LAS int* wsum = (LAS int*)(F.lds + 4096 + 4128 + 4096);
    LAS unsigned char* wl = F.lds + 16384 + F.wave * 4096;
    const int t = F.tid, lane = F.lane;
    __syncthreads();
    for (int x = t; x < 1024; x += 512) { const int hh = x >> 7, dd = x & 127; tab[x] = a.in[I_RELB][a.btab[dd] * 8 + hh] * LOG2E; }
    { const int c0 = (int)__hip_atomic_load(CNT + 2 * t, __ATOMIC_RELAXED, __HIP_MEMORY_SCOPE_AGENT), c1 = (int)__hip_atomic_load(CNT + 2 * t + 1, __ATOMIC_RELAXED, __HIP_MEMORY_SCOPE_AGENT);
      cnts[2 * t] = c0; cnts[2 * t + 1] = c1; const int t0 = (c0 + 31) >> 5, t1 = (c1 + 31) >> 5; int s = t0 + t1, inc = s;
#pragma unroll
      for (int o = 1; o < 64; o <<= 1) { const int v = __shfl_up(inc, o); if (lane >= o) inc += v; }
      if (lane == 63) wsum[F.wave] = inc;
      __syncthreads();
      int base = 0; for (int w = 0; w < F.wave; ++w) base += wsum[w];
      const int ex = base + inc - s; pre[2 * t] = ex; pre[2 * t + 1] = ex + t0; if (t == 511) pre[1024] = ex + s; }
    __syncthreads();
    const int nsel = pre[1024], ntask = nsel + NBATCH * MH * NMB * 8;
    for (int task = F.gw; task < ntask; task += F.GW) {
        if (task < nsel) {
            int lo = 0, hi = 1023;
            while (lo < hi) { const int mid = (lo + hi + 1) >> 1; if (pre[mid] <= task) lo = mid; else hi = mid - 1; }
            const int list = lo, chunk = task - pre[list], cnt = cnts[list], bh = list >> 4, j = list & 15;
            const int idx = chunk * 32 + (lane & 31); const bool valid = idx < cnt; const int e = valid ? LIST[(size_t)list * 4096 + idx] : 4095;
            const int tq = e & 4095, slot = valid ? (e >> 12) : 0; int tmin = tq;
#pragma unroll
            for (int o = 32; o >= 1; o >>= 1) tmin = min(tmin, __shfl_xor(tmin, o));
            moba_task<false>(Q, Kk, Vt, PO, PML, tab, wl, bh >> 3, bh & 7, tq, valid, slot, j * MBLK, 8, tmin, lane);
        } else {
            const int o = task - nsel, qg = o & 7, i = (o >> 3) & 15, bh = o >> 7; const int t0 = i * MBLK + 32 * qg;
            moba_task<true>(Q, Kk, Vt, PO, PML, tab, wl, bh >> 3, bh & 7, t0 + (lane & 31), true, 3, i * MBLK, qg + 1, t0, lane);
        }
    }
    __syncthreads();
}
__device__ __forceinline__ void moba_combine(const Frame& F) {
    const bf16_t* PO = (const bf16_t*)(F.ws + RB_PARTO); const float* PML = (const float*)(F.ws + RB_PARTML); bf16_t* Y = (bf16_t*)(F.ws + RB_YCAT);
    const int lane = F.lane, h = lane >> 3, dc = lane & 7;
    for (int tok = F.gw; tok < NTOK; tok += F.GW) {
        const int i = (tok & 4095) >> 8, nsel = i < 3 ? i : 3; const size_t pb = ((size_t)tok * 8 + h) * 4;
        float mm[4], ll[4]; float M = -3.0e38f;
#pragma unroll
        for (int s = 0; s < 4; ++s) { const bool v = (s == 3) || (s < nsel); if (v) { const f32x2 ml = *(const f32x2*)(PML + (pb + s) * 2); mm[s] = ml.x; ll[s] = ml.y; M = fmaxf(M, ml.x); } else { mm[s] = -3.0e38f; ll[s] = 0.f; } }
        float acc[8], den = 0.f;
#pragma unroll
        for (int j = 0; j < 8; ++j) acc[j] = 0.f;
#pragma unroll
        for (int s = 0; s < 4; ++s) { const bool v = (s == 3) || (s < nsel); if (v) { const float w = ll[s] * ex2(mm[s] - M); den += w; const u32x4 o = *(const u32x4*)(PO + (pb + s) * 64 + dc * 8);
            acc[0] += w * bf_lo(o.x); acc[1] += w * bf_hi(o.x); acc[2] += w * bf_lo(o.y); acc[3] += w * bf_hi(o.y); acc[4] += w * bf_lo(o.z); acc[5] += w * bf_hi(o.z); acc[6] += w * bf_lo(o.w); acc[7] += w * bf_hi(o.w); } }
        const float inv = 1.0f / den;
        u32x4 w; w.x = cvt_pk_bf16(acc[0] * inv, acc[1] * inv); w.y = cvt_pk_bf16(acc[2] * inv, acc[3] * inv); w.z = cvt_pk_bf16(acc[4] * inv, acc[5] * inv); w.w = cvt_pk_bf16(acc[6] * inv, acc[7] * inv);
        *(u32x4*)(Y + (size_t)tok * 1024 + 512 + h * 64 + dc * 8) = w;
    }
}

__device__ __forceinline__ void sb_attn(const Frame& F) {
    const bf16_t* Q = (const bf16_t*)(F.ws + RA_Q1); const bf16_t* Kk = (const bf16_t*)(F.ws + RA_K1); const bf16_t* Vt = (const bf16_t*)(F.ws + RA_VT1); bf16_t* Y = (bf16_t*)(F.ws + RB_Y1);
    const int lane = F.lane, r = lane & 31, hf = lane >> 5;
    LAS unsigned char* wl = F.lds + F.wave * 4096;
    bf16x8 tri[2];
#pragma unroll
    for (int s = 0; s < 2; ++s)
#pragma unroll
        for (int j = 0; j < 8; ++j) { const int kap = 16 * s + 8 * (j >> 2) + 4 * hf + (j & 3); tri[s][j] = (kap >= r) ? (short)0x3F80 : (short)0; }
    const int ntask = NBATCH * 16 * (SEQ / 32);
    for (int task = F.gw; task < ntask; task += F.GW) {
        const int qt = task & 127, head = (task >> 7) & 15, b = task >> 11; const int t0 = qt * 32; const size_t tokb = (size_t)b * SEQ;
        bf16x8 qf[4];
        { const bf16_t* qp = Q + qk_tile_off(b, head, t0, 16) + hf * 256 + r * 8;
#pragma unroll
          for (int s = 0; s < 4; ++s) qf[s] = *(const bf16x8*)(qp + 512 * s); }
        f32x16 o0, o1;
#pragma unroll
        for (int i = 0; i < 16; ++i) { o0[i] = 0.f; o1[i] = 0.f; }
        float carry = 0.f;
        const bf16_t* kbase = Kk + qk_tile_off(b, head, 0, 16) + hf * 256 + r * 8;
        const bf16_t* vbase = Vt + v_tile_off(b, head, 0, 16) + hf * 256 + r * 8;
        KFrag k0 = load_kfrag(kbase + (size_t)qt * 2048);
        VFrag v0 = load_vfrag(vbase + (size_t)qt * 2048);
        for (int key0 = t0; key0 >= 0; key0 -= 32) {
            const bool diag = (key0 == t0);
            const int kp1 = key0 >= 32 ? key0 - 32 : 0;
            const KFrag k1 = load_kfrag(kbase + (size_t)(kp1 >> 5) * 2048);
            const VFrag v1 = load_vfrag(vbase + (size_t)(kp1 >> 5) * 2048);
            f32x16 x;
#pragma unroll
            for (int i = 0; i < 16; ++i) x[i] = 0.f;
#pragma unroll
            for (int s = 0; s < 4; ++s) x = mfma32(k0.f[s], qf[s], x);
            float sp[16];
#pragma unroll
            for (int i = 0; i < 16; ++i) { const int row = (i & 3) + 8 * (i >> 2) + 4 * hf; const float zl = x[i];
                float v = fmaxf(zl, 0.f) + lg2(1.0f + ex2(-fabsf(zl))); if (diag && row >= r) v = 0.f; sp[i] = v; }
            unsigned hw[8], lw[8];
#pragma unroll
            for (int i = 0; i < 8; ++i) { hw[i] = cvt_pk_bf16(sp[2 * i], sp[2 * i + 1]); lw[i] = cvt_pk_bf16(sp[2 * i] - bf_lo(hw[i]), sp[2 * i + 1] - bf_hi(hw[i])); }
            f32x16 y;
#pragma unroll
            for (int i = 0; i < 16; ++i) y[i] = 0.f;
#pragma unroll
            for (int s = 0; s < 2; ++s) { u32x4 a, c; a.x = hw[4 * s]; a.y = hw[4 * s + 1]; a.z = hw[4 * s + 2]; a.w = hw[4 * s + 3]; c.x = lw[4 * s]; c.y = lw[4 * s + 1]; c.z = lw[4 * s + 2]; c.w = lw[4 * s + 3];
                y = mfma32(tri[s], __builtin_bit_cast(bf16x8, a), y); y = mfma32(tri[s], __builtin_bit_cast(bf16x8, c), y); }
            unsigned pw[8];
#pragma unroll
            for (int i = 0; i < 8; ++i) { const int i0 = 2 * i, i1 = 2 * i + 1; const int row0 = (i0 & 3) + 8 * (i0 >> 2) + 4 * hf, row1 = (i1 & 3) + 8 * (i1 >> 2) + 4 * hf;
                float w0 = ex2(x[i0] - y[i0] - carry), w1 = ex2(x[i1] - y[i1] - carry); if (diag && row0 >= r) w0 = 0.f; if (diag && row1 >= r) w1 = 0.f; pw[i] = cvt_pk_bf16(w0, w1); }
#pragma unroll
            for (int s = 0; s < 2; ++s) { u32x4 pf; pf.x = pw[4 * s]; pf.y = pw[4 * s + 1]; pf.z = pw[4 * s + 2]; pf.w = pw[4 * s + 3];
                const bf16x8 pb = __builtin_bit_cast(bf16x8, pf);
                o0 = mfma32(v0.f[0][s], pb, o0); o1 = mfma32(v0.f[1][s], pb, o1); }
            carry += __shfl(y[0], r);
            if (__all(carry >= SB_THR)) break;
            k0 = k1; v0 = v1;
        }
        stage_o_rows(wl, o0, o1, 1.0f, r, hf);
#pragma unroll
        for (int it = 0; it < 4; ++it) { const int q = it * 8 + (lane >> 3), c = lane & 7; *(u32x4*)(Y + (tokb + t0 + q) * 1024 + head * 64 + c * 8) = read_o_row(wl, q, c); }
        __builtin_amdgcn_fence(__ATOMIC_RELEASE, "wavefront"); __builtin_amdgcn_wave_barrier(); __builtin_amdgcn_fence(__ATOMIC_ACQUIRE, "wavefront");
    }
}

__device__ __forceinline__ void moe_router(const Frame& F, const Args& a, int layer, const float* __restrict__ r) {
    bf16_t* H = (bf16_t*)(F.ws + WS_H); int* MLIST = (int*)(F.ws + WS_MLIST); int* TOKEP = (int*)(F.ws + WS_TOKEP); float* TOKG = (float*)(F.ws + WS_TOKG); unsigned* GCNT = F.ctl + CW_GCNT + layer * 64;
    const float* rw = a.in[I_RW] + (size_t)layer * 1024 * 32; const float* rb = a.in[I_RB] + layer * 32; const float* gain = a.in[I_NFFN] + layer * 1024;
    LAS float* hs = (LAS float*)F.lds;
    LAS float* part = (LAS float*)(F.lds + 32768);
    LAS float* logit = (LAS float*)(F.lds + 49152);
    LAS int* lcnt = (LAS int*)(F.lds + 50176);
    LAS int* tinfo = (LAS int*)(F.lds + 50432);
    const int t = F.tid, lane = F.lane, wave = F.wave, e = t & 31, ks = t >> 5;
    const int per = (NTOK + F.G - 1) / F.G, tok0 = F.bid * per, tok1 = min(NTOK, tok0 + per);
    float rwr[64];
#pragma unroll
    for (int i = 0; i < 64; ++i) rwr[i] = rw[(size_t)(ks * 64 + i) * 32 + e];
    f32x4 gv[4];
#pragma unroll
    for (int j = 0; j < 4; ++j) gv[j] = *(const f32x4*)(gain + 4 * (lane + 64 * j));
    __syncthreads();
    if (t < 64) lcnt[t] = 0;
    for (int base = tok0; base < tok1; base += 8) {
        const int tok = base + wave;
        if (tok < tok1) { const float* s = r + (size_t)tok * 1024; f32x4 v[4]; float ss = 0.f;
#pragma unroll
            for (int j = 0; j < 4; ++j) { v[j] = *(const f32x4*)(s + 4 * (lane + 64 * j)); ss += v[j][0] * v[j][0] + v[j][1] * v[j][1] + v[j][2] * v[j][2] + v[j][3] * v[j][3]; }
            ss = wave_sum(ss); const float rstd = rsqrtf(ss * (1.0f / 1024.0f) + RMS_EPS);
#pragma unroll
            for (int j = 0; j < 4; ++j) { const f32x4 y = v[j] * rstd * gv[j]; *(LAS f32x4*)(hs + wave * 1024 + 4 * (lane + 64 * j)) = y;
                u32x2 w; w.x = cvt_pk_bf16(y[0], y[1]); w.y = cvt_pk_bf16(y[2], y[3]); *(u32x2*)(H + (size_t)tok * 1024 + 4 * (lane + 64 * j)) = w; } }
        __syncthreads();
#pragma unroll
        for (int tk = 0; tk < 8; ++tk) { float acc = 0.f;
#pragma unroll
            for (int i4 = 0; i4 < 16; ++i4) { const f32x4 hv = *(const LAS f32x4*)(hs + tk * 1024 + ks * 64 + 4 * i4); acc += hv[0] * rwr[4 * i4] + hv[1] * rwr[4 * i4 + 1] + hv[2] * rwr[4 * i4 + 2] + hv[3] * rwr[4 * i4 + 3]; }
            part[(tk * 16 + ks) * 32 + e] = acc; }
        __syncthreads();
        if (t < 256) { const int tk = t >> 5; float s = rb[e];
#pragma unroll
            for (int k = 0; k < 16; ++k) s += part[(tk * 16 + k) * 32 + e];
            logit[tk * 32 + e] = s; }
        __syncthreads();
        if (t < 8 && base + t < tok1) { const int tk = t, tokk = base + t; float v0 = -3.0e38f, v1 = -3.0e38f, v2 = -3.0e38f, v3 = -3.0e38f; int i0 = 0, i1 = 0, i2 = 0, i3 = 0;
            for (int j = 0; j < 32; ++j) { const float g = logit[tk * 32 + j];
                if (g > v0) { v3 = v2; i3 = i2; v2 = v1; i2 = i1; v1 = v0; i1 = i0; v0 = g; i0 = j; } else if (g > v1) { v3 = v2; i3 = i2; v2 = v1; i2 = i1; v1 = g; i1 = j; }
                else if (g > v2) { v3 = v2; i3 = i2; v2 = g; i2 = j; } else if (g > v3) { v3 = g; i3 = j; } }
            const float e1 = __expf(v1 - v0), e2 = __expf(v2 - v0), e3 = __expf(v3 - v0), inv = 1.0f / (1.0f + e1 + e2 + e3);
            f32x4 gg; gg[0] = inv; gg[1] = e1 * inv; gg[2] = e2 * inv; gg[3] = e3 * inv; *(f32x4*)(TOKG + (size_t)tokk * 4) = gg;
            const int lt = tokk - tok0;
            tinfo[lt * 4 + 0] = (i0 << 20) | atomicAdd((int*)&lcnt[i0], 1); tinfo[lt * 4 + 1] = (i1 << 20) | atomicAdd((int*)&lcnt[i1], 1);
            tinfo[lt * 4 + 2] = (i2 << 20) | atomicAdd((int*)&lcnt[i2], 1); tinfo[lt * 4 + 3] = (i3 << 20) | atomicAdd((int*)&lcnt[i3], 1); }
    }
    __syncthreads();
    if (t < 32) lcnt[32 + t] = (int)__hip_atomic_fetch_add(GCNT + t, (unsigned)lcnt[t], __ATOMIC_RELAXED, __HIP_MEMORY_SCOPE_AGENT);
    __syncthreads();
    for (int x = t; x < (tok1 - tok0) * 4; x += 512) { const int v = tinfo[x], ee = v >> 20, pos = lcnt[32 + ee] + (v & 0xfffff), tokk = tok0 + (x >> 2);
        MLIST[(size_t)ee * NTOK + pos] = tokk; TOKEP[(size_t)tokk * 4 + (x & 3)] = (ee << 20) | pos; }
    __syncthreads();
}

struct MoeTab { LAS int* cnt; LAS int* tb; LAS int* rte; int NT; };
__device__ __forceinline__ MoeTab moe_tables(const Frame& F, int layer) {
    MoeTab T; T.cnt = (LAS int*)(F.lds + LDS_AUX + 18432); T.tb = T.cnt + 32; T.rte = T.tb + 40;
    unsigned* GCNT = F.ctl + CW_GCNT + layer * 64; const int t = F.tid;
    __syncthreads();
    if (t < 32) T.cnt[t] = (int)__hip_atomic_load(GCNT + t, __ATOMIC_RELAXED, __HIP_MEMORY_SCOPE_AGENT);
    __syncthreads();
    if (t == 0) { int s = 0; for (int e = 0; e < 32; ++e) { T.tb[e] = s; s += (T.cnt[e] + 255) >> 8; } T.tb[32] = s; }
    __syncthreads();
    T.NT = T.tb[32];
    for (int x = t; x < T.NT; x += 512) { int e = 0; for (int k = 1; k < 32; ++k) if (T.tb[k] <= x) e = k; T.rte[x] = e; }
    __syncthreads();
    return T;
}
__device__ __forceinline__ bool moe_unit(int i, int G, int c, int NT, int NPN, int& rt, int& pn) {
    const long L = (long)i * G + c;
    if ((G & 7) == 0) { const int xcd = (int)(L & 7); const long idx = L >> 3; rt = (int)(idx / NPN) * 8 + xcd; pn = (int)(idx % NPN); }
    else { rt = (int)(L / NPN); pn = (int)(L % NPN); }
    return rt < NT;
}
struct MoeUpSched {
    static constexpr bool GATHER = true;
    MoeTab T; const char* H; const char* Wg; const char* Wu; LAS int* rowtab; int G, c;
    __device__ __forceinline__ bool next(int i, GU& u) const {
        int rt, pn; if (!moe_unit(i, G, c, T.NT, 8, rt, pn)) return false;
        const int e = T.rte[rt];
        u.a0 = H; u.a1 = H; u.b0 = Wg + ((size_t)e * 1024 + pn * 128) * 2048; u.b1 = Wu + ((size_t)e * 1024 + pn * 128) * 2048;
        u.p0 = rt * 256; u.p1 = pn * 128; u.p2 = e; u.p3 = 0; return true;
    }
    __device__ __forceinline__ const LAS int* rows(int i) const { return rowtab + i * 256; }
};
struct MoeDownSched {
    static constexpr bool GATHER = false;
    MoeTab T; const char* A; const char* Wd; int G, c;
    __device__ __forceinline__ bool next(int i, GU& u) const {
        int rt, pn; if (!moe_unit(i, G, c, T.NT, 4, rt, pn)) return false;
        const int e = T.rte[rt];
        u.a0 = A + (size_t)rt * 256 * 2048; u.a1 = u.a0 + (size_t)128 * 2048; u.b0 = Wd + ((size_t)e * 1024 + pn * 256) * 2048; u.b1 = u.b0 + (size_t)128 * 2048;
        u.p0 = rt * 256; u.p1 = pn * 256; u.p2 = e; u.p3 = 0; return true;
    }
    __device__ __forceinline__ const LAS int* rows(int) const { return nullptr; }
};
__device__ __forceinline__ void moe_up(const Frame& F, const Args& a, int layer) {
    const MoeTab T = moe_tables(F, layer); const int* MLIST = (const int*)(F.ws + WS_MLIST);
    LAS int* rowtab = (LAS int*)(F.lds + LDS_AUX);
    for (int i = 0; i < 18; ++i) { int rt, pn; if (!moe_unit(i, F.G, F.bid, T.NT, 8, rt, pn)) break;
        const int e = T.rte[rt], tile = rt - T.tb[e], cnt = T.cnt[e];
        if (F.tid < 256) { const int pos = tile * 256 + F.tid; rowtab[i * 256 + F.tid] = pos < cnt ? MLIST[(size_t)e * NTOK + pos] : 0; } }
    __syncthreads();
    const bf16_t* W = (const bf16_t*)(F.ws + WS_MOEW); const size_t L = (size_t)NEXP * 1024 * 1024;
    MoeUpSched S{T, (const char*)(F.ws + WS_H), (const char*)W, (const char*)(W + L), rowtab, F.G, F.bid};
    EpiSwiglu E{a.in[I_BG] + (size_t)layer * NEXP * 1024, a.in[I_BU] + (size_t)layer * NEXP * 1024, (bf16_t*)(F.ws + RA_ACT)};
    g8::gemm_run<EpiSwiglu, MoeUpSched>(F.lds, 1024, 2048u, 2048u, S, E);
}
__device__ __forceinline__ void moe_down(const Frame& F, const Args& a, int layer) {
    const MoeTab T = moe_tables(F, layer);
    const bf16_t* W = (const bf16_t*)(F.ws + WS_MOEW); const size_t L = (size_t)NEXP * 1024 * 1024;
    MoeDownSched S{T, (const char*)(F.ws + RA_ACT), (const char*)(W + 2 * L), F.G, F.bid};
    EpiDown E{a.in[I_BD] + (size_t)layer * NEXP * 1024, (bf16_t*)(F.ws + RB_YS)};
    g8::gemm_run<EpiDown, MoeDownSched>(F.lds, 1024, 2048u, 2048u, S, E);
}
__device__ __forceinline__ void moe_combine(const Frame& F, const Args& a, int layer, float* __restrict__ r) {
    const MoeTab T = moe_tables(F, layer);
    const bf16_t* YS = (const bf16_t*)(F.ws + RB_YS); const int* TOKEP = (const int*)(F.ws + WS_TOKEP); const float* TOKG = (const float*)(F.ws + WS_TOKG); bf16_t* H = (bf16_t*)(F.ws + WS_H);
    const float* gain = a.in[I_NPLE] + layer * 1024; const int lane = F.lane;
    f32x4 gv[2][2];
#pragma unroll
    for (int c = 0; c < 2; ++c) { gv[c][0] = *(const f32x4*)(gain + c * 512 + lane * 8); gv[c][1] = *(const f32x4*)(gain + c * 512 + lane * 8 + 4); }
    for (int tok = F.gw; tok < NTOK; tok += F.GW) {
        int slot[4]; float gt[4];
#pragma unroll
        for (int k = 0; k < 4; ++k) { const int v = TOKEP[(size_t)tok * 4 + k]; slot[k] = T.tb[v >> 20] * 256 + (v & 0xfffff); gt[k] = TOKG[(size_t)tok * 4 + k]; }
        f32x4 v[2][2]; float ss = 0.f;
#pragma unroll
        for (int c = 0; c < 2; ++c) { const size_t o = (size_t)tok * 1024 + c * 512 + lane * 8; v[c][0] = *(const f32x4*)(r + o); v[c][1] = *(const f32x4*)(r + o + 4);
#pragma unroll
            for (int k = 0; k < 4; ++k) { const u32x4 y = *(const u32x4*)(YS + (size_t)slot[k] * 1024 + c * 512 + lane * 8);
                v[c][0][0] += gt[k] * bf_lo(y.x); v[c][0][1] += gt[k] * bf_hi(y.x); v[c][0][2] += gt[k] * bf_lo(y.y); v[c][0][3] += gt[k] * bf_hi(y.y);
                v[c][1][0] += gt[k] * bf_lo(y.z); v[c][1][1] += gt[k] * bf_hi(y.z); v[c][1][2] += gt[k] * bf_lo(y.w); v[c][1][3] += gt[k] * bf_hi(y.w); }
            *(f32x4*)(r + o) = v[c][0]; *(f32x4*)(r + o + 4) = v[c][1];
#pragma unroll
            for (int q = 0; q < 2; ++q) ss += v[c][q][0] * v[c][q][0] + v[c][q][1] * v[c][q][1] + v[c][q][2] * v[c][q][2] + v[c][q][3] * v[c][q][3]; }
        ss = wave_sum(ss); const float rstd = rsqrtf(ss * (1.0f / 1024.0f) + RMS_EPS);
#pragma unroll
        for (int c = 0; c < 2; ++c) { const f32x4 y0 = v[c][0] * rstd * gv[c][0], y1 = v[c][1] * rstd * gv[c][1];
            u32x4 w; w.x = cvt_pk_bf16(y0[0], y0[1]); w.y = cvt_pk_bf16(y0[2], y0[3]); w.z = cvt_pk_bf16(y1[0], y1[1]); w.w = cvt_pk_bf16(y1[2], y1[3]);
            *(u32x4*)(H + (size_t)tok * 1024 + c * 512 + lane * 8) = w; }
    }
}

constexpr int N_PHASES = 22;
#ifndef DBG_DUP_MASK
#define DBG_DUP_MASK 0
#endif
#ifndef DBG_NPH
#define DBG_NPH 22
#endif
#ifndef MK_ONE_LAUNCH
#define MK_ONE_LAUNCH 1
#endif

__device__ __forceinline__ void moe_ple_phases(const Frame& F, const Args& a, int layer, int ph, float* out) {
    if (ph == 0) moe_router(F, a, layer, out);
    else if (ph == 1) moe_up(F, a, layer);
    else if (ph == 2) moe_down(F, a, layer);
    else if (ph == 3) {
        g8::DenseSched S{(const char*)(F.ws + WS_PB) + (size_t)layer * NTOK * PLE * 2, (const char*)(F.ws + WS_WPLE) + (size_t)layer * 1024 * PLE * 2, 512u, 512u, 128, 4, F.G, F.bid};
        EpiStoreBf16 E{(bf16_t*)(F.ws + RA_PROJ), 1024, 1.0f};
        g8::gemm_run<EpiStoreBf16, g8::DenseSched>(F.lds, 256, 512u, 512u, S, E);
        moe_combine(F, a, layer, out);
    } else {
        g8::DenseSched S{(const char*)(F.ws + WS_H), (const char*)(F.ws + WS_WPLEG) + (size_t)layer * 1024 * 1024 * 2, 2048u, 2048u, 128, 4, F.G, F.bid};
        EpiPle E{(const bf16_t*)(F.ws + RA_PROJ), out};
        g8::gemm_run<EpiPle, g8::DenseSched>(F.lds, 1024, 2048u, 2048u, S, E);
    }
}

__global__ void __launch_bounds__(512, 2) fwd(Args a) {
    extern __shared__ __attribute__((aligned(16))) unsigned char lds_raw[];
    Frame F;
    F.lds = (LAS unsigned char*)lds_raw; F.tid = threadIdx.x; F.lane = F.tid & 63; F.wave = __builtin_amdgcn_readfirstlane(F.tid >> 6);
    F.G = gridDim.x; F.bid = blockIdx.x; F.gw = F.bid * 8 + F.wave; F.GW = F.G * 8; F.ws = a.ws; F.ctl = (unsigned*)(a.ws + WS_CTL);
    volatile LAS unsigned* misc = (volatile LAS unsigned*)(F.lds + LDS_MISC);
    if (F.tid < 16) misc[F.tid] = 0u;
    __syncthreads();
    XcdBarrier bar; bar.bar = F.ctl + CW_BAR; bar.x = 0; bar.st = misc;
    const int lo = a.ph_lo, hi = a.ph_hi;
    if (hi - lo > 1) bar = xcd_barrier_post(F.ctl + CW_BAR, misc);
#define IN(k) (lo <= (k) && (k) < hi)
#define SEAM(k) do { if (IN(k) && IN((k) + 1)) xcd_barrier(bar); } while (0)
    float* out = a.out;

    if (IN(0)) { p0_prologue(F, a); } SEAM(0);
    if (IN(1)) {
        { g8::DenseSched S{(const char*)(F.ws + WS_H), (const char*)(F.ws + WS_WINAB), 2048u, 2048u, 128, 6, F.G, F.bid};
          EpiInAB E{(bf16_t*)(F.ws + RA_A2), (bf16_t*)(F.ws + RA_Q0), (bf16_t*)(F.ws + RA_K0)};
          g8::gemm_run<EpiInAB, g8::DenseSched>(F.lds, 1024, 2048u, 2048u, S, E); }
        { g8::DenseSched S{(const char*)(F.ws + WS_WINAB) + (size_t)1536 * 2048, (const char*)(F.ws + WS_H), 2048u, 2048u, 2, 128, F.G, F.bid};
          EpiVt E{(bf16_t*)(F.ws + RA_VT0), 8};
          g8::gemm_run<EpiVt, g8::DenseSched>(F.lds, 1024, 2048u, 2048u, S, E); }
    } SEAM(1);
    if (IN(2)) {
        { g8::BatchSched S{(const char*)(F.ws + RA_A2), (const char*)(F.ws + WS_WBT), 1280u, 1024u, (size_t)1024 * 1280, (size_t)256 * 1024, 4, 1, NGRP, F.G, F.bid};
          EpiS E{(float*)(F.ws + RA_SS)};
          g8::gemm_run<EpiS, g8::BatchSched>(F.lds, 512, 1280u, 1024u, S, E); }
        moba_kmean(F);
    } SEAM(2);
    if (IN(3)) { s5_scan(F, a); moba_gate(F); } SEAM(3);
    if (IN(4)) {
        { g8::BatchSched S{(const char*)(F.ws + RA_A2), (const char*)(F.ws + WS_MY), 1280u, 1280u, (size_t)1024 * 1280, (size_t)512 * 1280, 4, 2, NGRP, F.G, F.bid};
          EpiY E{(bf16_t*)(F.ws + RA_Z)};
          g8::gemm_run<EpiY, g8::BatchSched>(F.lds, 640, 1280u, 1280u, S, E); }
        moba_attn(F, a);
    } SEAM(4);
    if (IN(5)) {
        { g8::DenseSched S{(const char*)(F.ws + RA_Z), (const char*)(F.ws + WS_GLU), 1024u, 1024u, 128, 2, F.G, F.bid};
          EpiGlu E{(const bf16_t*)(F.ws + RA_Z), a.in[I_GLUB], (bf16_t*)(F.ws + RB_YCAT)};
          g8::gemm_run<EpiGlu, g8::DenseSched>(F.lds, 512, 1024u, 1024u, S, E); }
        moba_combine(F);
    } SEAM(5);
    if (IN(6)) {
        g8::DenseSched S{(const char*)(F.ws + RB_YCAT), (const char*)(F.ws + WS_WOUTAB), 2048u, 2048u, 128, 4, F.G, F.bid};
        EpiRes E{a.in[I_X], out};
        g8::gemm_run<EpiRes, g8::DenseSched>(F.lds, 1024, 2048u, 2048u, S, E);
    } SEAM(6);
    if (IN(7)) moe_ple_phases(F, a, 0, 0, out); SEAM(7);
    if (IN(8)) moe_ple_phases(F, a, 0, 1, out); SEAM(8);
    if (IN(9)) moe_ple_phases(F, a, 0, 2, out); SEAM(9);
    if (IN(10)) moe_ple_phases(F, a, 0, 3, out); SEAM(10);
    if (IN(11)) moe_ple_phases(F, a, 0, 4, out); SEAM(11);
    if (IN(12)) { rmsnorm_rows<false>(F, out, a.in[I_NMIX] + 1024, (bf16_t*)(F.ws + WS_H), nullptr, NTOK); conv_moe_weights(F, a, 1); } SEAM(12);
    if (IN(13)) {
        { g8::DenseSched S{(const char*)(F.ws + WS_H), (const char*)(F.ws + WS_WINC), 2048u, 2048u, 128, 8, F.G, F.bid};
          EpiInC E{(bf16_t*)(F.ws + RA_Q1), (bf16_t*)(F.ws + RA_K1)};
          g8::gemm_run<EpiInC, g8::DenseSched>(F.lds, 1024, 2048u, 2048u, S, E); }
        { g8::DenseSched S{(const char*)(F.ws + WS_WINC) + (size_t)2048 * 2048, (const char*)(F.ws + WS_H), 2048u, 2048u, 4, 128, F.G, F.bid};
          EpiVt E{(bf16_t*)(F.ws + RA_VT1), 16};
          g8::gemm_run<EpiVt, g8::DenseSched>(F.lds, 1024, 2048u, 2048u, S, E); }
    } SEAM(13);
#ifdef DBG_NOSB
    if (IN(14)) { const bf16_t* Qd = (const bf16_t*)(F.ws + RA_Q1); bf16_t* Yd = (bf16_t*)(F.ws + RB_Y1); for (size_t i = ((size_t)F.bid * 512 + F.tid) * 8; i < (size_t)NTOK * 1024; i += (size_t)F.G * 512 * 8) *(u32x4*)(Yd + i) = *(const u32x4*)(Qd + i); } SEAM(14);
#else
    if (IN(14)) sb_attn(F); SEAM(14);
#endif
    if (IN(15)) {
        g8::DenseSched S{(const char*)(F.ws + RB_Y1), (const char*)(F.ws + WS_WOUTC), 2048u, 2048u, 128, 4, F.G, F.bid};
        EpiRes E{out, out};
        g8::gemm_run<EpiRes, g8::DenseSched>(F.lds, 1024, 2048u, 2048u, S, E);
    } SEAM(15);
    if (IN(16)) moe_ple_phases(F, a, 1, 0, out); SEAM(16);
    if (IN(17)) moe_ple_phases(F, a, 1, 1, out); SEAM(17);
    if (IN(18)) moe_ple_phases(F, a, 1, 2, out); SEAM(18);
    if (IN(19)) moe_ple_phases(F, a, 1, 3, out); SEAM(19);
    if (IN(20)) moe_ple_phases(F, a, 1, 4, out); SEAM(20);
    if (IN(21)) rmsnorm_rows<true>(F, out, a.in[I_NFINAL], nullptr, out, NTOK);
#undef IN
#undef SEAM
}

extern "C" void kernel_launch(void* const* d_in, const int* in_sizes, int n_in, void* d_out, int out_size, void* d_ws, size_t ws_size, hipStream_t stream) {
    static int grid = 0;
    if (grid == 0) {
        if (n_in != 31 || out_size != NTOK * DM || ws_size < WS_END) { fprintf(stderr, "kernel_launch: unexpected shapes (n_in %d, out %d, ws %zu < %zu)\n", n_in, out_size, ws_size, (size_t)WS_END); grid = -1; return; }
        int dev = 0, cus = 0, per_cu = 0;
        if (hipGetDevice(&dev) != hipSuccess || hipDeviceGetAttribute(&cus, hipDeviceAttributeMultiprocessorCount, dev) != hipSuccess) { grid = -1; return; }
        if (hipFuncSetAttribute((const void*)fwd, hipFuncAttributeMaxDynamicSharedMemorySize, LDS_BYTES) != hipSuccess) { fprintf(stderr, "kernel_launch: hipFuncSetAttribute failed\n"); grid = -1; return; }
        if (hipOccupancyMaxActiveBlocksPerMultiprocessor(&per_cu, (const void*)fwd, 512, LDS_BYTES) != hipSuccess || per_cu < 1) fprintf(stderr, "kernel_launch: occupancy query says %d\n", per_cu);
        (void)hipGetLastError();
        grid = cus;
        if (grid != 256) fprintf(stderr, "kernel_launch: %d CUs (built for 256)\n", grid);
    }
    if (grid < 0) return;
    (void)hipMemsetAsync((char*)d_ws + WS_CTL, 0, 1 * MiB, stream);
    Args a{};
    for (int i = 0; i < 31; ++i) a.in[i] = (const float*)d_in[i];
    a.out = (float*)d_out; a.ws = (unsigned char*)d_ws;
    for (int n = 0; n < 128; ++n) { int bk; if (n < 16) bk = n; else { bk = 16 + (int)(std::log((double)n / 16.0) / std::log(8.0) * 16.0); if (bk > 31) bk = 31; } a.btab[n] = (unsigned char)bk; }
#if MK_ONE_LAUNCH
    a.ph_lo = 0; a.ph_hi = N_PHASES;
    hipLaunchKernelGGL(fwd, dim3(grid), dim3(512), LDS_BYTES, stream, a);
#else
    for (int p = 0; p < DBG_NPH; ++p) { a.ph_lo = p; a.ph_hi = p + 1; const int reps = ((DBG_DUP_MASK >> p) & 1) ? 2 : 1; for (int q = 0; q < reps; ++q) hipLaunchKernelGGL(fwd, dim3(grid), dim3(512), LDS_BYTES, stream, a); }
#endif
}
```

```cpp
#include <hip/hip_runtime.h>
#include <cstdio>
#include <cstdint>
#include <cmath>

#define LAS __attribute__((address_space(3)))
typedef unsigned short bf16_t;
typedef short bf16x8 __attribute__((ext_vector_type(8)));
typedef short bf16x4 __attribute__((ext_vector_type(4)));
typedef float f32x4 __attribute__((ext_vector_type(4)));
typedef float f32x2 __attribute__((ext_vector_type(2)));
typedef float f32x16 __attribute__((ext_vector_type(16)));
typedef unsigned u32x4 __attribute__((ext_vector_type(4)));
typedef unsigned u32x2 __attribute__((ext_vector_type(2)));
typedef int i32x4 __attribute__((ext_vector_type(4)));
typedef int i32x8 __attribute__((ext_vector_type(8)));

constexpr int NTOK = 32768, DM = 1024, SEQ = 4096, NBATCH = 8, PLE = 256;
constexpr int SSMW = 512, NGRP = 32, GH = 16, NST = 64, TCH = 32, NCH = SEQ / TCH  , A2LD = 640;
constexpr int MOBW = 512, MH = 8, MBLK = 256, NMB = 16;
constexpr int NEXP = 32;
constexpr float RMS_EPS = 1e-6f;
constexpr float LOG2E = 1.4426950408889634f;
constexpr float QSCALE = 0.125f * LOG2E;
constexpr float W8_SCALE = 32.0f;
constexpr float SB_THR = 150.0f;

constexpr size_t MiB = (size_t)1 << 20;
constexpr size_t WS_CTL = 0;
constexpr size_t WS_WINAB = 1 * MiB;
constexpr size_t WS_GLU = WS_WINAB + 4 * MiB;
constexpr size_t WS_WOUTAB = WS_GLU + MiB / 2;
constexpr size_t WS_WINC = WS_WOUTAB + 2 * MiB;
constexpr size_t WS_WOUTC = WS_WINC + 6 * MiB;
constexpr size_t WS_WPLE = WS_WOUTC + 2 * MiB;
constexpr size_t WS_WPLEG = WS_WPLE + 1 * MiB;
constexpr size_t WS_WBT = WS_WPLEG + 4 * MiB;
constexpr size_t WS_MY = WS_WBT + 8 * MiB;
constexpr size_t WS_MOEW = WS_MY + 20 * MiB;
constexpr size_t WS_H = WS_MOEW + 192 * MiB;
constexpr size_t WS_PB = WS_H + 64 * MiB;
constexpr size_t WS_MLIST = WS_PB + 32 * MiB;
constexpr size_t WS_TOKEP = WS_MLIST + 4 * MiB;
constexpr size_t WS_TOKG = WS_TOKEP + MiB / 2;
constexpr size_t WS_RA = WS_TOKG + MiB / 2;
constexpr size_t WS_RB = WS_RA + 272 * MiB;
constexpr size_t WS_END = WS_RB + 272 * MiB;
constexpr size_t RA_A2 = WS_RA;
constexpr size_t RA_Q0 = RA_A2 + 40 * MiB;
constexpr size_t RA_K0 = RA_Q0 + 32 * MiB;
constexpr size_t RA_VT0 = RA_K0 + 32 * MiB;
constexpr size_t RA_Z = RA_VT0 + 32 * MiB;
constexpr size_t RA_SS = RA_Z + 32 * MiB;
constexpr size_t RA_Q1 = WS_RA;
constexpr size_t RA_K1 = RA_Q1 + 64 * MiB;
constexpr size_t RA_VT1 = RA_K1 + 64 * MiB;
constexpr size_t RA_ACT = WS_RA;
constexpr size_t RA_PROJ = WS_RA;
constexpr size_t RB_PARTO = WS_RB;
constexpr size_t RB_PARTML = RB_PARTO + 128 * MiB;
constexpr size_t RB_MOBALIST = RB_PARTML + 8 * MiB;
constexpr size_t RB_KMEAN = RB_MOBALIST + 16 * MiB;
constexpr size_t RB_YCAT = RB_KMEAN + 1 * MiB;
constexpr size_t RB_Y1 = WS_RB;
constexpr size_t RB_YS = WS_RB;
constexpr int CW_BAR = 0;
constexpr int CW_GCNT = 4096;
constexpr int CW_MOBACNT = 8192;

constexpr int LDS_BYTES = 155648;
constexpr int LDS_AUX = 131072;
constexpr int LDS_MISC = 155648 - 64;

typedef __bf16 bf16x2_t __attribute__((ext_vector_type(2)));
__device__ __forceinline__ unsigned cvt_pk_bf16(float lo, float hi) { const f32x2 v = {lo, hi}; return __builtin_bit_cast(unsigned, __builtin_convertvector(v, bf16x2_t)); }
__device__ __forceinline__ bf16_t f2bf(float x) { return (bf16_t)(cvt_pk_bf16(x, 0.f) & 0xffffu); }
__device__ __forceinline__ unsigned cvt_pk4_fp8(float x0, float x1, float x2, float x3) { int w = __builtin_amdgcn_cvt_pk_fp8_f32(x0, x1, 0, false); w = __builtin_amdgcn_cvt_pk_fp8_f32(x2, x3, w, true); return (unsigned)w; }
__device__ __forceinline__ float bf_lo(unsigned w) { return __uint_as_float(w << 16); }
__device__ __forceinline__ float bf_hi(unsigned w) { return __uint_as_float(w & 0xffff0000u); }
__device__ __forceinline__ float ex2(float x) { return __builtin_amdgcn_exp2f(x); }
__device__ __forceinline__ float lg2(float x) { return __builtin_amdgcn_logf(x); }
__device__ __forceinline__ float rcp(float x) { return __builtin_amdgcn_rcpf(x); }
__device__ __forceinline__ float sigmoidf_(float x) { return rcp(1.0f + ex2(-LOG2E * x)); }
__device__ __forceinline__ float wave_sum(float v) { v += __shfl_xor(v, 32); v += __shfl_xor(v, 16); v += __shfl_xor(v, 8); v += __shfl_xor(v, 4); v += __shfl_xor(v, 2); v += __shfl_xor(v, 1); return v; }
__device__ __forceinline__ f32x16 mfma32(bf16x8 a, bf16x8 b, f32x16 c) { return __builtin_amdgcn_mfma_f32_32x32x16_bf16(a, b, c, 0, 0, 0); }

#define XB_TMO      128
#define XB_XCNT(j)  (256  + 64 * (j))
#define XB_XSUB(j)  (1280 + 64 * (j))
#define XB_XGEN(j)  (2304 + 64 * (j))
#define XB_TOP      3328
#define XB_TOPGEN   3392
#define XCD_BAR_WORDS 3456
#define XB_SPIN_CAP (1u << 18)
__device__ __forceinline__ unsigned xb_ld(unsigned* p)              { return __hip_atomic_load(p, __ATOMIC_RELAXED, __HIP_MEMORY_SCOPE_AGENT); }
__device__ __forceinline__ unsigned xb_add(unsigned* p, unsigned v) { return __hip_atomic_fetch_add(p, v, __ATOMIC_RELAXED, __HIP_MEMORY_SCOPE_AGENT); }
__device__ __forceinline__ unsigned xb_xcc_id() { return (unsigned)__builtin_amdgcn_s_getreg((3 << 11) | 20) & 0xFu; }
#define XB_SPIN(cond, bar) do { unsigned _sp = 0; while (cond) { __builtin_amdgcn_s_sleep(1); \
    if ((++_sp & 255u) == 0u) { if (xb_ld(&(bar)[XB_TMO])) break; if (_sp > XB_SPIN_CAP) { atomicAdd(&(bar)[XB_TMO], 1u); break; } } } } while (0)
struct XcdBarrier { unsigned* bar; unsigned x; volatile LAS unsigned* st; };
__device__ __forceinline__ XcdBarrier xcd_barrier_post(unsigned* bar, volatile LAS unsigned* st) {
    XcdBarrier b; b.bar = bar; b.x = xb_xcc_id(); b.st = st;
    if (threadIdx.x == 0) (void)xb_add(&bar[XB_XCNT(b.x)], 1u);
    return b;
}
__device__ __forceinline__ void xcd_barrier_complete(unsigned* bar, unsigned x, unsigned& nloc, unsigned& nx) {
    const unsigned G = gridDim.x * gridDim.y * gridDim.z;
    unsigned sum, cnt, mine, sp = 0u;
    for (;;) {
        sum = 0u; cnt = 0u; mine = 0u;
#pragma unroll
        for (unsigned j = 0; j < 16; ++j) { const unsigned c = xb_ld(&bar[XB_XCNT(j)]); sum += c; cnt += (c > 0u) ? 1u : 0u; mine = (j == x) ? c : mine; }
        if (sum == G) break;
        __builtin_amdgcn_s_sleep(1);
        if ((++sp & 255u) == 0u) { if (xb_ld(&bar[XB_TMO])) break; if (sp > XB_SPIN_CAP) { atomicAdd(&bar[XB_TMO], 1u); break; } }
    }
    nloc = mine > 0u ? mine : 1u; nx = cnt > 0u ? cnt : 1u;
}
__device__ __forceinline__ void xcd_barrier(const XcdBarrier& b) {
    asm volatile("s_waitcnt vmcnt(0)" ::: "memory");
    __syncthreads();
    if (threadIdx.x == 0) {
        unsigned* bar = b.bar;
        __builtin_amdgcn_s_waitcnt(0);
        unsigned nloc = b.st[0], nx = b.st[1];
        if (nloc == 0u) { xcd_barrier_complete(bar, b.x, nloc, nx); b.st[0] = nloc; b.st[1] = nx; }
        const unsigned old = xb_add(&bar[XB_XSUB(b.x)], 1u);
        const unsigned gen = old / nloc;
        if (old + 1u == (gen + 1u) * nloc) {
            __builtin_amdgcn_fence(__ATOMIC_RELEASE, "agent");
            asm volatile("s_waitcnt vmcnt(0)" ::: "memory");
            const unsigned og = xb_add(&bar[XB_TOP], 1u);
            const unsigned tg = og / nx;
            if (og + 1u == (tg + 1u) * nx) xb_add(&bar[XB_TOPGEN], 1u);
            else XB_SPIN(xb_ld(&bar[XB_TOPGEN]) == tg, bar);
            __builtin_amdgcn_fence(__ATOMIC_ACQUIRE, "agent");
            xb_add(&bar[XB_XGEN(b.x)], 1u);
            asm volatile("s_waitcnt vmcnt(0)" ::: "memory");
        } else {
            XB_SPIN(xb_ld(&bar[XB_XGEN(b.x)]) == gen, bar);
            __builtin_amdgcn_fence(__ATOMIC_ACQUIRE, "agent");
            asm volatile("s_waitcnt vmcnt(0)" ::: "memory");
        }
    }
    __syncthreads();
}

namespace g8 {
constexpr int BM = 256, BK = 64, HALF = 128, HTB = HALF * BK * 2, STAGE_BYTES = 8 * HTB, NXCD = 8, WGM = 8;
__host__ __device__ __forceinline__ int lds_byte(int r, int c) { const int st = (r >> 4) * 2 + (c >> 5), rr = r & 15, cc = c & 31, ob = rr * 64 + cc * 2; return st * 1024 + (ob ^ (((ob >> 9) & 1) << 5)); }
__host__ __device__ __forceinline__ void stage_rc(int b, int& R, int& C) { const int st = b / 1024, sb = b % 1024, swz = sb ^ (((sb >> 9) & 1) << 5); R = (st >> 1) * 16 + swz / 64; C = (st & 1) * 32 + (swz % 64) / 2; }
__host__ __device__ __forceinline__ int perm32(int rho) { const int n = rho >> 4, i = rho & 15; return 8 * (i >> 2) + 4 * n + (i & 3); }

struct GU { const char *a0, *a1, *b0, *b1; int p0, p1, p2, p3; };

__device__ __forceinline__ bool static_tile(int i, int G, int c, int nM, int nN, int& pm, int& pn) {
    const int nwg = nM * nN; const long L = (long)i * G + c; if (L >= nwg) return false;
    int wgid = (int)L; { const int q = nwg / NXCD, r = nwg % NXCD, xcd = wgid % NXCD, off = wgid / NXCD; wgid = (xcd < r ? xcd * (q + 1) : r * (q + 1) + (xcd - r) * q) + off; }
    const int nig = WGM * nN, gid = wgid / nig, fm = gid * WGM, gsz = (nM - fm) < WGM ? (nM - fm) : WGM;
    pm = fm + ((wgid % nig) % gsz); pn = (wgid % nig) / gsz; return true;
}
struct DenseSched {
    const char* A; const char* B; unsigned lda2, ldb2; int nM, nN, G, c;
    static constexpr bool GATHER = false;
    __device__ __forceinline__ bool next(int i, GU& u) const {
        int pm, pn; if (!static_tile(i, G, c, nM, nN, pm, pn)) return false;
        u.a0 = A + (size_t)pm * 256 * lda2; u.a1 = u.a0 + (size_t)128 * lda2; u.b0 = B + (size_t)pn * 256 * ldb2; u.b1 = u.b0 + (size_t)128 * ldb2;
        u.p0 = pm; u.p1 = pn; u.p2 = 0; u.p3 = 0; return true;
    }
    __device__ __forceinline__ const LAS int* rows(int) const { return nullptr; }
};
struct BatchSched {
    const char* A; const char* B; unsigned lda2, ldb2; size_t sA, sB; int nM, nN, nb, G, c;
    static constexpr bool GATHER = false;
    __device__ __forceinline__ bool next(int i, GU& u) const {
        const long L = (long)i * G + c; const int per = nM * nN; if (L >= (long)per * nb) return false;
        const int g = (int)(L / per), rem = (int)(L % per), pm = rem / nN, pn = rem % nN;
        u.a0 = A + (size_t)g * sA + (size_t)pm * 256 * lda2; u.a1 = u.a0 + (size_t)128 * lda2; u.b0 = B + (size_t)g * sB + (size_t)pn * 256 * ldb2; u.b1 = u.b0 + (size_t)128 * ldb2;
        u.p0 = pm; u.p1 = pn; u.p2 = g; u.p3 = 0; return true;
    }
    __device__ __forceinline__ const LAS int* rows(int) const { return nullptr; }
};

#define G8_WAIT_V(n) asm volatile("s_waitcnt vmcnt(" #n ")" ::: "memory")
#define G8_WAIT_L(n) asm volatile("s_waitcnt lgkmcnt(" #n ")" ::: "memory")
#define G8_BAR __builtin_amdgcn_s_barrier()
#define G8_SCHED __builtin_amdgcn_sched_barrier(0)

template <class Epi, class Sched, bool F8 = false>
__device__ __forceinline__ void gemm_run(LAS unsigned char* lds, const int K, const unsigned lda2, const unsigned ldb2, const Sched& S, const Epi& E) {
    constexpr bool GATHER = Sched::GATHER;
    const int tid = threadIdx.x, wid = __builtin_amdgcn_readfirstlane(tid >> 6), lane = tid & 63, wr = wid >> 2, wc = wid & 3, fr = lane & 15, fq = lane >> 4;
    const int nt = K / BK;
    int sR[2], sC[2];
    unsigned voffB[2], vc[2][2], vn[2][2];
#pragma unroll
    for (int i = 0; i < 2; ++i) { stage_rc(tid * 16 + i * 8192, sR[i], sC[i]); const int Rb = Epi::PERM ? ((sR[i] & ~31) + perm32(sR[i] & 31)) : sR[i];
        voffB[i] = (unsigned)Rb * ldb2 + (unsigned)sC[i] * 2u; vc[0][i] = vc[1][i] = vn[0][i] = vn[1][i] = (unsigned)sR[i] * lda2 + (unsigned)sC[i] * 2u; }
    const size_t kstep = (size_t)(BK * 2);
    const unsigned ldsw = (unsigned)wid * 1024u;
    const int aoff = lds_byte(wr * 64 + fr, fq * 8), boff = lds_byte(wc * 32 + fr, fq * 8);
#define G8_SA(b, h) (((b) * 2 + (h)) * HTB)
#define G8_SB(b, h) ((4 + (b) * 2 + (h)) * HTB)
#define G8_STAGE(bufoff, gbase, v0, v1) do { \
        __builtin_amdgcn_global_load_lds((const unsigned*)((const char*)(gbase) + (v0)), (LAS unsigned*)(lds + (bufoff) + ldsw), 16, 0, 0); \
        __builtin_amdgcn_global_load_lds((const unsigned*)((const char*)(gbase) + (v1)), (LAS unsigned*)(lds + (bufoff) + ldsw + 8192), 16, 0, 0); } while (0)
#define G8_LDA(dst, b, h) do { _Pragma("unroll") for (int m = 0; m < 4; ++m) _Pragma("unroll") for (int k = 0; k < 2; ++k) dst[m][k] = *(const LAS bf16x8*)(lds + G8_SA(b, h) + aoff + m * 2048 + k * 1024); } while (0)
#define G8_LDB(dst, b, h) do { _Pragma("unroll") for (int n = 0; n < 2; ++n) _Pragma("unroll") for (int k = 0; k < 2; ++k) dst[n][k] = *(const LAS bf16x8*)(lds + G8_SB(b, h) + boff + n * 2048 + k * 1024); } while (0)
#define G8_CAT(a, b) __builtin_shufflevector(__builtin_bit_cast(i32x4, a), __builtin_bit_cast(i32x4, b), 0, 1, 2, 3, 4, 5, 6, 7)
#define G8_MMA(ai, bj, At, Bt) do { __builtin_amdgcn_s_setprio(1); \
        if constexpr (F8) { _Pragma("unroll") for (int m = 0; m < 4; ++m) _Pragma("unroll") for (int n = 0; n < 2; ++n) { const i32x8 b8_ = G8_CAT(Bt[n][0], Bt[n][1]), a8_ = G8_CAT(At[m][0], At[m][1]); \
            asm volatile("v_mfma_f32_16x16x128_f8f6f4 %0, %1, %2, %0" : "+v"(acc[ai][bj][m][n]) : "v"(b8_), "v"(a8_)); } } \
        else { _Pragma("unroll") for (int m = 0; m < 4; ++m) _Pragma("unroll") for (int n = 0; n < 2; ++n) _Pragma("unroll") for (int k = 0; k < 2; ++k) \
            acc[ai][bj][m][n] = __builtin_amdgcn_mfma_f32_16x16x32_bf16(Bt[n][k], At[m][k], acc[ai][bj][m][n], 0, 0, 0); } \
        __builtin_amdgcn_s_setprio(0); } while (0)
    GU cur, nxt; int ui = 0;
    if (!S.next(0, cur)) return;
    if constexpr (GATHER) { const LAS int* rw = S.rows(0);
#pragma unroll
        for (int h = 0; h < 2; ++h)
#pragma unroll
            for (int i = 0; i < 2; ++i) vc[h][i] = (unsigned)rw[h * 128 + sR[i]] * lda2 + (unsigned)sC[i] * 2u; }
    f32x4 acc[2][2][4][2];
#pragma unroll
    for (int a = 0; a < 2; ++a)
#pragma unroll
        for (int b = 0; b < 2; ++b)
#pragma unroll
            for (int m = 0; m < 4; ++m)
#pragma unroll
                for (int n = 0; n < 2; ++n) acc[a][b][m][n] = (f32x4){0.f, 0.f, 0.f, 0.f};
    bf16x8 At[4][2], B0[2][2], B1[2][2];
    const char* cA0 = cur.a0; const char* cA1 = cur.a1; const char* cB0 = cur.b0; const char* cB1 = cur.b1;
    G8_STAGE(G8_SB(0, 0), cB0, voffB[0], voffB[1]); G8_STAGE(G8_SA(0, 0), cA0, vc[0][0], vc[0][1]); G8_STAGE(G8_SB(0, 1), cB1, voffB[0], voffB[1]); G8_STAGE(G8_SA(0, 1), cA1, vc[1][0], vc[1][1]);
    if (wr == 1) G8_BAR;
    G8_WAIT_V(4); G8_BAR;
    G8_STAGE(G8_SB(1, 0), cB0 + kstep, voffB[0], voffB[1]); G8_STAGE(G8_SA(1, 0), cA0 + kstep, vc[0][0], vc[0][1]); G8_STAGE(G8_SB(1, 1), cB1 + kstep, voffB[0], voffB[1]);
    G8_WAIT_V(6); G8_BAR;
    for (;;) {
        const bool has_next = S.next(ui + 1, nxt);
        const char* nA0 = has_next ? nxt.a0 : cA0; const char* nA1 = has_next ? nxt.a1 : cA1; const char* nB0 = has_next ? nxt.b0 : cB0; const char* nB1 = has_next ? nxt.b1 : cB1;
        if constexpr (GATHER) {
            if (has_next) { const LAS int* rw = S.rows(ui + 1);
#pragma unroll
                for (int h = 0; h < 2; ++h)
#pragma unroll
                    for (int i = 0; i < 2; ++i) vn[h][i] = (unsigned)rw[h * 128 + sR[i]] * lda2 + (unsigned)sC[i] * 2u; }
            else {
#pragma unroll
                for (int h = 0; h < 2; ++h)
#pragma unroll
                    for (int i = 0; i < 2; ++i) vn[h][i] = vc[h][i]; }
        }
#pragma nounroll
        for (int t = 0; t < nt; t += 2) {
            const bool last = (t == nt - 2);
            const char* a1_1 = cA1 + (size_t)(t + 1) * kstep;
            const char* a2_0 = last ? nA0 : cA0 + (size_t)(t + 2) * kstep; const char* a2_1 = last ? nA1 : cA1 + (size_t)(t + 2) * kstep;
            const char* b2_0 = last ? nB0 : cB0 + (size_t)(t + 2) * kstep; const char* b2_1 = last ? nB1 : cB1 + (size_t)(t + 2) * kstep;
            unsigned w00 = vc[0][0], w01 = vc[0][1], w10 = vc[1][0], w11 = vc[1][1];
            if constexpr (GATHER) { if (last) { w00 = vn[0][0]; w01 = vn[0][1]; w10 = vn[1][0]; w11 = vn[1][1]; } }
            G8_LDB(B0, 0, 0); G8_SCHED; G8_LDA(At, 0, 0); G8_STAGE(G8_SA(1, 1), a1_1, vc[1][0], vc[1][1]);
            G8_WAIT_L(8); G8_BAR; G8_WAIT_L(0); G8_MMA(0, 0, At, B0); G8_BAR; G8_SCHED;
            G8_LDB(B1, 0, 1); G8_STAGE(G8_SB(0, 0), b2_0, voffB[0], voffB[1]);
            G8_BAR; G8_WAIT_L(0); G8_MMA(0, 1, At, B1); G8_BAR;
            G8_LDA(At, 0, 1); G8_STAGE(G8_SA(0, 0), a2_0, w00, w01);
            G8_BAR; G8_WAIT_L(0); G8_MMA(1, 0, At, B0); G8_BAR; G8_SCHED;
            G8_STAGE(G8_SB(0, 1), b2_1, voffB[0], voffB[1]);
            G8_WAIT_V(6); G8_BAR; G8_MMA(1, 1, At, B1); G8_BAR;
            G8_LDB(B0, 1, 0); G8_SCHED; G8_LDA(At, 1, 0); G8_STAGE(G8_SA(0, 1), a2_1, w10, w11);
            G8_WAIT_L(8); G8_BAR; G8_WAIT_L(0); G8_MMA(0, 0, At, B0); G8_BAR; G8_SCHED;
            G8_LDB(B1, 1, 1); G8_STAGE(G8_SB(1, 0), b2_0 + kstep, voffB[0], voffB[1]);
            G8_BAR; G8_WAIT_L(0); G8_MMA(0, 1, At, B1); G8_BAR;
            G8_LDA(At, 1, 1); G8_STAGE(G8_SA(1, 0), a2_0 + kstep, w00, w01);
            G8_BAR; G8_WAIT_L(0); G8_MMA(1, 0, At, B0); G8_BAR; G8_SCHED;
            G8_STAGE(G8_SB(1, 1), b2_1 + kstep, voffB[0], voffB[1]);
            G8_WAIT_V(6); G8_BAR; G8_MMA(1, 1, At, B1); G8_BAR;
        }
        if constexpr (F8) {
#define G8_T(a, b, m) "+v"(acc[a][b][m][0]), "+v"(acc[a][b][m][1])
            asm volatile("s_nop 15\n\ts_nop 15" : G8_T(0, 0, 0), G8_T(0, 0, 1), G8_T(0, 0, 2), G8_T(0, 0, 3), G8_T(0, 1, 0), G8_T(0, 1, 1), G8_T(0, 1, 2), G8_T(0, 1, 3));
            asm volatile("s_nop 1" : G8_T(1, 0, 0), G8_T(1, 0, 1), G8_T(1, 0, 2), G8_T(1, 0, 3), G8_T(1, 1, 0), G8_T(1, 1, 1), G8_T(1, 1, 2), G8_T(1, 1, 3));
#undef G8_T
        }
        E(acc, cur, wr, wc, fr, fq);
        if (!has_next) break;
#pragma unroll
        for (int a = 0; a < 2; ++a)
#pragma unroll
            for (int b = 0; b < 2; ++b)
#pragma unroll
                for (int m = 0; m < 4; ++m)
#pragma unroll
                    for (int n = 0; n < 2; ++n) acc[a][b][m][n] = (f32x4){0.f, 0.f, 0.f, 0.f};
        cur = nxt; cA0 = nA0; cA1 = nA1; cB0 = nB0; cB1 = nB1; ++ui;
        if constexpr (GATHER) {
#pragma unroll
            for (int h = 0; h < 2; ++h)
#pragma unroll
                for (int i = 0; i < 2; ++i) vc[h][i] = vn[h][i]; }
    }
    G8_WAIT_V(0);
    if (wr == 0) G8_BAR;
    G8_BAR;
#undef G8_SA
#undef G8_SB
#undef G8_STAGE
#undef G8_LDA
#undef G8_LDB
#undef G8_MMA
#undef G8_CAT
}
}
using g8::GU;

#define EPI_ARGS const f32x4 (&acc)[2][2][4][2], const GU& u, int wr, int wc, int fr, int fq

__device__ __forceinline__ size_t qk_tile_off(int b, int h, int t, int NH) { return ((size_t)(b * NH + h) * 128 + (t >> 5)) * 2048 + (size_t)(t & 31) * 8; }
__device__ __forceinline__ size_t v_tile_off(int b, int h, int tile, int NH) { return ((size_t)(b * NH + h) * 128 + tile) * 2048; }
struct EpiVt {
    static constexpr bool PERM = true;
    bf16_t* V; int NH;
    __device__ __forceinline__ void operator()(EPI_ARGS) const {
        const int row0 = u.p0 * 256 + wr * 64 + fr, col0 = u.p1 * 256 + wc * 32 + 8 * fq;
#pragma unroll
        for (int ai = 0; ai < 2; ++ai)
#pragma unroll
            for (int m = 0; m < 4; ++m) { const int feat = row0 + ai * 128 + m * 16, h = feat >> 6, d = feat & 63, db = d >> 5, r = d & 31;
#pragma unroll
                for (int bj = 0; bj < 2; ++bj) { const int col = col0 + bj * 128, b = col >> 12, t = col & 4095, mm = (t & 31) >> 3, sI = mm >> 1, jg = mm & 1;
                    const f32x4 v0 = acc[ai][bj][m][0], v1 = acc[ai][bj][m][1];
                    bf16_t* p = V + v_tile_off(b, h, t >> 5, NH) + (size_t)((((db * 2 + sI) * 2) * 32 + r) * 8 + jg * 4);
                    u32x2 w0, w1; w0.x = cvt_pk_bf16(v0[0], v0[1]); w0.y = cvt_pk_bf16(v0[2], v0[3]); w1.x = cvt_pk_bf16(v1[0], v1[1]); w1.y = cvt_pk_bf16(v1[2], v1[3]);
                    *(u32x2*)p = w0; *(u32x2*)(p + 256) = w1; } }
    }
};

struct EpiStoreBf16 {
    static constexpr bool PERM = true;
    bf16_t* O; size_t ld; float scale;
    __device__ __forceinline__ void operator()(EPI_ARGS) const {
        const int row0 = u.p0 * 256 + wr * 64 + fr, col0 = u.p1 * 256 + wc * 32 + 8 * fq;
#pragma unroll
        for (int ai = 0; ai < 2; ++ai)
#pragma unroll
            for (int m = 0; m < 4; ++m) { bf16_t* rowp = O + (size_t)(row0 + ai * 128 + m * 16) * ld + col0;
#pragma unroll
                for (int bj = 0; bj < 2; ++bj) { const f32x4 v0 = acc[ai][bj][m][0] * scale, v1 = acc[ai][bj][m][1] * scale;
                    u32x4 w; w.x = cvt_pk_bf16(v0[0], v0[1]); w.y = cvt_pk_bf16(v0[2], v0[3]); w.z = cvt_pk_bf16(v1[0], v1[1]); w.w = cvt_pk_bf16(v1[2], v1[3]);
                    *(u32x4*)(rowp + bj * 128) = w; } }
    }
};
struct EpiInAB {
    static constexpr bool PERM = true;
    bf16_t* A2; bf16_t* Q; bf16_t* Kk;
    __device__ __forceinline__ void operator()(EPI_ARGS) const {
        const int row0 = u.p0 * 256 + wr * 64 + fr, colt = u.p1 * 256 + wc * 32 + 8 * fq; const int kind = u.p1 >> 1;
        const float sc = (kind == 1) ? QSCALE : 1.0f;
#pragma unroll
        for (int ai = 0; ai < 2; ++ai)
#pragma unroll
            for (int m = 0; m < 4; ++m) { const int row = row0 + ai * 128 + m * 16;
#pragma unroll
                for (int bj = 0; bj < 2; ++bj) { const f32x4 v0 = acc[ai][bj][m][0] * sc, v1 = acc[ai][bj][m][1] * sc; const int col = colt + bj * 128;
                    u32x4 w; w.x = cvt_pk_bf16(v0[0], v0[1]); w.y = cvt_pk_bf16(v0[2], v0[3]); w.z = cvt_pk_bf16(v1[0], v1[1]); w.w = cvt_pk_bf16(v1[2], v1[3]);
                    bf16_t* p;
                    if (kind == 0) { const int g = col >> 4, hp = col & 15, b = row >> 12, l = row & 4095; p = A2 + ((size_t)(g * 1024 + b * NCH + (l >> 5)) * A2LD + (l & 31) * 16 + hp); }
                    else { const int cc = col - (kind == 1 ? 512 : 1024); p = (kind == 1 ? Q : Kk) + qk_tile_off(row >> 12, cc >> 6, row & 4095, 8) + (size_t)((cc & 63) >> 3) * 256; }
                    *(u32x4*)p = w; } }
    }
};
struct EpiInC {
    static constexpr bool PERM = true;
    bf16_t* Q; bf16_t* Kk;
    __device__ __forceinline__ void operator()(EPI_ARGS) const {
        const int row0 = u.p0 * 256 + wr * 64 + fr; const bool isq = u.p1 < 4; const int col0 = (u.p1 & 3) * 256 + wc * 32 + 8 * fq;
        const float sc = isq ? QSCALE : 1.0f; bf16_t* base = isq ? Q : Kk;
#pragma unroll
        for (int ai = 0; ai < 2; ++ai)
#pragma unroll
            for (int m = 0; m < 4; ++m) { const int row = row0 + ai * 128 + m * 16;
#pragma unroll
                for (int bj = 0; bj < 2; ++bj) { const f32x4 v0 = acc[ai][bj][m][0] * sc, v1 = acc[ai][bj][m][1] * sc; const int col = col0 + bj * 128;
                    u32x4 w; w.x = cvt_pk_bf16(v0[0], v0[1]); w.y = cvt_pk_bf16(v0[2], v0[3]); w.z = cvt_pk_bf16(v1[0], v1[1]); w.w = cvt_pk_bf16(v1[2], v1[3]);
                    *(u32x4*)(base + qk_tile_off(row >> 12, col >> 6, row & 4095, 16) + (size_t)((col & 63) >> 3) * 256) = w; } }
    }
};
struct EpiS {
    static constexpr bool PERM = false;
    float* S;
    __device__ __forceinline__ void operator()(EPI_ARGS) const {
        const int row0 = u.p0 * 256 + wr * 64 + fr, col0 = wc * 32 + 4 * fq; float* base = S + (size_t)u.p2 * 1024 * 128;
#pragma unroll
        for (int ai = 0; ai < 2; ++ai)
#pragma unroll
            for (int m = 0; m < 4; ++m) { float* rowp = base + (size_t)(row0 + ai * 128 + m * 16) * 128 + col0;
#pragma unroll
                for (int n = 0; n < 2; ++n) *(f32x4*)(rowp + n * 16) = acc[ai][0][m][n]; }
    }
};
__device__ __forceinline__ float gelu_tanh(float x) { const float a = 0.7978845608f * (x + 0.044715f * x * x * x); return x * rcp(1.0f + ex2(-2.0f * LOG2E * a)); }
struct EpiY {
    static constexpr bool PERM = true;
    bf16_t* Z;
    __device__ __forceinline__ void operator()(EPI_ARGS) const {
        const int row0 = u.p0 * 256 + wr * 64 + fr, col0 = u.p1 * 256 + wc * 32 + 8 * fq, g = u.p2;
#pragma unroll
        for (int ai = 0; ai < 2; ++ai)
#pragma unroll
            for (int m = 0; m < 4; ++m) { const int row = row0 + ai * 128 + m * 16, b = row >> 7, ch = row & 127;
#pragma unroll
                for (int bj = 0; bj < 2; ++bj) { const int col = col0 + bj * 128, t = col >> 4, h = col & 15; const f32x4 v0 = acc[ai][bj][m][0], v1 = acc[ai][bj][m][1];
                    u32x4 w; w.x = cvt_pk_bf16(gelu_tanh(v0[0]), gelu_tanh(v0[1])); w.y = cvt_pk_bf16(gelu_tanh(v0[2]), gelu_tanh(v0[3]));
                    w.z = cvt_pk_bf16(gelu_tanh(v1[0]), gelu_tanh(v1[1])); w.w = cvt_pk_bf16(gelu_tanh(v1[2]), gelu_tanh(v1[3]));
                    *(u32x4*)(Z + (size_t)(b * SEQ + ch * TCH + t) * 512 + g * 16 + h) = w; } }
    }
};
struct EpiGlu {
    static constexpr bool PERM = true;
    const bf16_t* Z; const float* bias; bf16_t* Y;
    __device__ __forceinline__ void operator()(EPI_ARGS) const {
        const int row0 = u.p0 * 256 + wr * 64 + fr, col0 = u.p1 * 256 + wc * 32 + 8 * fq;
#pragma unroll
        for (int bj = 0; bj < 2; ++bj) { const int col = col0 + bj * 128; const f32x4 b0 = *(const f32x4*)(bias + col), b1 = *(const f32x4*)(bias + col + 4);
#pragma unroll
            for (int ai = 0; ai < 2; ++ai)
#pragma unroll
                for (int m = 0; m < 4; ++m) { const int row = row0 + ai * 128 + m * 16; const u32x4 zz = *(const u32x4*)(Z + (size_t)row * 512 + col);
                    const f32x4 v0 = acc[ai][bj][m][0] + b0, v1 = acc[ai][bj][m][1] + b1;
                    u32x4 w; w.x = cvt_pk_bf16(bf_lo(zz.x) * sigmoidf_(v0[0]), bf_hi(zz.x) * sigmoidf_(v0[1])); w.y = cvt_pk_bf16(bf_lo(zz.y) * sigmoidf_(v0[2]), bf_hi(zz.y) * sigmoidf_(v0[3]));
                    w.z = cvt_pk_bf16(bf_lo(zz.z) * sigmoidf_(v1[0]), bf_hi(zz.z) * sigmoidf_(v1[1])); w.w = cvt_pk_bf16(bf_lo(zz.w) * sigmoidf_(v1[2]), bf_hi(zz.w) * sigmoidf_(v1[3]));
                    *(u32x4*)(Y + (size_t)row * 1024 + col) = w; } }
    }
};
struct EpiRes {
    static constexpr bool PERM = false;
    const float* res; float* out;
    __device__ __forceinline__ void operator()(EPI_ARGS) const {
        const int row0 = u.p0 * 256 + wr * 64 + fr, col0 = u.p1 * 256 + wc * 32 + 4 * fq;
#pragma unroll
        for (int ai = 0; ai < 2; ++ai)
#pragma unroll
            for (int m = 0; m < 4; ++m) { const size_t ro = (size_t)(row0 + ai * 128 + m * 16) * 1024 + col0;
#pragma unroll
                for (int bj = 0; bj < 2; ++bj)
#pragma unroll
                    for (int n = 0; n < 2; ++n) { const size_t o = ro + bj * 128 + n * 16; *(f32x4*)(out + o) = *(const f32x4*)(res + o) + acc[ai][bj][m][n]; } }
    }
};
struct EpiSwiglu {
    static constexpr bool PERM = true;
    const float* bg; const float* bu; unsigned char* act;
    __device__ __forceinline__ void operator()(EPI_ARGS) const {
        const int row0 = u.p0 + wr * 64 + fr, col = u.p1 + wc * 32 + 8 * fq; const float* pg = bg + (size_t)u.p2 * 1024 + col; const float* pu = bu + (size_t)u.p2 * 1024 + col;
        const f32x4 g0 = *(const f32x4*)pg, g1 = *(const f32x4*)(pg + 4), u0 = *(const f32x4*)pu, u1 = *(const f32x4*)(pu + 4);
#pragma unroll
        for (int ai = 0; ai < 2; ++ai)
#pragma unroll
            for (int m = 0; m < 4; ++m) { float r[8];
#pragma unroll
                for (int n = 0; n < 2; ++n)
#pragma unroll
                    for (int j = 0; j < 4; ++j) { const float gg = fminf(acc[ai][0][m][n][j] * (1.0f / W8_SCALE) + (n ? g1[j] : g0[j]), 7.0f); const float uu = fminf(fmaxf(acc[ai][1][m][n][j] * (1.0f / W8_SCALE) + (n ? u1[j] : u0[j]), -7.0f), 7.0f);
                        r[n * 4 + j] = gg * sigmoidf_(1.702f * gg) * (uu + 1.0f); }
                u32x2 w; w.x = cvt_pk4_fp8(r[0], r[1], r[2], r[3]); w.y = cvt_pk4_fp8(r[4], r[5], r[6], r[7]);
                *(u32x2*)(act + (size_t)(row0 + ai * 128 + m * 16) * 1024 + col) = w; }
    }
};
struct EpiDown {
    static constexpr bool PERM = true;
    const float* bd; bf16_t* ys;
    __device__ __forceinline__ void operator()(EPI_ARGS) const {
        const int row0 = u.p0 + wr * 64 + fr, col0 = u.p1 + wc * 32 + 8 * fq;
#pragma unroll
        for (int bj = 0; bj < 2; ++bj) { const int col = col0 + bj * 128; const float* pb = bd + (size_t)u.p2 * 1024 + col; const f32x4 b0 = *(const f32x4*)pb, b1 = *(const f32x4*)(pb + 4);
#pragma unroll
            for (int ai = 0; ai < 2; ++ai)
#pragma unroll
                for (int m = 0; m < 4; ++m) { const f32x4 v0 = acc[ai][bj][m][0] * (1.0f / W8_SCALE) + b0, v1 = acc[ai][bj][m][1] * (1.0f / W8_SCALE) + b1;
                    u32x4 w; w.x = cvt_pk_bf16(v0[0], v0[1]); w.y = cvt_pk_bf16(v0[2], v0[3]); w.z = cvt_pk_bf16(v1[0], v1[1]); w.w = cvt_pk_bf16(v1[2], v1[3]);
                    *(u32x4*)(ys + (size_t)(row0 + ai * 128 + m * 16) * 1024 + col) = w; } }
    }
};
struct EpiPle {
    static constexpr bool PERM = true;
    const bf16_t* proj; float* r;
    __device__ __forceinline__ void operator()(EPI_ARGS) const {
        const int row0 = u.p0 * 256 + wr * 64 + fr, col0 = u.p1 * 256 + wc * 32 + 8 * fq;
#pragma unroll
        for (int ai = 0; ai < 2; ++ai)
#pragma unroll
            for (int m = 0; m < 4; ++m) { const size_t ro = (size_t)(row0 + ai * 128 + m * 16) * 1024 + col0;
#pragma unroll
                for (int bj = 0; bj < 2; ++bj) { const size_t o = ro + bj * 128; const u32x4 pp = *(const u32x4*)(proj + o); const f32x4 r0 = *(const f32x4*)(r + o), r1 = *(const f32x4*)(r + o + 4);
                    const f32x4 v0 = acc[ai][bj][m][0], v1 = acc[ai][bj][m][1];
                    f32x4 o0, o1;
                    o0[0] = r0[0] + bf_lo(pp.x) * sigmoidf_(v0[0]); o0[1] = r0[1] + bf_hi(pp.x) * sigmoidf_(v0[1]); o0[2] = r0[2] + bf_lo(pp.y) * sigmoidf_(v0[2]); o0[3] = r0[3] + bf_hi(pp.y) * sigmoidf_(v0[3]);
                    o1[0] = r1[0] + bf_lo(pp.z) * sigmoidf_(v1[0]); o1[1] = r1[1] + bf_hi(pp.z) * sigmoidf_(v1[1]); o1[2] = r1[2] + bf_lo(pp.w) * sigmoidf_(v1[2]); o1[3] = r1[3] + bf_hi(pp.w) * sigmoidf_(v1[3]);
                    *(f32x4*)(r + o) = o0; *(f32x4*)(r + o + 4) = o1; } }
    }
};

struct Args { const float* in[31]; float* out; unsigned char* ws; int ph_lo, ph_hi; unsigned char btab[128]; };
struct Frame {
    LAS unsigned char* lds; int tid, lane, wave, G, bid, gw, GW;
    unsigned char* ws; unsigned* ctl;
};
enum { I_X = 0, I_P, I_NMIX, I_NFFN, I_NPLE, I_NFINAL, I_WINAB, I_ARE, I_AIM, I_BRE, I_BIM, I_CRE, I_CIM, I_SSMD, I_LOGSTEP, I_GLUW, I_GLUB, I_WOUTAB, I_RELB, I_WINC, I_WOUTC,
       I_RW, I_RB, I_WG, I_BG, I_WU, I_BU, I_WD, I_BD, I_WPLE, I_WPLEG };

__device__ __forceinline__ void tconv(const Frame& F, const float* __restrict__ src, bf16_t* __restrict__ dst, int K, int N, int nmat) {
    LAS unsigned* T = (LAS unsigned*)(F.lds + F.wave * 8192);
    const int tk = K >> 6, tn = N >> 6; const long ntiles = (long)nmat * tk * tn;
    const int lane = F.lane, nq = lane & 15, kk = lane >> 4;
    for (long tt = F.gw; tt < ntiles; tt += F.GW) {
        const int mat = (int)(tt / (tk * tn)), rem = (int)(tt % (tk * tn)), kt = rem / tn, ntl = rem % tn;
        const float* s = src + (size_t)mat * K * N + (size_t)(kt * 64) * N + ntl * 64;
        bf16_t* d = dst + (size_t)mat * N * K + (size_t)(ntl * 64) * K + kt * 64;
#pragma unroll
        for (int it = 0; it < 8; ++it) { const int k0 = 8 * it + 2 * kk;
            const f32x4 a = *(const f32x4*)(s + (size_t)k0 * N + 4 * nq), b = *(const f32x4*)(s + (size_t)(k0 + 1) * N + 4 * nq);
#pragma unroll
            for (int j = 0; j < 4; ++j) { const int n = 4 * nq + j, kp = 4 * it + kk; T[32 * n + (kp ^ (4 * (nq & 7)))] = cvt_pk_bf16(a[j], b[j]); } }
        __builtin_amdgcn_fence(__ATOMIC_RELEASE, "wavefront"); __builtin_amdgcn_wave_barrier(); __builtin_amdgcn_fence(__ATOMIC_ACQUIRE, "wavefront");
#pragma unroll
        for (int it = 0; it < 8; ++it) { const int n = 8 * it + (lane >> 3), c = lane & 7;
            const u32x4 v = *(const LAS u32x4*)(T + 32 * n + 4 * (c ^ ((n >> 2) & 7)));
            *(u32x4*)(d + (size_t)n * K + 8 * c) = v; }
        __builtin_amdgcn_fence(__ATOMIC_RELEASE, "wavefront"); __builtin_amdgcn_wave_barrier(); __builtin_amdgcn_fence(__ATOMIC_ACQUIRE, "wavefront");
    }
}
__device__ __forceinline__ void tconv8(const Frame& F, const float* __restrict__ src, unsigned char* __restrict__ dst, int K, int N, int nmat, float sc) {
    LAS unsigned* T = (LAS unsigned*)(F.lds + F.wave * 8192);
    const int tk = K >> 6, tn = N >> 6; const long ntiles = (long)nmat * tk * tn;
    const int lane = F.lane, nq = lane & 15, kk = lane >> 4;
    for (long tt = F.gw; tt < ntiles; tt += F.GW) {
        const int mat = (int)(tt / (tk * tn)), rem = (int)(tt % (tk * tn)), kt = rem / tn, ntl = rem % tn;
        const float* s = src + (size_t)mat * K * N + (size_t)(kt * 64) * N + ntl * 64;
        unsigned char* d = dst + (size_t)mat * N * K + (size_t)(ntl * 64) * K + kt * 64;
#pragma unroll
        for (int it = 0; it < 4; ++it) { const int k0 = 16 * it + 4 * kk; f32x4 a[4];
#pragma unroll
            for (int q = 0; q < 4; ++q) a[q] = *(const f32x4*)(s + (size_t)(k0 + q) * N + 4 * nq) * sc;
#pragma unroll
            for (int j = 0; j < 4; ++j) { const int n = 4 * nq + j; T[16 * n + (((it ^ (nq & 3)) << 2) | kk)] = cvt_pk4_fp8(a[0][j], a[1][j], a[2][j], a[3][j]); } }
        __builtin_amdgcn_fence(__ATOMIC_RELEASE, "wavefront"); __builtin_amdgcn_wave_barrier(); __builtin_amdgcn_fence(__ATOMIC_ACQUIRE, "wavefront");
#pragma unroll
        for (int it = 0; it < 4; ++it) { const int n = 16 * it + (lane >> 2), c = lane & 3;
            const u32x4 v = *(const LAS u32x4*)(T + 16 * n + 4 * (c ^ ((n >> 2) & 3)));
            *(u32x4*)(d + (size_t)n * K + 16 * c) = v; }
        __builtin_amdgcn_fence(__ATOMIC_RELEASE, "wavefront"); __builtin_amdgcn_wave_barrier(); __builtin_amdgcn_fence(__ATOMIC_ACQUIRE, "wavefront");
    }
}
__device__ __forceinline__ void conv_plain(const Frame& F, const float* __restrict__ src, bf16_t* __restrict__ dst, size_t n) {
    const size_t nth = (size_t)F.G * 512;
    for (size_t i = ((size_t)F.bid * 512 + F.tid) * 8; i < n; i += nth * 8) { const f32x4 a = *(const f32x4*)(src + i), b = *(const f32x4*)(src + i + 4);
        u32x4 w; w.x = cvt_pk_bf16(a[0], a[1]); w.y = cvt_pk_bf16(a[2], a[3]); w.z = cvt_pk_bf16(b[0], b[1]); w.w = cvt_pk_bf16(b[2], b[3]); *(u32x4*)(dst + i) = w; }
}
template <bool F32OUT>
__device__ __forceinline__ void rmsnorm_rows(const Frame& F, const float* __restrict__ src, const float* __restrict__ gain, bf16_t* __restrict__ dst, float* outf, int nrows) {
    const int lane = F.lane;
    f32x4 gv[4];
#pragma unroll
    for (int j = 0; j < 4; ++j) gv[j] = *(const f32x4*)(gain + 4 * (lane + 64 * j));
    for (int row = F.gw; row < nrows; row += F.GW) {
        const float* s = src + (size_t)row * 1024; f32x4 v[4]; float ss = 0.f;
#pragma unroll
        for (int j = 0; j < 4; ++j) { v[j] = *(const f32x4*)(s + 4 * (lane + 64 * j)); ss += v[j][0] * v[j][0] + v[j][1] * v[j][1] + v[j][2] * v[j][2] + v[j][3] * v[j][3]; }
        ss = wave_sum(ss); const float rstd = rsqrtf(ss * (1.0f / 1024.0f) + RMS_EPS);
#pragma unroll
        for (int j = 0; j < 4; ++j) { const f32x4 y = v[j] * rstd * gv[j];
            if (F32OUT) *(f32x4*)(outf + (size_t)row * 1024 + 4 * (lane + 64 * j)) = y;
            else { u32x2 w; w.x = cvt_pk_bf16(y[0], y[1]); w.y = cvt_pk_bf16(y[2], y[3]); *(u32x2*)(dst + (size_t)row * 1024 + 4 * (lane + 64 * j)) = w; } }
    }
}

__device__ __forceinline__ void s5_matrices(const Frame& F, const Args& a) {
    LAS float* Pr = (LAS float*)F.lds;
    LAS float* Pi = Pr + 33 * 64;
    LAS float* Br = Pi + 33 * 64;
    LAS float* Bi = Br + 1024;
    LAS float* Cr = Bi + 1024;
    LAS float* Ci = Cr + 1024;
    LAS float* Kf = Ci + 1024;
    LAS float* coefr = Kf + 8192; LAS float* coefi = coefr + 64;
    bf16_t* WbT = (bf16_t*)(F.ws + WS_WBT); bf16_t* My = (bf16_t*)(F.ws + WS_MY);
    const int t = F.tid;
    for (int g = F.bid; g < NGRP; g += F.G) {
        __syncthreads();
        if (t < 64) { const int n = t; const float are = a.in[I_ARE][g * 64 + n], aim = a.in[I_AIM][g * 64 + n], step = __expf(a.in[I_LOGSTEP][g]);
            for (int d = 0; d <= 32; ++d) { const float mag = __expf(are * step * (float)d); float rev = aim * step * (float)d * 0.15915494309189535f; rev -= rintf(rev);
                Pr[d * 64 + n] = mag * __builtin_amdgcn_cosf(rev); Pi[d * 64 + n] = mag * __builtin_amdgcn_sinf(rev); }
            const float lr = Pr[64 + n] - 1.0f, li = Pi[64 + n], den = 1.0f / (are * are + aim * aim);
            coefr[n] = (lr * are + li * aim) * den; coefi[n] = (li * are - lr * aim) * den; }
        __syncthreads();
        for (int idx = t; idx < 1024; idx += 512) { const int n = idx >> 4; const float br = a.in[I_BRE][g * 1024 + idx], bi = a.in[I_BIM][g * 1024 + idx];
            Br[idx] = coefr[n] * br - coefi[n] * bi; Bi[idx] = coefr[n] * bi + coefi[n] * br;
            Cr[idx] = a.in[I_CRE][g * 1024 + idx]; Ci[idx] = a.in[I_CIM][g * 1024 + idx]; }
        __syncthreads();
        { const int hh = t & 255, h = hh >> 4, hp = hh & 15;
          for (int d = t >> 8; d < 32; d += 2) { float s = 0.f;
              for (int n = 0; n < 64; ++n) { const float cr = Cr[h * 64 + n], ci = Ci[h * 64 + n], pr = Pr[d * 64 + n], pi = Pi[d * 64 + n];
                  const float mr = cr * pr - ci * pi, mi = cr * pi + ci * pr; s += mr * Br[n * 16 + hp] - mi * Bi[n * 16 + hp]; }
              if (d == 0 && h == hp) s += a.in[I_SSMD][g * 16 + h];
              Kf[d * 256 + hh] = s; } }
        __syncthreads();
        for (int ch = t; ch < 256 * 64; ch += 512) { const int row = ch >> 6, k0 = (ch & 63) * 8, s = k0 >> 4, hp0 = k0 & 15; float v[8];
            if (row < 128) { const int n = row & 63; const float pr = Pr[(31 - s) * 64 + n], pi = Pi[(31 - s) * 64 + n];
#pragma unroll
                for (int j = 0; j < 8; ++j) { const float br = Br[n * 16 + hp0 + j], bi = Bi[n * 16 + hp0 + j]; v[j] = (row < 64) ? (pr * br - pi * bi) : (pr * bi + pi * br); } }
            else {
#pragma unroll
                for (int j = 0; j < 8; ++j) v[j] = 0.f; }
            u32x4 w; w.x = cvt_pk_bf16(v[0], v[1]); w.y = cvt_pk_bf16(v[2], v[3]); w.z = cvt_pk_bf16(v[4], v[5]); w.w = cvt_pk_bf16(v[6], v[7]);
            *(u32x4*)(WbT + ((size_t)g * 256 + row) * 512 + k0) = w; }
        for (int ch = t; ch < 512 * 80; ch += 512) { const int row = ch / 80, k0 = (ch % 80) * 8, tt = row >> 4, h = row & 15; float v[8];
            if (k0 < 512) { const int s = k0 >> 4, hp0 = k0 & 15;
#pragma unroll
                for (int j = 0; j < 8; ++j) v[j] = (s <= tt) ? Kf[(tt - s) * 256 + h * 16 + hp0 + j] : 0.f; }
            else { const int n0 = (k0 - 512) & 63; const bool im = k0 >= 576;
#pragma unroll
                for (int j = 0; j < 8; ++j) { const int n = n0 + j; const float cr = Cr[h * 64 + n], ci = Ci[h * 64 + n], pr = Pr[(tt + 1) * 64 + n], pi = Pi[(tt + 1) * 64 + n];
                    v[j] = im ? -(cr * pi + ci * pr) : (cr * pr - ci * pi); } }
            u32x4 w; w.x = cvt_pk_bf16(v[0], v[1]); w.y = cvt_pk_bf16(v[2], v[3]); w.z = cvt_pk_bf16(v[4], v[5]); w.w = cvt_pk_bf16(v[6], v[7]);
            *(u32x4*)(My + ((size_t)g * 512 + row) * A2LD + k0) = w; }
    }
    __syncthreads();
}

__device__ __forceinline__ void conv_moe_weights(const Frame& F, const Args& a, int layer) {
    unsigned char* W = (unsigned char*)(F.ws + WS_MOEW); const size_t L = (size_t)NEXP * 1024 * 1024;
    tconv8(F, a.in[I_WG] + layer * L, W, 1024, 1024, NEXP, W8_SCALE);
    tconv8(F, a.in[I_WU] + layer * L, W + L, 1024, 1024, NEXP, W8_SCALE);
    tconv8(F, a.in[I_WD] + layer * L, W + 2 * L, 1024, 1024, NEXP, W8_SCALE);
}

__device__ __forceinline__ void p0_prologue(const Frame& F, const Args& a) {
    s5_matrices(F, a);
    tconv(F, a.in[I_WINAB], (bf16_t*)(F.ws + WS_WINAB), 1024, 2048, 1);
    tconv(F, a.in[I_GLUW], (bf16_t*)(F.ws + WS_GLU), 512, 512, 1);
    tconv(F, a.in[I_WOUTAB], (bf16_t*)(F.ws + WS_WOUTAB), 1024, 1024, 1);
    tconv(F, a.in[I_WINC], (bf16_t*)(F.ws + WS_WINC), 1024, 3072, 1);
    tconv(F, a.in[I_WOUTC], (bf16_t*)(F.ws + WS_WOUTC), 1024, 1024, 1);
    tconv(F, a.in[I_WPLE], (bf16_t*)(F.ws + WS_WPLE), 256, 1024, 2);
    tconv(F, a.in[I_WPLEG], (bf16_t*)(F.ws + WS_WPLEG), 1024, 1024, 2);
    conv_moe_weights(F, a, 0);
    conv_plain(F, a.in[I_P], (bf16_t*)(F.ws + WS_PB), (size_t)2 * NTOK * PLE);
    rmsnorm_rows<false>(F, a.in[I_X], a.in[I_NMIX], (bf16_t*)(F.ws + WS_H), nullptr, NTOK);
}

__device__ __forceinline__ void s5_scan(const Frame& F, const Args& a) {
    const float* S = (const float*)(F.ws + RA_SS); bf16_t* A2 = (bf16_t*)(F.ws + RA_A2);
    const int n = F.lane;
    for (int item = F.gw; item < NGRP * NBATCH; item += F.GW) {
        const int g = item >> 3, b = item & 7;
        const float are = a.in[I_ARE][g * 64 + n], aim = a.in[I_AIM][g * 64 + n], step = __expf(a.in[I_LOGSTEP][g]);
        const float mag = __expf(are * step * 32.0f); float rev = aim * step * 32.0f * 0.15915494309189535f; rev -= rintf(rev);
        const float lr = mag * __builtin_amdgcn_cosf(rev), li = mag * __builtin_amdgcn_sinf(rev);
        float xr = 0.f, xi = 0.f;
        const float* sp = S + ((size_t)g * 1024 + b * NCH) * 128 + n; bf16_t* xp = A2 + ((size_t)g * 1024 + b * NCH) * A2LD + 512 + n;
        for (int c0 = 0; c0 < NCH; c0 += 16) {
            float sr[16], si[16];
#pragma unroll
            for (int j = 0; j < 16; ++j) { sr[j] = sp[(size_t)(c0 + j) * 128]; si[j] = sp[(size_t)(c0 + j) * 128 + 64]; }
#pragma unroll
            for (int j = 0; j < 16; ++j) { xp[(size_t)(c0 + j) * A2LD] = f2bf(xr); xp[(size_t)(c0 + j) * A2LD + 64] = f2bf(xi);
                const float nr = lr * xr - li * xi + sr[j], ni = lr * xi + li * xr + si[j]; xr = nr; xi = ni; }
        }
    }
}

__device__ __forceinline__ void moba_kmean(const Frame& F) {
    const bf16_t* Kk = (const bf16_t*)(F.ws + RA_K0); float* KM = (float*)(F.ws + RB_KMEAN);
    const int lane = F.lane;
    for (int item = F.gw; item < NBATCH * MH * NMB; item += F.GW) {
        const int j = item & 15, h = (item >> 4) & 7, b = item >> 7;
        const bf16_t* p = Kk + qk_tile_off(b, h, j * MBLK, 8) + (size_t)lane * 8;
        float s[4][8];
#pragma unroll
        for (int q = 0; q < 4; ++q)
#pragma unroll
            for (int i = 0; i < 8; ++i) s[q][i] = 0.f;
        for (int it4 = 0; it4 < 8; ++it4) {
#pragma unroll
            for (int q = 0; q < 4; ++q) { const u32x4 v = *(const u32x4*)(p + (size_t)(it4 * 4 + q) * 512);
                s[q][0] += bf_lo(v.x); s[q][1] += bf_hi(v.x); s[q][2] += bf_lo(v.y); s[q][3] += bf_hi(v.y); s[q][4] += bf_lo(v.z); s[q][5] += bf_hi(v.z); s[q][6] += bf_lo(v.w); s[q][7] += bf_hi(v.w); } }
#pragma unroll
        for (int q = 0; q < 4; ++q)
#pragma unroll
            for (int i = 0; i < 8; ++i) { float v = s[q][i]; v += __shfl_xor(v, 1); v += __shfl_xor(v, 2); v += __shfl_xor(v, 4); v += __shfl_xor(v, 8); v += __shfl_xor(v, 16); s[q][i] = v; }
        if ((lane & 31) == 0) { const int hf = lane >> 5;
#pragma unroll
            for (int q = 0; q < 4; ++q)
#pragma unroll
                for (int i = 0; i < 8; ++i) KM[(size_t)item * 64 + (hf + 2 * q) * 8 + i] = s[q][i] * (1.0f / 256.0f); }
    }
}
__device__ __forceinline__ void moba_gate(const Frame& F) {
    const bf16_t* Q = (const bf16_t*)(F.ws + RA_Q0); const float* KM = (const float*)(F.ws + RB_KMEAN); int* LIST = (int*)(F.ws + RB_MOBALIST); unsigned* CNT = F.ctl + CW_MOBACNT;
    const int t = F.tid, sub = t >> 8, tq = t & 255;
    LAS float* km = (LAS float*)F.lds + sub * 1024;
    LAS int* lcnt = (LAS int*)(F.lds + 8192) + sub * 32;
    const int nitem = NBATCH * MH * 15;
    for (int it0 = F.bid * 2; it0 < nitem; it0 += F.G * 2) {
        const int item = it0 + sub; const bool act = item < nitem;
        const int i = act ? 1 + item % 15 : 1, bh = act ? item / 15 : 0, b = bh >> 3, h = bh & 7;
        __syncthreads();
        for (int x = tq; x < i * 64; x += 256) km[x] = KM[(size_t)bh * 1024 + x];
        if (tq < 32) lcnt[tq] = 0;
        __syncthreads();
        int sel[3] = {0, 0, 0}, lpos[3] = {0, 0, 0}; const int nsel = i < 3 ? i : 3;
        if (act) {
            const bf16_t* qp = Q + qk_tile_off(b, h, i * MBLK + tq, 8); float qv[64];
#pragma unroll
            for (int c = 0; c < 8; ++c) { const u32x4 v = *(const u32x4*)(qp + c * 256); qv[c * 8 + 0] = bf_lo(v.x); qv[c * 8 + 1] = bf_hi(v.x); qv[c * 8 + 2] = bf_lo(v.y); qv[c * 8 + 3] = bf_hi(v.y);
                qv[c * 8 + 4] = bf_lo(v.z); qv[c * 8 + 5] = bf_hi(v.z); qv[c * 8 + 6] = bf_lo(v.w); qv[c * 8 + 7] = bf_hi(v.w); }
            float v0 = -3.0e38f, v1 = -3.0e38f, v2 = -3.0e38f; int i0 = 0, i1 = 0, i2 = 0;
            for (int j = 0; j < i; ++j) { float gsum = 0.f;
#pragma unroll
                for (int d = 0; d < 64; ++d) gsum += qv[d] * km[j * 64 + d];
                if (gsum > v0) { v2 = v1; i2 = i1; v1 = v0; i1 = i0; v0 = gsum; i0 = j; } else if (gsum > v1) { v2 = v1; i2 = i1; v1 = gsum; i1 = j; } else if (gsum > v2) { v2 = gsum; i2 = j; } }
            sel[0] = i0; sel[1] = i1; sel[2] = i2;
#pragma unroll
            for (int s = 0; s < 3; ++s) if (s < nsel) lpos[s] = atomicAdd((int*)&lcnt[sel[s]], 1);
        }
        __syncthreads();
        if (act && tq < 16 && lcnt[tq] > 0) lcnt[16 + tq] = (int)__hip_atomic_fetch_add(CNT + bh * 16 + tq, (unsigned)lcnt[tq], __ATOMIC_RELAXED, __HIP_MEMORY_SCOPE_AGENT);
        __syncthreads();
        if (act) {
#pragma unroll
            for (int s = 0; s < 3; ++s) if (s < nsel) LIST[((size_t)bh * 16 + sel[s]) * 4096 + lcnt[16 + sel[s]] + lpos[s]] = (i * MBLK + tq) | (s << 12); }
    }
    __syncthreads();
}

__device__ __forceinline__ void stage_o_rows(LAS unsigned char* wl, const f32x16& o0, const f32x16& o1, float sc, int r, int hf) {
#pragma unroll
    for (int g = 0; g < 4; ++g) { u32x2 w0, w1; w0.x = cvt_pk_bf16(o0[4 * g] * sc, o0[4 * g + 1] * sc); w0.y = cvt_pk_bf16(o0[4 * g + 2] * sc, o0[4 * g + 3] * sc);
        w1.x = cvt_pk_bf16(o1[4 * g] * sc, o1[4 * g + 1] * sc); w1.y = cvt_pk_bf16(o1[4 * g + 2] * sc, o1[4 * g + 3] * sc);
        *(LAS u32x2*)(wl + r * 128 + ((g ^ (r & 7)) << 4) + hf * 8) = w0; *(LAS u32x2*)(wl + r * 128 + (((4 + g) ^ (r & 7)) << 4) + hf * 8) = w1; }
    __builtin_amdgcn_fence(__ATOMIC_RELEASE, "wavefront"); __builtin_amdgcn_wave_barrier(); __builtin_amdgcn_fence(__ATOMIC_ACQUIRE, "wavefront");
}
__device__ __forceinline__ u32x4 read_o_row(const LAS unsigned char* wl, int q, int c) { return *(const LAS u32x4*)(wl + q * 128 + ((c ^ (q & 7)) << 4)); }
struct KFrag { bf16x8 f[4]; };
__device__ __forceinline__ KFrag load_kfrag(const bf16_t* kp) { KFrag k;
#pragma unroll
    for (int s = 0; s < 4; ++s) k.f[s] = *(const bf16x8*)(kp + 512 * s);
    return k; }
struct VFrag { bf16x8 f[2][2]; };
__device__ __forceinline__ VFrag load_vfrag(const bf16_t* vp) { VFrag v;
#pragma unroll
    for (int db = 0; db < 2; ++db)
#pragma unroll
        for (int s = 0; s < 2; ++s) v.f[db][s] = *(const bf16x8*)(vp + (db * 2 + s) * 512);
    return v; }
template <bool OWN>
__device__ __forceinline__ void moba_task(const bf16_t* __restrict__ Q, const bf16_t* __restrict__ Kk, const bf16_t* __restrict__ Vt, bf16_t* __restrict__ PO, float* __restrict__ PML,
                                          const LAS float* tab, LAS unsigned char* wl, int b, int h, int tq, bool valid, int slot, int key_base, int ntile, int tmin, int lane) {
    const int r = lane & 31, hf = lane >> 5; const size_t tokb = (size_t)b * SEQ;
    bf16x8 qf[4];
    { const bf16_t* qp = Q + qk_tile_off(b, h, tq, 8) + hf * 256;
#pragma unroll
      for (int s = 0; s < 4; ++s) qf[s] = *(const bf16x8*)(qp + 512 * s); }
    const bf16_t* kbase = Kk + qk_tile_off(b, h, key_base, 8) + hf * 256 + r * 8;
    const bf16_t* vbase = Vt + v_tile_off(b, h, key_base >> 5, 8) + hf * 256 + r * 8;
    KFrag k0 = load_kfrag(kbase);
    VFrag v0 = load_vfrag(vbase);
    f32x16 o0, o1;
#pragma unroll
    for (int i = 0; i < 16; ++i) { o0[i] = 0.f; o1[i] = 0.f; }
    float m = -1.0e30f, l = 0.f; const float b31 = tab[h * 128 + 127];
    for (int kt = 0; kt < ntile; ++kt) {
        const int key0 = key_base + 32 * kt;
        const int kn1 = (kt + 1 < ntile) ? kt + 1 : ntile - 1;
        const KFrag k1 = load_kfrag(kbase + (size_t)kn1 * 2048);
        const VFrag v1 = load_vfrag(vbase + (size_t)kn1 * 2048);
        f32x16 x;
#pragma unroll
        for (int i = 0; i < 16; ++i) x[i] = 0.f;
#pragma unroll
        for (int s = 0; s < 4; ++s) x = mfma32(k0.f[s], qf[s], x);
        if (tmin - (key0 + 31) < 113) {
#pragma unroll
            for (int i = 0; i < 16; ++i) { const int row = (i & 3) + 8 * (i >> 2) + 4 * hf; const int dist = tq - (key0 + row); const int idx = dist < 0 ? 0 : (dist > 127 ? 127 : dist);
                x[i] += tab[h * 128 + idx]; if (OWN && dist < 0) x[i] = -1.0e30f; }
        } else {
#pragma unroll
            for (int i = 0; i < 16; ++i) x[i] += b31;
        }
        float mx = x[0];
#pragma unroll
        for (int i = 1; i < 16; ++i) mx = fmaxf(mx, x[i]);
        mx = fmaxf(mx, __shfl_xor(mx, 32));
        const float mn = fmaxf(m, mx), alpha = ex2(m - mn); m = mn;
        float ps = 0.f; unsigned pw[8];
#pragma unroll
        for (int i = 0; i < 8; ++i) { const float p0 = ex2(x[2 * i] - mn), p1 = ex2(x[2 * i + 1] - mn); ps += p0 + p1; pw[i] = cvt_pk_bf16(p0, p1); }
        l = l * alpha + ps;
        o0 *= alpha; o1 *= alpha;
#pragma unroll
        for (int s = 0; s < 2; ++s) { u32x4 pf; pf.x = pw[4 * s]; pf.y = pw[4 * s + 1]; pf.z = pw[4 * s + 2]; pf.w = pw[4 * s + 3];
            const bf16x8 pb = __builtin_bit_cast(bf16x8, pf);
            o0 = mfma32(v0.f[0][s], pb, o0); o1 = mfma32(v0.f[1][s], pb, o1); }
        k0 = k1; v0 = v1;
    }
    l += __shfl_xor(l, 32);
    const int pi = valid ? (int)(((tokb + tq) * 8 + h) * 4 + slot) : -1;
    stage_o_rows(wl, o0, o1, 1.0f / l, r, hf);
#pragma unroll
    for (int it = 0; it < 4; ++it) { const int q = it * 8 + (lane >> 3), c = lane & 7; const int pq = __shfl(pi, q); const u32x4 v = read_o_row(wl, q, c);
        if (pq >= 0) *(u32x4*)(PO + (size_t)pq * 64 + c * 8) = v; }
    if (valid && hf == 0) { f32x2 ml; ml.x = m; ml.y = l; *(f32x2*)(PML + (size_t)pi * 2) = ml; }
    __builtin_amdgcn_fence(__ATOMIC_RELEASE, "wavefront"); __builtin_amdgcn_wave_barrier(); __builtin_amdgcn_fence(__ATOMIC_ACQUIRE, "wavefront");
}

__device__ __forceinline__ void moba_attn(const Frame& F, const Args& a) {
    const bf16_t* Q = (const bf16_t*)(F.ws + RA_Q0); const bf16_t* Kk = (const bf16_t*)(F.ws + RA_K0); const bf16_t* Vt = (const bf16_t*)(F.ws + RA_VT0);
    bf16_t* PO = (bf16_t*)(F.ws + RB_PARTO); float* PML = (float*)(F.ws + RB_PARTML); const int* LIST = (const int*)(F.ws + RB_MOBALIST); unsigned* CNT = F.ctl + CW_MOBACNT;
    LAS float* tab = (LAS float*)F.lds;
    LAS int* pre = (LAS int*)(F.lds + 4096);
    LAS int* cnts = (LAS int*)(F.lds + 4096 + 4128);
    LAS int* wsum = (LAS int*)(F.lds + 4096 + 4128 + 4096);
    LAS unsigned char* wl = F.lds + 16384 + F.wave * 4096;
    const int t = F.tid, lane = F.lane;
    __syncthreads();
    for (int x = t; x < 1024; x += 512) { const int hh = x >> 7, dd = x & 127; tab[x] = a.in[I_RELB][a.btab[dd] * 8 + hh] * LOG2E; }
    { const int c0 = (int)__hip_atomic_load(CNT + 2 * t, __ATOMIC_RELAXED, __HIP_MEMORY_SCOPE_AGENT), c1 = (int)__hip_atomic_load(CNT + 2 * t + 1, __ATOMIC_RELAXED, __HIP_MEMORY_SCOPE_AGENT);
      cnts[2 * t] = c0; cnts[2 * t + 1] = c1; const int t0 = (c0 + 31) >> 5, t1 = (c1 + 31) >> 5; int s = t0 + t1, inc = s;
#pragma unroll
      for (int o = 1; o < 64; o <<= 1) { const int v = __shfl_up(inc, o); if (lane >= o) inc += v; }
      if (lane == 63) wsum[F.wave] = inc;
      __syncthreads();
      int base = 0; for (int w = 0; w < F.wave; ++w) base += wsum[w];
      const int ex = base + inc - s; pre[2 * t] = ex; pre[2 * t + 1] = ex + t0; if (t == 511) pre[1024] = ex + s; }
    __syncthreads();
    const int nsel = pre[1024], ntask = nsel + NBATCH * MH * NMB * 8;
    for (int task = F.gw; task < ntask; task += F.GW) {
        if (task < nsel) {
            int lo = 0, hi = 1023;
            while (lo < hi) { const int mid = (lo + hi + 1) >> 1; if (pre[mid] <= task) lo = mid; else hi = mid - 1; }
            const int list = lo, chunk = task - pre[list], cnt = cnts[list], bh = list >> 4, j = list & 15;
            const int idx = chunk * 32 + (lane & 31); const bool valid = idx < cnt; const int e = valid ? LIST[(size_t)list * 4096 + idx] : 4095;
            const int tq = e & 4095, slot = valid ? (e >> 12) : 0; int tmin = tq;
#pragma unroll
            for (int o = 32; o >= 1; o >>= 1) tmin = min(tmin, __shfl_xor(tmin, o));
            moba_task<false>(Q, Kk, Vt, PO, PML, tab, wl, bh >> 3, bh & 7, tq, valid, slot, j * MBLK, 8, tmin, lane);
        } else {
            const int o = task - nsel, qg = o & 7, i = (o >> 3) & 15, bh = o >> 7; const int t0 = i * MBLK + 32 * qg;
            moba_task<true>(Q, Kk, Vt, PO, PML, tab, wl, bh >> 3, bh & 7, t0 + (lane & 31), true, 3, i * MBLK, qg + 1, t0, lane);
        }
    }
    __syncthreads();
}
__device__ __forceinline__ void moba_combine(const Frame& F) {
    const bf16_t* PO = (const bf16_t*)(F.ws + RB_PARTO); const float* PML = (const float*)(F.ws + RB_PARTML); bf16_t* Y = (bf16_t*)(F.ws + RB_YCAT);
    const int lane = F.lane, h = lane >> 3, dc = lane & 7;
    for (int tok = F.gw; tok < NTOK; tok += F.GW) {
        const int i = (tok & 4095) >> 8, nsel = i < 3 ? i : 3; const size_t pb = ((size_t)tok * 8 + h) * 4;
        float mm[4], ll[4]; float M = -3.0e38f;
#pragma unroll
        for (int s = 0; s < 4; ++s) { const bool v = (s == 3) || (s < nsel); if (v) { const f32x2 ml = *(const f32x2*)(PML + (pb + s) * 2); mm[s] = ml.x; ll[s] = ml.y; M = fmaxf(M, ml.x); } else { mm[s] = -3.0e38f; ll[s] = 0.f; } }
        float acc[8], den = 0.f;
#pragma unroll
        for (int j = 0; j < 8; ++j) acc[j] = 0.f;
#pragma unroll
        for (int s = 0; s < 4; ++s) { const bool v = (s == 3) || (s < nsel); if (v) { const float w = ll[s] * ex2(mm[s] - M); den += w; const u32x4 o = *(const u32x4*)(PO + (pb + s) * 64 + dc * 8);
            acc[0] += w * bf_lo(o.x); acc[1] += w * bf_hi(o.x); acc[2] += w * bf_lo(o.y); acc[3] += w * bf_hi(o.y); acc[4] += w * bf_lo(o.z); acc[5] += w * bf_hi(o.z); acc[6] += w * bf_lo(o.w); acc[7] += w * bf_hi(o.w); } }
        const float inv = 1.0f / den;
        u32x4 w; w.x = cvt_pk_bf16(acc[0] * inv, acc[1] * inv); w.y = cvt_pk_bf16(acc[2] * inv, acc[3] * inv); w.z = cvt_pk_bf16(acc[4] * inv, acc[5] * inv); w.w = cvt_pk_bf16(acc[6] * inv, acc[7] * inv);
        *(u32x4*)(Y + (size_t)tok * 1024 + 512 + h * 64 + dc * 8) = w;
    }
}

__device__ __forceinline__ void sb_attn(const Frame& F) {
    const bf16_t* Q = (const bf16_t*)(F.ws + RA_Q1); const bf16_t* Kk = (const bf16_t*)(F.ws + RA_K1); const bf16_t* Vt = (const bf16_t*)(F.ws + RA_VT1); bf16_t* Y = (bf16_t*)(F.ws + RB_Y1);
    const int lane = F.lane, r = lane & 31, hf = lane >> 5;
    LAS unsigned char* wl = F.lds + F.wave * 4096;
    bf16x8 tri[2];
#pragma unroll
    for (int s = 0; s < 2; ++s)
#pragma unroll
        for (int j = 0; j < 8; ++j) { const int kap = 16 * s + 8 * (j >> 2) + 4 * hf + (j & 3); tri[s][j] = (kap >= r) ? (short)0x3F80 : (short)0; }
    const int ntask = NBATCH * 16 * (SEQ / 32);
    for (int task = F.gw; task < ntask; task += F.GW) {
        const int qt = task & 127, head = (task >> 7) & 15, b = task >> 11; const int t0 = qt * 32; const size_t tokb = (size_t)b * SEQ;
        bf16x8 qf[4];
        { const bf16_t* qp = Q + qk_tile_off(b, head, t0, 16) + hf * 256 + r * 8;
#pragma unroll
          for (int s = 0; s < 4; ++s) qf[s] = *(const bf16x8*)(qp + 512 * s); }
        f32x16 o0, o1;
#pragma unroll
        for (int i = 0; i < 16; ++i) { o0[i] = 0.f; o1[i] = 0.f; }
        float carry = 0.f;
        const bf16_t* kbase = Kk + qk_tile_off(b, head, 0, 16) + hf * 256 + r * 8;
        const bf16_t* vbase = Vt + v_tile_off(b, head, 0, 16) + hf * 256 + r * 8;
        KFrag k0 = load_kfrag(kbase + (size_t)qt * 2048);
        VFrag v0 = load_vfrag(vbase + (size_t)qt * 2048);
        for (int key0 = t0; key0 >= 0; key0 -= 32) {
            const bool diag = (key0 == t0);
            const int kp1 = key0 >= 32 ? key0 - 32 : 0;
            const KFrag k1 = load_kfrag(kbase + (size_t)(kp1 >> 5) * 2048);
            const VFrag v1 = load_vfrag(vbase + (size_t)(kp1 >> 5) * 2048);
            f32x16 x;
#pragma unroll
            for (int i = 0; i < 16; ++i) x[i] = 0.f;
#pragma unroll
            for (int s = 0; s < 4; ++s) x = mfma32(k0.f[s], qf[s], x);
            float sp[16];
#pragma unroll
            for (int i = 0; i < 16; ++i) { const int row = (i & 3) + 8 * (i >> 2) + 4 * hf; const float zl = x[i];
                float v = fmaxf(zl, 0.f) + lg2(1.0f + ex2(-fabsf(zl))); if (diag && row >= r) v = 0.f; sp[i] = v; }
            unsigned hw[8], lw[8];
#pragma unroll
            for (int i = 0; i < 8; ++i) { hw[i] = cvt_pk_bf16(sp[2 * i], sp[2 * i + 1]); lw[i] = cvt_pk_bf16(sp[2 * i] - bf_lo(hw[i]), sp[2 * i + 1] - bf_hi(hw[i])); }
            f32x16 y;
#pragma unroll
            for (int i = 0; i < 16; ++i) y[i] = 0.f;
#pragma unroll
            for (int s = 0; s < 2; ++s) { u32x4 a, c; a.x = hw[4 * s]; a.y = hw[4 * s + 1]; a.z = hw[4 * s + 2]; a.w = hw[4 * s + 3]; c.x = lw[4 * s]; c.y = lw[4 * s + 1]; c.z = lw[4 * s + 2]; c.w = lw[4 * s + 3];
                y = mfma32(tri[s], __builtin_bit_cast(bf16x8, a), y); y = mfma32(tri[s], __builtin_bit_cast(bf16x8, c), y); }
            unsigned pw[8];
#pragma unroll
            for (int i = 0; i < 8; ++i) { const int i0 = 2 * i, i1 = 2 * i + 1; const int row0 = (i0 & 3) + 8 * (i0 >> 2) + 4 * hf, row1 = (i1 & 3) + 8 * (i1 >> 2) + 4 * hf;
                float w0 = ex2(x[i0] - y[i0] - carry), w1 = ex2(x[i1] - y[i1] - carry); if (diag && row0 >= r) w0 = 0.f; if (diag && row1 >= r) w1 = 0.f; pw[i] = cvt_pk_bf16(w0, w1); }
#pragma unroll
            for (int s = 0; s < 2; ++s) { u32x4 pf; pf.x = pw[4 * s]; pf.y = pw[4 * s + 1]; pf.z = pw[4 * s + 2]; pf.w = pw[4 * s + 3];
                const bf16x8 pb = __builtin_bit_cast(bf16x8, pf);
                o0 = mfma32(v0.f[0][s], pb, o0); o1 = mfma32(v0.f[1][s], pb, o1); }
            carry += __shfl(y[0], r);
            if (__all(carry >= SB_THR)) break;
            k0 = k1; v0 = v1;
        }
        stage_o_rows(wl, o0, o1, 1.0f, r, hf);
#pragma unroll
        for (int it = 0; it < 4; ++it) { const int q = it * 8 + (lane >> 3), c = lane & 7; *(u32x4*)(Y + (tokb + t0 + q) * 1024 + head * 64 + c * 8) = read_o_row(wl, q, c); }
        __builtin_amdgcn_fence(__ATOMIC_RELEASE, "wavefront"); __builtin_amdgcn_wave_barrier(); __builtin_amdgcn_fence(__ATOMIC_ACQUIRE, "wavefront");
    }
}

__device__ __forceinline__ void moe_router(const Frame& F, const Args& a, int layer, const float* __restrict__ r) {
    unsigned char* H8 = (unsigned char*)(F.ws + WS_H); int* MLIST = (int*)(F.ws + WS_MLIST); int* TOKEP = (int*)(F.ws + WS_TOKEP); float* TOKG = (float*)(F.ws + WS_TOKG); unsigned* GCNT = F.ctl + CW_GCNT + layer * 64;
    const float* rw = a.in[I_RW] + (size_t)layer * 1024 * 32; const float* rb = a.in[I_RB] + layer * 32; const float* gain = a.in[I_NFFN] + layer * 1024;
    LAS float* hs = (LAS float*)F.lds;
    LAS float* part = (LAS float*)(F.lds + 32768);
    LAS float* logit = (LAS float*)(F.lds + 49152);
    LAS int* lcnt = (LAS int*)(F.lds + 50176);
    LAS int* tinfo = (LAS int*)(F.lds + 50432);
    const int t = F.tid, lane = F.lane, wave = F.wave, e = t & 31, ks = t >> 5;
    const int per = (NTOK + F.G - 1) / F.G, tok0 = F.bid * per, tok1 = min(NTOK, tok0 + per);
    float rwr[64];
#pragma unroll
    for (int i = 0; i < 64; ++i) rwr[i] = rw[(size_t)(ks * 64 + i) * 32 + e];
    f32x4 gv[4];
#pragma unroll
    for (int j = 0; j < 4; ++j) gv[j] = *(const f32x4*)(gain + 4 * (lane + 64 * j));
    __syncthreads();
    if (t < 64) lcnt[t] = 0;
    for (int base = tok0; base < tok1; base += 8) {
        const int tok = base + wave;
        if (tok < tok1) { const float* s = r + (size_t)tok * 1024; f32x4 v[4]; float ss = 0.f;
#pragma unroll
            for (int j = 0; j < 4; ++j) { v[j] = *(const f32x4*)(s + 4 * (lane + 64 * j)); ss += v[j][0] * v[j][0] + v[j][1] * v[j][1] + v[j][2] * v[j][2] + v[j][3] * v[j][3]; }
            ss = wave_sum(ss); const float rstd = rsqrtf(ss * (1.0f / 1024.0f) + RMS_EPS);
#pragma unroll
            for (int j = 0; j < 4; ++j) { const f32x4 y = v[j] * rstd * gv[j]; *(LAS f32x4*)(hs + wave * 1024 + 4 * (lane + 64 * j)) = y;
                *(unsigned*)(H8 + (size_t)tok * 1024 + 4 * (lane + 64 * j)) = cvt_pk4_fp8(y[0], y[1], y[2], y[3]); } }
        __syncthreads();
#pragma unroll
        for (int tk = 0; tk < 8; ++tk) { float acc = 0.f;
#pragma unroll
            for (int i4 = 0; i4 < 16; ++i4) { const f32x4 hv = *(const LAS f32x4*)(hs + tk * 1024 + ks * 64 + 4 * i4); acc += hv[0] * rwr[4 * i4] + hv[1] * rwr[4 * i4 + 1] + hv[2] * rwr[4 * i4 + 2] + hv[3] * rwr[4 * i4 + 3]; }
            part[(tk * 16 + ks) * 32 + e] = acc; }
        __syncthreads();
        if (t < 256) { const int tk = t >> 5; float s = rb[e];
#pragma unroll
            for (int k = 0; k < 16; ++k) s += part[(tk * 16 + k) * 32 + e];
            logit[tk * 32 + e] = s; }
        __syncthreads();
        if (t < 8 && base + t < tok1) { const int tk = t, tokk = base + t; float v0 = -3.0e38f, v1 = -3.0e38f, v2 = -3.0e38f, v3 = -3.0e38f; int i0 = 0, i1 = 0, i2 = 0, i3 = 0;
            for (int j = 0; j < 32; ++j) { const float g = logit[tk * 32 + j];
                if (g > v0) { v3 = v2; i3 = i2; v2 = v1; i2 = i1; v1 = v0; i1 = i0; v0 = g; i0 = j; } else if (g > v1) { v3 = v2; i3 = i2; v2 = v1; i2 = i1; v1 = g; i1 = j; }
                else if (g > v2) { v3 = v2; i3 = i2; v2 = g; i2 = j; } else if (g > v3) { v3 = g; i3 = j; } }
            const float e1 = __expf(v1 - v0), e2 = __expf(v2 - v0), e3 = __expf(v3 - v0), inv = 1.0f / (1.0f + e1 + e2 + e3);
            f32x4 gg; gg[0] = inv; gg[1] = e1 * inv; gg[2] = e2 * inv; gg[3] = e3 * inv; *(f32x4*)(TOKG + (size_t)tokk * 4) = gg;
            const int lt = tokk - tok0;
            tinfo[lt * 4 + 0] = (i0 << 20) | atomicAdd((int*)&lcnt[i0], 1); tinfo[lt * 4 + 1] = (i1 << 20) | atomicAdd((int*)&lcnt[i1], 1);
            tinfo[lt * 4 + 2] = (i2 << 20) | atomicAdd((int*)&lcnt[i2], 1); tinfo[lt * 4 + 3] = (i3 << 20) | atomicAdd((int*)&lcnt[i3], 1); }
    }
    __syncthreads();
    if (t < 32) lcnt[32 + t] = (int)__hip_atomic_fetch_add(GCNT + t, (unsigned)lcnt[t], __ATOMIC_RELAXED, __HIP_MEMORY_SCOPE_AGENT);
    __syncthreads();
    for (int x = t; x < (tok1 - tok0) * 4; x += 512) { const int v = tinfo[x], ee = v >> 20, pos = lcnt[32 + ee] + (v & 0xfffff), tokk = tok0 + (x >> 2);
        MLIST[(size_t)ee * NTOK + pos] = tokk; TOKEP[(size_t)tokk * 4 + (x & 3)] = (ee << 20) | pos; }
    __syncthreads();
}

struct MoeTab { LAS int* cnt; LAS int* tb; LAS int* rte; int NT; };
__device__ __forceinline__ MoeTab moe_tables(const Frame& F, int layer) {
    MoeTab T; T.cnt = (LAS int*)(F.lds + LDS_AUX + 18432); T.tb = T.cnt + 32; T.rte = T.tb + 40;
    unsigned* GCNT = F.ctl + CW_GCNT + layer * 64; const int t = F.tid;
    __syncthreads();
    if (t < 32) T.cnt[t] = (int)__hip_atomic_load(GCNT + t, __ATOMIC_RELAXED, __HIP_MEMORY_SCOPE_AGENT);
    __syncthreads();
    if (t == 0) { int s = 0; for (int e = 0; e < 32; ++e) { T.tb[e] = s; s += (T.cnt[e] + 255) >> 8; } T.tb[32] = s; }
    __syncthreads();
    T.NT = T.tb[32];
    for (int x = t; x < T.NT; x += 512) { int e = 0; for (int k = 1; k < 32; ++k) if (T.tb[k] <= x) e = k; T.rte[x] = e; }
    __syncthreads();
    return T;
}
__device__ __forceinline__ bool moe_unit(int i, int G, int c, int NT, int NPN, int& rt, int& pn) {
    const long L = (long)i * G + c;
    if ((G & 7) == 0) { const int xcd = (int)(L & 7); const long idx = L >> 3; rt = (int)(idx / NPN) * 8 + xcd; pn = (int)(idx % NPN); }
    else { rt = (int)(L / NPN); pn = (int)(L % NPN); }
    return rt < NT;
}
struct MoeUpSched {
    static constexpr bool GATHER = true;
    MoeTab T; const char* H; const char* Wg; const char* Wu; LAS int* rowtab; int G, c;
    __device__ __forceinline__ bool next(int i, GU& u) const {
        int rt, pn; if (!moe_unit(i, G, c, T.NT, 8, rt, pn)) return false;
        const int e = T.rte[rt];
        u.a0 = H; u.a1 = H; u.b0 = Wg + ((size_t)e * 1024 + pn * 128) * 1024; u.b1 = Wu + ((size_t)e * 1024 + pn * 128) * 1024;
        u.p0 = rt * 256; u.p1 = pn * 128; u.p2 = e; u.p3 = 0; return true;
    }
    __device__ __forceinline__ const LAS int* rows(int i) const { return rowtab + i * 256; }
};
struct MoeDownSched {
    static constexpr bool GATHER = false;
    MoeTab T; const char* A; const char* Wd; int G, c;
    __device__ __forceinline__ bool next(int i, GU& u) const {
        int rt, pn; if (!moe_unit(i, G, c, T.NT, 4, rt, pn)) return false;
        const int e = T.rte[rt];
        u.a0 = A + (size_t)rt * 256 * 1024; u.a1 = u.a0 + (size_t)128 * 1024; u.b0 = Wd + ((size_t)e * 1024 + pn * 256) * 1024; u.b1 = u.b0 + (size_t)128 * 1024;
        u.p0 = rt * 256; u.p1 = pn * 256; u.p2 = e; u.p3 = 0; return true;
    }
    __device__ __forceinline__ const LAS int* rows(int) const { return nullptr; }
};
__device__ __forceinline__ void moe_up(const Frame& F, const Args& a, int layer) {
    const MoeTab T = moe_tables(F, layer); const int* MLIST = (const int*)(F.ws + WS_MLIST);
    LAS int* rowtab = (LAS int*)(F.lds + LDS_AUX);
    for (int i = 0; i < 18; ++i) { int rt, pn; if (!moe_unit(i, F.G, F.bid, T.NT, 8, rt, pn)) break;
        const int e = T.rte[rt], tile = rt - T.tb[e], cnt = T.cnt[e];
        if (F.tid < 256) { const int pos = tile * 256 + F.tid; rowtab[i * 256 + F.tid] = pos < cnt ? MLIST[(size_t)e * NTOK + pos] : 0; } }
    __syncthreads();
    const char* W = (const char*)(F.ws + WS_MOEW); const size_t L = (size_t)NEXP * 1024 * 1024;
    MoeUpSched S{T, (const char*)(F.ws + WS_H), W, W + L, rowtab, F.G, F.bid};
    EpiSwiglu E{a.in[I_BG] + (size_t)layer * NEXP * 1024, a.in[I_BU] + (size_t)layer * NEXP * 1024, (unsigned char*)(F.ws + RA_ACT)};
    g8::gemm_run<EpiSwiglu, MoeUpSched, true>(F.lds, 512, 1024u, 1024u, S, E);
}
__device__ __forceinline__ void moe_down(const Frame& F, const Args& a, int layer) {
    const MoeTab T = moe_tables(F, layer);
    const char* W = (const char*)(F.ws + WS_MOEW); const size_t L = (size_t)NEXP * 1024 * 1024;
    MoeDownSched S{T, (const char*)(F.ws + RA_ACT), W + 2 * L, F.G, F.bid};
    EpiDown E{a.in[I_BD] + (size_t)layer * NEXP * 1024, (bf16_t*)(F.ws + RB_YS)};
    g8::gemm_run<EpiDown, MoeDownSched, true>(F.lds, 512, 1024u, 1024u, S, E);
}
__device__ __forceinline__ void moe_combine(const Frame& F, const Args& a, int layer, float* __restrict__ r) {
    const MoeTab T = moe_tables(F, layer);
    const bf16_t* YS = (const bf16_t*)(F.ws + RB_YS); const int* TOKEP = (const int*)(F.ws + WS_TOKEP); const float* TOKG = (const float*)(F.ws + WS_TOKG); bf16_t* H = (bf16_t*)(F.ws + WS_H);
    const float* gain = a.in[I_NPLE] + layer * 1024; const int lane = F.lane;
    f32x4 gv[2][2];
#pragma unroll
    for (int c = 0; c < 2; ++c) { gv[c][0] = *(const f32x4*)(gain + c * 512 + lane * 8); gv[c][1] = *(const f32x4*)(gain + c * 512 + lane * 8 + 4); }
    for (int tok = F.gw; tok < NTOK; tok += F.GW) {
        int slot[4]; float gt[4];
#pragma unroll
        for (int k = 0; k < 4; ++k) { const int v = TOKEP[(size_t)tok * 4 + k]; slot[k] = T.tb[v >> 20] * 256 + (v & 0xfffff); gt[k] = TOKG[(size_t)tok * 4 + k]; }
        f32x4 v[2][2]; float ss = 0.f;
#pragma unroll
        for (int c = 0; c < 2; ++c) { const size_t o = (size_t)tok * 1024 + c * 512 + lane * 8; v[c][0] = *(const f32x4*)(r + o); v[c][1] = *(const f32x4*)(r + o + 4);
#pragma unroll
            for (int k = 0; k < 4; ++k) { const u32x4 y = *(const u32x4*)(YS + (size_t)slot[k] * 1024 + c * 512 + lane * 8);
                v[c][0][0] += gt[k] * bf_lo(y.x); v[c][0][1] += gt[k] * bf_hi(y.x); v[c][0][2] += gt[k] * bf_lo(y.y); v[c][0][3] += gt[k] * bf_hi(y.y);
                v[c][1][0] += gt[k] * bf_lo(y.z); v[c][1][1] += gt[k] * bf_hi(y.z); v[c][1][2] += gt[k] * bf_lo(y.w); v[c][1][3] += gt[k] * bf_hi(y.w); }
            *(f32x4*)(r + o) = v[c][0]; *(f32x4*)(r + o + 4) = v[c][1];
#pragma unroll
            for (int q = 0; q < 2; ++q) ss += v[c][q][0] * v[c][q][0] + v[c][q][1] * v[c][q][1] + v[c][q][2] * v[c][q][2] + v[c][q][3] * v[c][q][3]; }
        ss = wave_sum(ss); const float rstd = rsqrtf(ss * (1.0f / 1024.0f) + RMS_EPS);
#pragma unroll
        for (int c = 0; c < 2; ++c) { const f32x4 y0 = v[c][0] * rstd * gv[c][0], y1 = v[c][1] * rstd * gv[c][1];
            u32x4 w; w.x = cvt_pk_bf16(y0[0], y0[1]); w.y = cvt_pk_bf16(y0[2], y0[3]); w.z = cvt_pk_bf16(y1[0], y1[1]); w.w = cvt_pk_bf16(y1[2], y1[3]);
            *(u32x4*)(H + (size_t)tok * 1024 + c * 512 + lane * 8) = w; }
    }
}

constexpr int N_PHASES = 22;
#ifndef DBG_DUP_MASK
#define DBG_DUP_MASK 0
#endif
#ifndef DBG_NPH
#define DBG_NPH 22
#endif
#ifndef MK_ONE_LAUNCH
#define MK_ONE_LAUNCH 1
#endif

__device__ __forceinline__ void moe_ple_phases(const Frame& F, const Args& a, int layer, int ph, float* out) {
    if (ph == 0) moe_router(F, a, layer, out);
    else if (ph == 1) moe_up(F, a, layer);
    else if (ph == 2) moe_down(F, a, layer);
    else if (ph == 3) {
        g8::DenseSched S{(const char*)(F.ws + WS_PB) + (size_t)layer * NTOK * PLE * 2, (const char*)(F.ws + WS_WPLE) + (size_t)layer * 1024 * PLE * 2, 512u, 512u, 128, 4, F.G, F.bid};
        EpiStoreBf16 E{(bf16_t*)(F.ws + RA_PROJ), 1024, 1.0f};
        g8::gemm_run<EpiStoreBf16, g8::DenseSched>(F.lds, 256, 512u, 512u, S, E);
        moe_combine(F, a, layer, out);
    } else {
        g8::DenseSched S{(const char*)(F.ws + WS_H), (const char*)(F.ws + WS_WPLEG) + (size_t)layer * 1024 * 1024 * 2, 2048u, 2048u, 128, 4, F.G, F.bid};
        EpiPle E{(const bf16_t*)(F.ws + RA_PROJ), out};
        g8::gemm_run<EpiPle, g8::DenseSched>(F.lds, 1024, 2048u, 2048u, S, E);
    }
}

__global__ void __launch_bounds__(512, 2) fwd(Args a) {
    extern __shared__ __attribute__((aligned(16))) unsigned char lds_raw[];
    Frame F;
    F.lds = (LAS unsigned char*)lds_raw; F.tid = threadIdx.x; F.lane = F.tid & 63; F.wave = __builtin_amdgcn_readfirstlane(F.tid >> 6);
    F.G = gridDim.x; F.bid = blockIdx.x; F.gw = F.bid * 8 + F.wave; F.GW = F.G * 8; F.ws = a.ws; F.ctl = (unsigned*)(a.ws + WS_CTL);
    volatile LAS unsigned* misc = (volatile LAS unsigned*)(F.lds + LDS_MISC);
    if (F.tid < 16) misc[F.tid] = 0u;
    __syncthreads();
    XcdBarrier bar; bar.bar = F.ctl + CW_BAR; bar.x = 0; bar.st = misc;
    const int lo = a.ph_lo, hi = a.ph_hi;
    if (hi - lo > 1) bar = xcd_barrier_post(F.ctl + CW_BAR, misc);
#define IN(k) (lo <= (k) && (k) < hi)
#define SEAM(k) do { if (IN(k) && IN((k) + 1)) xcd_barrier(bar); } while (0)
    float* out = a.out;

    if (IN(0)) { p0_prologue(F, a); } SEAM(0);
    if (IN(1)) {
        { g8::DenseSched S{(const char*)(F.ws + WS_H), (const char*)(F.ws + WS_WINAB), 2048u, 2048u, 128, 6, F.G, F.bid};
          EpiInAB E{(bf16_t*)(F.ws + RA_A2), (bf16_t*)(F.ws + RA_Q0), (bf16_t*)(F.ws + RA_K0)};
          g8::gemm_run<EpiInAB, g8::DenseSched>(F.lds, 1024, 2048u, 2048u, S, E); }
        { g8::DenseSched S{(const char*)(F.ws + WS_WINAB) + (size_t)1536 * 2048, (const char*)(F.ws + WS_H), 2048u, 2048u, 2, 128, F.G, F.bid};
          EpiVt E{(bf16_t*)(F.ws + RA_VT0), 8};
          g8::gemm_run<EpiVt, g8::DenseSched>(F.lds, 1024, 2048u, 2048u, S, E); }
    } SEAM(1);
    if (IN(2)) {
        { g8::BatchSched S{(const char*)(F.ws + RA_A2), (const char*)(F.ws + WS_WBT), 1280u, 1024u, (size_t)1024 * 1280, (size_t)256 * 1024, 4, 1, NGRP, F.G, F.bid};
          EpiS E{(float*)(F.ws + RA_SS)};
          g8::gemm_run<EpiS, g8::BatchSched>(F.lds, 512, 1280u, 1024u, S, E); }
        moba_kmean(F);
    } SEAM(2);
    if (IN(3)) { s5_scan(F, a); moba_gate(F); } SEAM(3);
    if (IN(4)) {
        { g8::BatchSched S{(const char*)(F.ws + RA_A2), (const char*)(F.ws + WS_MY), 1280u, 1280u, (size_t)1024 * 1280, (size_t)512 * 1280, 4, 2, NGRP, F.G, F.bid};
          EpiY E{(bf16_t*)(F.ws + RA_Z)};
          g8::gemm_run<EpiY, g8::BatchSched>(F.lds, 640, 1280u, 1280u, S, E); }
        moba_attn(F, a);
    } SEAM(4);
    if (IN(5)) {
        { g8::DenseSched S{(const char*)(F.ws + RA_Z), (const char*)(F.ws + WS_GLU), 1024u, 1024u, 128, 2, F.G, F.bid};
          EpiGlu E{(const bf16_t*)(F.ws + RA_Z), a.in[I_GLUB], (bf16_t*)(F.ws + RB_YCAT)};
          g8::gemm_run<EpiGlu, g8::DenseSched>(F.lds, 512, 1024u, 1024u, S, E); }
        moba_combine(F);
    } SEAM(5);
    if (IN(6)) {
        g8::DenseSched S{(const char*)(F.ws + RB_YCAT), (const char*)(F.ws + WS_WOUTAB), 2048u, 2048u, 128, 4, F.G, F.bid};
        EpiRes E{a.in[I_X], out};
        g8::gemm_run<EpiRes, g8::DenseSched>(F.lds, 1024, 2048u, 2048u, S, E);
    } SEAM(6);
    if (IN(7)) moe_ple_phases(F, a, 0, 0, out); SEAM(7);
    if (IN(8)) moe_ple_phases(F, a, 0, 1, out); SEAM(8);
    if (IN(9)) moe_ple_phases(F, a, 0, 2, out); SEAM(9);
    if (IN(10)) moe_ple_phases(F, a, 0, 3, out); SEAM(10);
    if (IN(11)) moe_ple_phases(F, a, 0, 4, out); SEAM(11);
    if (IN(12)) { rmsnorm_rows<false>(F, out, a.in[I_NMIX] + 1024, (bf16_t*)(F.ws + WS_H), nullptr, NTOK); conv_moe_weights(F, a, 1); } SEAM(12);
    if (IN(13)) {
        { g8::DenseSched S{(const char*)(F.ws + WS_H), (const char*)(F.ws + WS_WINC), 2048u, 2048u, 128, 8, F.G, F.bid};
          EpiInC E{(bf16_t*)(F.ws + RA_Q1), (bf16_t*)(F.ws + RA_K1)};
          g8::gemm_run<EpiInC, g8::DenseSched>(F.lds, 1024, 2048u, 2048u, S, E); }
        { g8::DenseSched S{(const char*)(F.ws + WS_WINC) + (size_t)2048 * 2048, (const char*)(F.ws + WS_H), 2048u, 2048u, 4, 128, F.G, F.bid};
          EpiVt E{(bf16_t*)(F.ws + RA_VT1), 16};
          g8::gemm_run<EpiVt, g8::DenseSched>(F.lds, 1024, 2048u, 2048u, S, E); }
    } SEAM(13);
#ifdef DBG_NOSB
    if (IN(14)) { const bf16_t* Qd = (const bf16_t*)(F.ws + RA_Q1); bf16_t* Yd = (bf16_t*)(F.ws + RB_Y1); for (size_t i = ((size_t)F.bid * 512 + F.tid) * 8; i < (size_t)NTOK * 1024; i += (size_t)F.G * 512 * 8) *(u32x4*)(Yd + i) = *(const u32x4*)(Qd + i); } SEAM(14);
#else
    if (IN(14)) sb_attn(F); SEAM(14);
#endif
    if (IN(15)) {
        g8::DenseSched S{(const char*)(F.ws + RB_Y1), (const char*)(F.ws + WS_WOUTC), 2048u, 2048u, 128, 4, F.G, F.bid};
        EpiRes E{out, out};
        g8::gemm_run<EpiRes, g8::DenseSched>(F.lds, 1024, 2048u, 2048u, S, E);
    } SEAM(15);
    if (IN(16)) moe_ple_phases(F, a, 1, 0, out); SEAM(16);
    if (IN(17)) moe_ple_phases(F, a, 1, 1, out); SEAM(17);
    if (IN(18)) moe_ple_phases(F, a, 1, 2, out); SEAM(18);
    if (IN(19)) moe_ple_phases(F, a, 1, 3, out); SEAM(19);
    if (IN(20)) moe_ple_phases(F, a, 1, 4, out); SEAM(20);
    if (IN(21)) rmsnorm_rows<true>(F, out, a.in[I_NFINAL], nullptr, out, NTOK);
#undef IN
#undef SEAM
}

extern "C" void kernel_launch(void* const* d_in, const int* in_sizes, int n_in, void* d_out, int out_size, void* d_ws, size_t ws_size, hipStream_t stream) {
    static int grid = 0;
    if (grid == 0) {
        if (n_in != 31 || out_size != NTOK * DM || ws_size < WS_END) { fprintf(stderr, "kernel_launch: unexpected shapes (n_in %d, out %d, ws %zu < %zu)\n", n_in, out_size, ws_size, (size_t)WS_END); grid = -1; return; }
        int dev = 0, cus = 0, per_cu = 0;
        if (hipGetDevice(&dev) != hipSuccess || hipDeviceGetAttribute(&cus, hipDeviceAttributeMultiprocessorCount, dev) != hipSuccess) { grid = -1; return; }
        if (hipFuncSetAttribute((const void*)fwd, hipFuncAttributeMaxDynamicSharedMemorySize, LDS_BYTES) != hipSuccess) { fprintf(stderr, "kernel_launch: hipFuncSetAttribute failed\n"); grid = -1; return; }
        if (hipOccupancyMaxActiveBlocksPerMultiprocessor(&per_cu, (const void*)fwd, 512, LDS_BYTES) != hipSuccess || per_cu < 1) fprintf(stderr, "kernel_launch: occupancy query says %d\n", per_cu);
        (void)hipGetLastError();
        grid = cus;
        if (grid != 256) fprintf(stderr, "kernel_launch: %d CUs (built for 256)\n", grid);
    }
    if (grid < 0) return;
    (void)hipMemsetAsync((char*)d_ws + WS_CTL, 0, 1 * MiB, stream);
    Args a{};
    for (int i = 0; i < 31; ++i) a.in[i] = (const float*)d_in[i];
    a.out = (float*)d_out; a.ws = (unsigned char*)d_ws;
    for (int n = 0; n < 128; ++n) { int bk; if (n < 16) bk = n; else { bk = 16 + (int)(std::log((double)n / 16.0) / std::log(8.0) * 16.0); if (bk > 31) bk = 31; } a.btab[n] = (unsigned char)bk; }
#if MK_ONE_LAUNCH
    a.ph_lo = 0; a.ph_hi = N_PHASES;
    hipLaunchKernelGGL(fwd, dim3(grid), dim3(512), LDS_BYTES, stream, a);
#else
    for (int p = 0; p < DBG_NPH; ++p) { a.ph_lo = p; a.ph_hi = p + 1; const int reps = ((DBG_DUP_MASK >> p) & 1) ? 2 : 1; for (int q = 0; q < reps; ++q) hipLaunchKernelGGL(fwd, dim3(grid), dim3(512), LDS_BYTES, stream, a); }
#endif
}
```

```cpp
#include <hip/hip_runtime.h>
#include <cstdio>
#include <cstdint>
#include <cmath>

#define LAS __attribute__((address_space(3)))
typedef unsigned short bf16_t;
typedef short bf16x8 __attribute__((ext_vector_type(8)));
typedef short bf16x4 __attribute__((ext_vector_type(4)));
typedef float f32x4 __attribute__((ext_vector_type(4)));
typedef float f32x2 __attribute__((ext_vector_type(2)));
typedef float f32x16 __attribute__((ext_vector_type(16)));
typedef unsigned u32x4 __attribute__((ext_vector_type(4)));
typedef unsigned u32x2 __attribute__((ext_vector_type(2)));
typedef int i32x4 __attribute__((ext_vector_type(4)));
typedef int i32x8 __attribute__((ext_vector_type(8)));

constexpr int NTOK = 32768, DM = 1024, SEQ = 4096, NBATCH = 8, PLE = 256;
constexpr int SSMW = 512, NGRP = 32, GH = 16, NST = 64, TCH = 32, NCH = SEQ / TCH  , A2LD = 640;
constexpr int MOBW = 512, MH = 8, MBLK = 256, NMB = 16;
constexpr int NEXP = 32;
constexpr float RMS_EPS = 1e-6f;
constexpr float LOG2E = 1.4426950408889634f;
constexpr float QSCALE = 0.125f * LOG2E;
constexpr float W8_SCALE = 32.0f;
constexpr float SB_THR = 150.0f;

constexpr size_t MiB = (size_t)1 << 20;
constexpr size_t WS_CTL = 0;
constexpr size_t WS_WINAB = 1 * MiB;
constexpr size_t WS_GLU = WS_WINAB + 4 * MiB;
constexpr size_t WS_WOUTAB = WS_GLU + MiB / 2;
constexpr size_t WS_WINC = WS_WOUTAB + 2 * MiB;
constexpr size_t WS_WOUTC = WS_WINC + 6 * MiB;
constexpr size_t WS_WPLE = WS_WOUTC + 2 * MiB;
constexpr size_t WS_WPLEG = WS_WPLE + 1 * MiB;
constexpr size_t WS_WBT = WS_WPLEG + 4 * MiB;
constexpr size_t WS_MY = WS_WBT + 8 * MiB;
constexpr size_t WS_MOEW = WS_MY + 20 * MiB;
constexpr size_t WS_H = WS_MOEW + 192 * MiB;
constexpr size_t WS_PB = WS_H + 64 * MiB;
constexpr size_t WS_MLIST = WS_PB + 32 * MiB;
constexpr size_t WS_TOKEP = WS_MLIST + 4 * MiB;
constexpr size_t WS_TOKG = WS_TOKEP + MiB / 2;
constexpr size_t WS_RA = WS_TOKG + MiB / 2;
constexpr size_t WS_RB = WS_RA + 272 * MiB;
constexpr size_t WS_END = WS_RB + 272 * MiB;
constexpr size_t RA_A2 = WS_RA;
constexpr size_t RA_Q0 = RA_A2 + 40 * MiB;
constexpr size_t RA_K0 = RA_Q0 + 32 * MiB;
constexpr size_t RA_VT0 = RA_K0 + 32 * MiB;
constexpr size_t RA_Z = RA_VT0 + 32 * MiB;
constexpr size_t RA_SS = RA_Z + 32 * MiB;
constexpr size_t RA_Q1 = WS_RA;
constexpr size_t RA_K1 = RA_Q1 + 64 * MiB;
constexpr size_t RA_VT1 = RA_K1 + 64 * MiB;
constexpr size_t RA_ACT = WS_RA;
constexpr size_t RA_PROJ = WS_RA;
constexpr size_t RB_PARTO = WS_RB;
constexpr size_t RB_PARTML = RB_PARTO + 128 * MiB;
constexpr size_t RB_MOBALIST = RB_PARTML + 8 * MiB;
constexpr size_t RB_KMEAN = RB_MOBALIST + 16 * MiB;
constexpr size_t RB_YCAT = RB_KMEAN + 1 * MiB;
constexpr size_t RB_Y1 = WS_RB;
constexpr size_t RB_YS = WS_RB;
constexpr int CW_BAR = 0;
constexpr int CW_GCNT = 4096;
constexpr int CW_MOBACNT = 8192;

constexpr int LDS_BYTES = 155648;
constexpr int LDS_AUX = 131072;
constexpr int LDS_MISC = 155648 - 64;

typedef __bf16 bf16x2_t __attribute__((ext_vector_type(2)));
__device__ __forceinline__ unsigned cvt_pk_bf16(float lo, float hi) { const f32x2 v = {lo, hi}; return __builtin_bit_cast(unsigned, __builtin_convertvector(v, bf16x2_t)); }
__device__ __forceinline__ bf16_t f2bf(float x) { return (bf16_t)(cvt_pk_bf16(x, 0.f) & 0xffffu); }
__device__ __forceinline__ unsigned cvt_pk4_fp8(float x0, float x1, float x2, float x3) { int w = __builtin_amdgcn_cvt_pk_fp8_f32(x0, x1, 0, false); w = __builtin_amdgcn_cvt_pk_fp8_f32(x2, x3, w, true); return (unsigned)w; }
__device__ __forceinline__ float bf_lo(unsigned w) { return __uint_as_float(w << 16); }
__device__ __forceinline__ float bf_hi(unsigned w) { return __uint_as_float(w & 0xffff0000u); }
__device__ __forceinline__ float ex2(float x) { return __builtin_amdgcn_exp2f(x); }
__device__ __forceinline__ float lg2(float x) { return __builtin_amdgcn_logf(x); }
__device__ __forceinline__ float rcp(float x) { return __builtin_amdgcn_rcpf(x); }
__device__ __forceinline__ float sigmoidf_(float x) { return rcp(1.0f + ex2(-LOG2E * x)); }
__device__ __forceinline__ float wave_sum(float v) { v += __shfl_xor(v, 32); v += __shfl_xor(v, 16); v += __shfl_xor(v, 8); v += __shfl_xor(v, 4); v += __shfl_xor(v, 2); v += __shfl_xor(v, 1); return v; }
__device__ __forceinline__ f32x16 mfma32(bf16x8 a, bf16x8 b, f32x16 c) { return __builtin_amdgcn_mfma_f32_32x32x16_bf16(a, b, c, 0, 0, 0); }

#define XB_TMO      128
#define XB_XCNT(j)  (256  + 64 * (j))
#define XB_XSUB(j)  (1280 + 64 * (j))
#define XB_XGEN(j)  (2304 + 64 * (j))
#define XB_TOP      3328
#define XB_TOPGEN   3392
#define XCD_BAR_WORDS 3456
#define XB_SPIN_CAP (1u << 18)
__device__ __forceinline__ unsigned xb_ld(unsigned* p)              { return __hip_atomic_load(p, __ATOMIC_RELAXED, __HIP_MEMORY_SCOPE_AGENT); }
__device__ __forceinline__ unsigned xb_add(unsigned* p, unsigned v) { return __hip_atomic_fetch_add(p, v, __ATOMIC_RELAXED, __HIP_MEMORY_SCOPE_AGENT); }
__device__ __forceinline__ unsigned xb_xcc_id() { return (unsigned)__builtin_amdgcn_s_getreg((3 << 11) | 20) & 0xFu; }
#define XB_SPIN(cond, bar) do { unsigned _sp = 0; while (cond) { __builtin_amdgcn_s_sleep(1); \
    if ((++_sp & 255u) == 0u) { if (xb_ld(&(bar)[XB_TMO])) break; if (_sp > XB_SPIN_CAP) { atomicAdd(&(bar)[XB_TMO], 1u); break; } } } } while (0)
struct XcdBarrier { unsigned* bar; unsigned x; volatile LAS unsigned* st; };
__device__ __forceinline__ XcdBarrier xcd_barrier_post(unsigned* bar, volatile LAS unsigned* st) {
    XcdBarrier b; b.bar = bar; b.x = xb_xcc_id(); b.st = st;
    if (threadIdx.x == 0) (void)xb_add(&bar[XB_XCNT(b.x)], 1u);
    return b;
}
__device__ __forceinline__ void xcd_barrier_complete(unsigned* bar, unsigned x, unsigned& nloc, unsigned& nx) {
    const unsigned G = gridDim.x * gridDim.y * gridDim.z;
    unsigned sum, cnt, mine, sp = 0u;
    for (;;) {
        sum = 0u; cnt = 0u; mine = 0u;
#pragma unroll
        for (unsigned j = 0; j < 16; ++j) { const unsigned c = xb_ld(&bar[XB_XCNT(j)]); sum += c; cnt += (c > 0u) ? 1u : 0u; mine = (j == x) ? c : mine; }
        if (sum == G) break;
        __builtin_amdgcn_s_sleep(1);
        if ((++sp & 255u) == 0u) { if (xb_ld(&bar[XB_TMO])) break; if (sp > XB_SPIN_CAP) { atomicAdd(&bar[XB_TMO], 1u); break; } }
    }
    nloc = mine > 0u ? mine : 1u; nx = cnt > 0u ? cnt : 1u;
}
__device__ __forceinline__ void xcd_barrier(const XcdBarrier& b) {
    asm volatile("s_waitcnt vmcnt(0)" ::: "memory");
    __syncthreads();
    if (threadIdx.x == 0) {
        unsigned* bar = b.bar;
        __builtin_amdgcn_s_waitcnt(0);
        unsigned nloc = b.st[0], nx = b.st[1];
        if (nloc == 0u) { xcd_barrier_complete(bar, b.x, nloc, nx); b.st[0] = nloc; b.st[1] = nx; }
        const unsigned old = xb_add(&bar[XB_XSUB(b.x)], 1u);
        const unsigned gen = old / nloc;
        if (old + 1u == (gen + 1u) * nloc) {
            __builtin_amdgcn_fence(__ATOMIC_RELEASE, "agent");
            asm volatile("s_waitcnt vmcnt(0)" ::: "memory");
            const unsigned og = xb_add(&bar[XB_TOP], 1u);
            const unsigned tg = og / nx;
            if (og + 1u == (tg + 1u) * nx) xb_add(&bar[XB_TOPGEN], 1u);
            else XB_SPIN(xb_ld(&bar[XB_TOPGEN]) == tg, bar);
            __builtin_amdgcn_fence(__ATOMIC_ACQUIRE, "agent");
            xb_add(&bar[XB_XGEN(b.x)], 1u);
            asm volatile("s_waitcnt vmcnt(0)" ::: "memory");
        } else {
            XB_SPIN(xb_ld(&bar[XB_XGEN(b.x)]) == gen, bar);
            __builtin_amdgcn_fence(__ATOMIC_ACQUIRE, "agent");
            asm volatile("s_waitcnt vmcnt(0)" ::: "memory");
        }
    }
    __syncthreads();
}

namespace g8 {
constexpr int BM = 256, BK = 64, HALF = 128, HTB = HALF * BK * 2, STAGE_BYTES = 8 * HTB, NXCD = 8, WGM = 8;
__host__ __device__ __forceinline__ int lds_byte(int r, int c) { const int st = (r >> 4) * 2 + (c >> 5), rr = r & 15, cc = c & 31, ob = rr * 64 + cc * 2; return st * 1024 + (ob ^ (((ob >> 9) & 1) << 5)); }
__host__ __device__ __forceinline__ void stage_rc(int b, int& R, int& C) { const int st = b / 1024, sb = b % 1024, swz = sb ^ (((sb >> 9) & 1) << 5); R = (st >> 1) * 16 + swz / 64; C = (st & 1) * 32 + (swz % 64) / 2; }
__host__ __device__ __forceinline__ int perm32(int rho) { const int n = rho >> 4, i = rho & 15; return 8 * (i >> 2) + 4 * n + (i & 3); }

struct GU { const char *a0, *a1, *b0, *b1; int p0, p1, p2, p3; };

__device__ __forceinline__ bool static_tile(int i, int G, int c, int nM, int nN, int& pm, int& pn) {
    const int nwg = nM * nN; const long L = (long)i * G + c; if (L >= nwg) return false;
    int wgid = (int)L; { const int q = nwg / NXCD, r = nwg % NXCD, xcd = wgid % NXCD, off = wgid / NXCD; wgid = (xcd < r ? xcd * (q + 1) : r * (q + 1) + (xcd - r) * q) + off; }
    const int nig = WGM * nN, gid = wgid / nig, fm = gid * WGM, gsz = (nM - fm) < WGM ? (nM - fm) : WGM;
    pm = fm + ((wgid % nig) % gsz); pn = (wgid % nig) / gsz; return true;
}
struct DenseSched {
    const char* A; const char* B; unsigned lda2, ldb2; int nM, nN, G, c;
    static constexpr bool GATHER = false;
    __device__ __forceinline__ bool next(int i, GU& u) const {
        int pm, pn; if (!static_tile(i, G, c, nM, nN, pm, pn)) return false;
        u.a0 = A + (size_t)pm * 256 * lda2; u.a1 = u.a0 + (size_t)128 * lda2; u.b0 = B + (size_t)pn * 256 * ldb2; u.b1 = u.b0 + (size_t)128 * ldb2;
        u.p0 = pm; u.p1 = pn; u.p2 = 0; u.p3 = 0; return true;
    }
    __device__ __forceinline__ const LAS int* rows(int) const { return nullptr; }
};
struct BatchSched {
    const char* A; const char* B; unsigned lda2, ldb2; size_t sA, sB; int nM, nN, nb, G, c;
    static constexpr bool GATHER = false;
    __device__ __forceinline__ bool next(int i, GU& u) const {
        const long L = (long)i * G + c; const int per = nM * nN; if (L >= (long)per * nb) return false;
        const int g = (int)(L / per), rem = (int)(L % per), pm = rem / nN, pn = rem % nN;
        u.a0 = A + (size_t)g * sA + (size_t)pm * 256 * lda2; u.a1 = u.a0 + (size_t)128 * lda2; u.b0 = B + (size_t)g * sB + (size_t)pn * 256 * ldb2; u.b1 = u.b0 + (size_t)128 * ldb2;
        u.p0 = pm; u.p1 = pn; u.p2 = g; u.p3 = 0; return true;
    }
    __device__ __forceinline__ const LAS int* rows(int) const { return nullptr; }
};

#define G8_WAIT_V(n) asm volatile("s_waitcnt vmcnt(" #n ")" ::: "memory")
#define G8_WAIT_L(n) asm volatile("s_waitcnt lgkmcnt(" #n ")" ::: "memory")
#define G8_BAR __builtin_amdgcn_s_barrier()
#define G8_SCHED __builtin_amdgcn_sched_barrier(0)

template <class Epi, class Sched, bool F8 = false>
__device__ __forceinline__ void gemm_run(LAS unsigned char* lds, const int K, const unsigned lda2, const unsigned ldb2, const Sched& S, const Epi& E) {
    constexpr bool GATHER = Sched::GATHER;
    const int tid = threadIdx.x, wid = __builtin_amdgcn_readfirstlane(tid >> 6), lane = tid & 63, wr = wid >> 2, wc = wid & 3, fr = lane & 15, fq = lane >> 4;
    const int nt = K / BK;
    int sR[2], sC[2];
    unsigned voffB[2], vc[2][2], vn[2][2];
#pragma unroll
    for (int i = 0; i < 2; ++i) { stage_rc(tid * 16 + i * 8192, sR[i], sC[i]); const int Rb = Epi::PERM ? ((sR[i] & ~31) + perm32(sR[i] & 31)) : sR[i];
        voffB[i] = (unsigned)Rb * ldb2 + (unsigned)sC[i] * 2u; vc[0][i] = vc[1][i] = vn[0][i] = vn[1][i] = (unsigned)sR[i] * lda2 + (unsigned)sC[i] * 2u; }
    const size_t kstep = (size_t)(BK * 2);
    const unsigned ldsw = (unsigned)wid * 1024u;
    const int aoff = lds_byte(wr * 64 + fr, fq * 8), boff = lds_byte(wc * 32 + fr, fq * 8);
#define G8_SA(b, h) (((b) * 2 + (h)) * HTB)
#define G8_SB(b, h) ((4 + (b) * 2 + (h)) * HTB)
#define G8_STAGE(bufoff, gbase, v0, v1) do { \
        __builtin_amdgcn_global_load_lds((const unsigned*)((const char*)(gbase) + (v0)), (LAS unsigned*)(lds + (bufoff) + ldsw), 16, 0, 0); \
        __builtin_amdgcn_global_load_lds((const unsigned*)((const char*)(gbase) + (v1)), (LAS unsigned*)(lds + (bufoff) + ldsw + 8192), 16, 0, 0); } while (0)
#define G8_LDA(dst, b, h) do { _Pragma("unroll") for (int m = 0; m < 4; ++m) _Pragma("unroll") for (int k = 0; k < 2; ++k) dst[m][k] = *(const LAS bf16x8*)(lds + G8_SA(b, h) + aoff + m * 2048 + k * 1024); } while (0)
#define G8_LDB(dst, b, h) do { _Pragma("unroll") for (int n = 0; n < 2; ++n) _Pragma("unroll") for (int k = 0; k < 2; ++k) dst[n][k] = *(const LAS bf16x8*)(lds + G8_SB(b, h) + boff + n * 2048 + k * 1024); } while (0)
#define G8_CAT(a, b) __builtin_shufflevector(__builtin_bit_cast(i32x4, a), __builtin_bit_cast(i32x4, b), 0, 1, 2, 3, 4, 5, 6, 7)
#define G8_MMA(ai, bj, At, Bt) do { __builtin_amdgcn_s_setprio(1); \
        if constexpr (F8) { _Pragma("unroll") for (int m = 0; m < 4; ++m) _Pragma("unroll") for (int n = 0; n < 2; ++n) { const i32x8 b8_ = G8_CAT(Bt[n][0], Bt[n][1]), a8_ = G8_CAT(At[m][0], At[m][1]); \
            asm volatile("v_mfma_f32_16x16x128_f8f6f4 %0, %1, %2, %0" : "+v"(acc[ai][bj][m][n]) : "v"(b8_), "v"(a8_)); } } \
        else { _Pragma("unroll") for (int m = 0; m < 4; ++m) _Pragma("unroll") for (int n = 0; n < 2; ++n) _Pragma("unroll") for (int k = 0; k < 2; ++k) \
            acc[ai][bj][m][n] = __builtin_amdgcn_mfma_f32_16x16x32_bf16(Bt[n][k], At[m][k], acc[ai][bj][m][n], 0, 0, 0); } \
        __builtin_amdgcn_s_setprio(0); } while (0)
    GU cur, nxt; int ui = 0;
    if (!S.next(0, cur)) return;
    if constexpr (GATHER) { const LAS int* rw = S.rows(0);
#pragma unroll
        for (int h = 0; h < 2; ++h)
#pragma unroll
            for (int i = 0; i < 2; ++i) vc[h][i] = (unsigned)rw[h * 128 + sR[i]] * lda2 + (unsigned)sC[i] * 2u; }
    f32x4 acc[2][2][4][2];
#pragma unroll
    for (int a = 0; a < 2; ++a)
#pragma unroll
        for (int b = 0; b < 2; ++b)
#pragma unroll
            for (int m = 0; m < 4; ++m)
#pragma unroll
                for (int n = 0; n < 2; ++n) acc[a][b][m][n] = (f32x4){0.f, 0.f, 0.f, 0.f};
    bf16x8 At[4][2], B0[2][2], B1[2][2];
    const char* cA0 = cur.a0; const char* cA1 = cur.a1; const char* cB0 = cur.b0; const char* cB1 = cur.b1;
    G8_STAGE(G8_SB(0, 0), cB0, voffB[0], voffB[1]); G8_STAGE(G8_SA(0, 0), cA0, vc[0][0], vc[0][1]); G8_STAGE(G8_SB(0, 1), cB1, voffB[0], voffB[1]); G8_STAGE(G8_SA(0, 1), cA1, vc[1][0], vc[1][1]);
    if (wr == 1) G8_BAR;
    G8_WAIT_V(4); G8_BAR;
    G8_STAGE(G8_SB(1, 0), cB0 + kstep, voffB[0], voffB[1]); G8_STAGE(G8_SA(1, 0), cA0 + kstep, vc[0][0], vc[0][1]); G8_STAGE(G8_SB(1, 1), cB1 + kstep, voffB[0], voffB[1]);
    G8_WAIT_V(6); G8_BAR;
    for (;;) {
        const bool has_next = S.next(ui + 1, nxt);
        const char* nA0 = has_next ? nxt.a0 : cA0; const char* nA1 = has_next ? nxt.a1 : cA1; const char* nB0 = has_next ? nxt.b0 : cB0; const char* nB1 = has_next ? nxt.b1 : cB1;
        if constexpr (GATHER) {
            if (has_next) { const LAS int* rw = S.rows(ui + 1);
#pragma unroll
                for (int h = 0; h < 2; ++h)
#pragma unroll
                    for (int i = 0; i < 2; ++i) vn[h][i] = (unsigned)rw[h * 128 + sR[i]] * lda2 + (unsigned)sC[i] * 2u; }
            else {
#pragma unroll
                for (int h = 0; h < 2; ++h)
#pragma unroll
                    for (int i = 0; i < 2; ++i) vn[h][i] = vc[h][i]; }
        }
#pragma nounroll
        for (int t = 0; t < nt; t += 2) {
            const bool last = (t == nt - 2);
            const char* a1_1 = cA1 + (size_t)(t + 1) * kstep;
            const char* a2_0 = last ? nA0 : cA0 + (size_t)(t + 2) * kstep; const char* a2_1 = last ? nA1 : cA1 + (size_t)(t + 2) * kstep;
            const char* b2_0 = last ? nB0 : cB0 + (size_t)(t + 2) * kstep; const char* b2_1 = last ? nB1 : cB1 + (size_t)(t + 2) * kstep;
            unsigned w00 = vc[0][0], w01 = vc[0][1], w10 = vc[1][0], w11 = vc[1][1];
            if constexpr (GATHER) { if (last) { w00 = vn[0][0]; w01 = vn[0][1]; w10 = vn[1][0]; w11 = vn[1][1]; } }
            G8_LDB(B0, 0, 0); G8_SCHED; G8_LDA(At, 0, 0); G8_STAGE(G8_SA(1, 1), a1_1, vc[1][0], vc[1][1]);
            G8_WAIT_L(8); G8_BAR; G8_WAIT_L(0); G8_MMA(0, 0, At, B0); G8_BAR; G8_SCHED;
            G8_LDB(B1, 0, 1); G8_STAGE(G8_SB(0, 0), b2_0, voffB[0], voffB[1]);
            G8_BAR; G8_WAIT_L(0); G8_MMA(0, 1, At, B1); G8_BAR;
            G8_LDA(At, 0, 1); G8_STAGE(G8_SA(0, 0), a2_0, w00, w01);
            G8_BAR; G8_WAIT_L(0); G8_MMA(1, 0, At, B0); G8_BAR; G8_SCHED;
            G8_STAGE(G8_SB(0, 1), b2_1, voffB[0], voffB[1]);
            G8_WAIT_V(6); G8_BAR; G8_MMA(1, 1, At, B1); G8_BAR;
            G8_LDB(B0, 1, 0); G8_SCHED; G8_LDA(At, 1, 0); G8_STAGE(G8_SA(0, 1), a2_1, w10, w11);
            G8_WAIT_L(8); G8_BAR; G8_WAIT_L(0); G8_MMA(0, 0, At, B0); G8_BAR; G8_SCHED;
            G8_LDB(B1, 1, 1); G8_STAGE(G8_SB(1, 0), b2_0 + kstep, voffB[0], voffB[1]);
            G8_BAR; G8_WAIT_L(0); G8_MMA(0, 1, At, B1); G8_BAR;
            G8_LDA(At, 1, 1); G8_STAGE(G8_SA(1, 0), a2_0 + kstep, w00, w01);
            G8_BAR; G8_WAIT_L(0); G8_MMA(1, 0, At, B0); G8_BAR; G8_SCHED;
            G8_STAGE(G8_SB(1, 1), b2_1 + kstep, voffB[0], voffB[1]);
            G8_WAIT_V(6); G8_BAR; G8_MMA(1, 1, At, B1); G8_BAR;
        }
        if constexpr (F8) {
#define G8_T(a, b, m) "+v"(acc[a][b][m][0]), "+v"(acc[a][b][m][1])
            asm volatile("s_nop 15\n\ts_nop 15" : G8_T(0, 0, 0), G8_T(0, 0, 1), G8_T(0, 0, 2), G8_T(0, 0, 3), G8_T(0, 1, 0), G8_T(0, 1, 1), G8_T(0, 1, 2), G8_T(0, 1, 3));
            asm volatile("s_nop 1" : G8_T(1, 0, 0), G8_T(1, 0, 1), G8_T(1, 0, 2), G8_T(1, 0, 3), G8_T(1, 1, 0), G8_T(1, 1, 1), G8_T(1, 1, 2), G8_T(1, 1, 3));
#undef G8_T
        }
        E(acc, cur, wr, wc, fr, fq);
        if (!has_next) break;
#pragma unroll
        for (int a = 0; a < 2; ++a)
#pragma unroll
            for (int b = 0; b < 2; ++b)
#pragma unroll
                for (int m = 0; m < 4; ++m)
#pragma unroll
                    for (int n = 0; n < 2; ++n) acc[a][b][m][n] = (f32x4){0.f, 0.f, 0.f, 0.f};
        cur = nxt; cA0 = nA0; cA1 = nA1; cB0 = nB0; cB1 = nB1; ++ui;
        if constexpr (GATHER) {
#pragma unroll
            for (int h = 0; h < 2; ++h)
#pragma unroll
                for (int i = 0; i < 2; ++i) vc[h][i] = vn[h][i]; }
    }
    G8_WAIT_V(0);
    if (wr == 0) G8_BAR;
    G8_BAR;
#undef G8_SA
#undef G8_SB
#undef G8_STAGE
#undef G8_LDA
#undef G8_LDB
#undef G8_MMA
#undef G8_CAT
}
}
using g8::GU;

#define EPI_ARGS const f32x4 (&acc)[2][2][4][2], const GU& u, int wr, int wc, int fr, int fq

__device__ __forceinline__ size_t qk_tile_off(int b, int h, int t, int NH) { return ((size_t)(b * NH + h) * 128 + (t >> 5)) * 2048 + (size_t)(t & 31) * 8; }
__device__ __forceinline__ size_t v_tile_off(int b, int h, int tile, int NH) { return ((size_t)(b * NH + h) * 128 + tile) * 2048; }
struct EpiVt {
    static constexpr bool PERM = true;
    bf16_t* V; int NH;
    __device__ __forceinline__ void operator()(EPI_ARGS) const {
        const int row0 = u.p0 * 256 + wr * 64 + fr, col0 = u.p1 * 256 + wc * 32 + 8 * fq;
#pragma unroll
        for (int ai = 0; ai < 2; ++ai)
#pragma unroll
            for (int m = 0; m < 4; ++m) { const int feat = row0 + ai * 128 + m * 16, h = feat >> 6, d = feat & 63, db = d >> 5, r = d & 31;
#pragma unroll
                for (int bj = 0; bj < 2; ++bj) { const int col = col0 + bj * 128, b = col >> 12, t = col & 4095, mm = (t & 31) >> 3, sI = mm >> 1, jg = mm & 1;
                    const f32x4 v0 = acc[ai][bj][m][0], v1 = acc[ai][bj][m][1];
                    bf16_t* p = V + v_tile_off(b, h, t >> 5, NH) + (size_t)((((db * 2 + sI) * 2) * 32 + r) * 8 + jg * 4);
                    u32x2 w0, w1; w0.x = cvt_pk_bf16(v0[0], v0[1]); w0.y = cvt_pk_bf16(v0[2], v0[3]); w1.x = cvt_pk_bf16(v1[0], v1[1]); w1.y = cvt_pk_bf16(v1[2], v1[3]);
                    *(u32x2*)p = w0; *(u32x2*)(p + 256) = w1; } }
    }
};

struct EpiStoreBf16 {
    static constexpr bool PERM = true;
    bf16_t* O; size_t ld; float scale;
    __device__ __forceinline__ void operator()(EPI_ARGS) const {
        const int row0 = u.p0 * 256 + wr * 64 + fr, col0 = u.p1 * 256 + wc * 32 + 8 * fq;
#pragma unroll
        for (int ai = 0; ai < 2; ++ai)
#pragma unroll
            for (int m = 0; m < 4; ++m) { bf16_t* rowp = O + (size_t)(row0 + ai * 128 + m * 16) * ld + col0;
#pragma unroll
                for (int bj = 0; bj < 2; ++bj) { const f32x4 v0 = acc[ai][bj][m][0] * scale, v1 = acc[ai][bj][m][1] * scale;
                    u32x4 w; w.x = cvt_pk_bf16(v0[0], v0[1]); w.y = cvt_pk_bf16(v0[2], v0[3]); w.z = cvt_pk_bf16(v1[0], v1[1]); w.w = cvt_pk_bf16(v1[2], v1[3]);
                    *(u32x4*)(rowp + bj * 128) = w; } }
    }
};
struct EpiInAB {
    static constexpr bool PERM = true;
    bf16_t* A2; bf16_t* Q; bf16_t* Kk;
    __device__ __forceinline__ void operator()(EPI_ARGS) const {
        const int row0 = u.p0 * 256 + wr * 64 + fr, colt = u.p1 * 256 + wc * 32 + 8 * fq; const int kind = u.p1 >> 1;
        const float sc = (kind == 1) ? QSCALE : 1.0f;
#pragma unroll
        for (int ai = 0; ai < 2; ++ai)
#pragma unroll
            for (int m = 0; m < 4; ++m) { const int row = row0 + ai * 128 + m * 16;
#pragma unroll
                for (int bj = 0; bj < 2; ++bj) { const f32x4 v0 = acc[ai][bj][m][0] * sc, v1 = acc[ai][bj][m][1] * sc; const int col = colt + bj * 128;
                    u32x4 w; w.x = cvt_pk_bf16(v0[0], v0[1]); w.y = cvt_pk_bf16(v0[2], v0[3]); w.z = cvt_pk_bf16(v1[0], v1[1]); w.w = cvt_pk_bf16(v1[2], v1[3]);
                    bf16_t* p;
                    if (kind == 0) { const int g = col >> 4, hp = col & 15, b = row >> 12, l = row & 4095; p = A2 + ((size_t)(g * 1024 + b * NCH + (l >> 5)) * A2LD + (l & 31) * 16 + hp); }
                    else { const int cc = col - (kind == 1 ? 512 : 1024); p = (kind == 1 ? Q : Kk) + qk_tile_off(row >> 12, cc >> 6, row & 4095, 8) + (size_t)((cc & 63) >> 3) * 256; }
                    *(u32x4*)p = w; } }
    }
};
struct EpiInC {
    static constexpr bool PERM = true;
    bf16_t* Q; bf16_t* Kk;
    __device__ __forceinline__ void operator()(EPI_ARGS) const {
        const int row0 = u.p0 * 256 + wr * 64 + fr; const bool isq = u.p1 < 4; const int col0 = (u.p1 & 3) * 256 + wc * 32 + 8 * fq;
        const float sc = isq ? QSCALE : 1.0f; bf16_t* base = isq ? Q : Kk;
#pragma unroll
        for (int ai = 0; ai < 2; ++ai)
#pragma unroll
            for (int m = 0; m < 4; ++m) { const int row = row0 + ai * 128 + m * 16;
#pragma unroll
                for (int bj = 0; bj < 2; ++bj) { const f32x4 v0 = acc[ai][bj][m][0] * sc, v1 = acc[ai][bj][m][1] * sc; const int col = col0 + bj * 128;
                    u32x4 w; w.x = cvt_pk_bf16(v0[0], v0[1]); w.y = cvt_pk_bf16(v0[2], v0[3]); w.z = cvt_pk_bf16(v1[0], v1[1]); w.w = cvt_pk_bf16(v1[2], v1[3]);
                    *(u32x4*)(base + qk_tile_off(row >> 12, col >> 6, row & 4095, 16) + (size_t)((col & 63) >> 3) * 256) = w; } }
    }
};
struct EpiS {
    static constexpr bool PERM = false;
    float* S;
    __device__ __forceinline__ void operator()(EPI_ARGS) const {
        const int row0 = u.p0 * 256 + wr * 64 + fr, col0 = wc * 32 + 4 * fq; float* base = S + (size_t)u.p2 * 1024 * 128;
#pragma unroll
        for (int ai = 0; ai < 2; ++ai)
#pragma unroll
            for (int m = 0; m < 4; ++m) { float* rowp = base + (size_t)(row0 + ai * 128 + m * 16) * 128 + col0;
#pragma unroll
                for (int n = 0; n < 2; ++n) *(f32x4*)(rowp + n * 16) = acc[ai][0][m][n]; }
    }
};
__device__ __forceinline__ float gelu_tanh(float x) { const float a = 0.7978845608f * (x + 0.044715f * x * x * x); return x * rcp(1.0f + ex2(-2.0f * LOG2E * a)); }
struct EpiY {
    static constexpr bool PERM = true;
    bf16_t* Z;
    __device__ __forceinline__ void operator()(EPI_ARGS) const {
        const int row0 = u.p0 * 256 + wr * 64 + fr, col0 = u.p1 * 256 + wc * 32 + 8 * fq, g = u.p2;
#pragma unroll
        for (int ai = 0; ai < 2; ++ai)
#pragma unroll
            for (int m = 0; m < 4; ++m) { const int row = row0 + ai * 128 + m * 16, b = row >> 7, ch = row & 127;
#pragma unroll
                for (int bj = 0; bj < 2; ++bj) { const int col = col0 + bj * 128, t = col >> 4, h = col & 15; const f32x4 v0 = acc[ai][bj][m][0], v1 = acc[ai][bj][m][1];
                    u32x4 w; w.x = cvt_pk_bf16(gelu_tanh(v0[0]), gelu_tanh(v0[1])); w.y = cvt_pk_bf16(gelu_tanh(v0[2]), gelu_tanh(v0[3]));
                    w.z = cvt_pk_bf16(gelu_tanh(v1[0]), gelu_tanh(v1[1])); w.w = cvt_pk_bf16(gelu_tanh(v1[2]), gelu_tanh(v1[3]));
                    *(u32x4*)(Z + (size_t)(b * SEQ + ch * TCH + t) * 512 + g * 16 + h) = w; } }
    }
};
struct EpiGlu {
    static constexpr bool PERM = true;
    const bf16_t* Z; const float* bias; bf16_t* Y;
    __device__ __forceinline__ void operator()(EPI_ARGS) const {
        const int row0 = u.p0 * 256 + wr * 64 + fr, col0 = u.p1 * 256 + wc * 32 + 8 * fq;
#pragma unroll
        for (int bj = 0; bj < 2; ++bj) { const int col = col0 + bj * 128; const f32x4 b0 = *(const f32x4*)(bias + col), b1 = *(const f32x4*)(bias + col + 4);
#pragma unroll
            for (int ai = 0; ai < 2; ++ai)
#pragma unroll
                for (int m = 0; m < 4; ++m) { const int row = row0 + ai * 128 + m * 16; const u32x4 zz = *(const u32x4*)(Z + (size_t)row * 512 + col);
                    const f32x4 v0 = acc[ai][bj][m][0] + b0, v1 = acc[ai][bj][m][1] + b1;
                    u32x4 w; w.x = cvt_pk_bf16(bf_lo(zz.x) * sigmoidf_(v0[0]), bf_hi(zz.x) * sigmoidf_(v0[1])); w.y = cvt_pk_bf16(bf_lo(zz.y) * sigmoidf_(v0[2]), bf_hi(zz.y) * sigmoidf_(v0[3]));
                    w.z = cvt_pk_bf16(bf_lo(zz.z) * sigmoidf_(v1[0]), bf_hi(zz.z) * sigmoidf_(v1[1])); w.w = cvt_pk_bf16(bf_lo(zz.w) * sigmoidf_(v1[2]), bf_hi(zz.w) * sigmoidf_(v1[3]));
                    *(u32x4*)(Y + (size_t)row * 1024 + col) = w; } }
    }
};
struct EpiRes {
    static constexpr bool PERM = false;
    const float* res; float* out;
    __device__ __forceinline__ void operator()(EPI_ARGS) const {
        const int row0 = u.p0 * 256 + wr * 64 + fr, col0 = u.p1 * 256 + wc * 32 + 4 * fq;
#pragma unroll
        for (int ai = 0; ai < 2; ++ai)
#pragma unroll
            for (int m = 0; m < 4; ++m) { const size_t ro = (size_t)(row0 + ai * 128 + m * 16) * 1024 + col0;
#pragma unroll
                for (int bj = 0; bj < 2; ++bj)
#pragma unroll
                    for (int n = 0; n < 2; ++n) { const size_t o = ro + bj * 128 + n * 16; *(f32x4*)(out + o) = *(const f32x4*)(res + o) + acc[ai][bj][m][n]; } }
    }
};
struct EpiSwiglu {
    static constexpr bool PERM = true;
    const float* bg; const float* bu; unsigned char* act;
    __device__ __forceinline__ void operator()(EPI_ARGS) const {
        const int row0 = u.p0 + wr * 64 + fr, col = u.p1 + wc * 32 + 8 * fq; const float* pg = bg + (size_t)u.p2 * 1024 + col; const float* pu = bu + (size_t)u.p2 * 1024 + col;
        const f32x4 g0 = *(const f32x4*)pg, g1 = *(const f32x4*)(pg + 4), u0 = *(const f32x4*)pu, u1 = *(const f32x4*)(pu + 4);
#pragma unroll
        for (int ai = 0; ai < 2; ++ai)
#pragma unroll
            for (int m = 0; m < 4; ++m) { float r[8];
#pragma unroll
                for (int n = 0; n < 2; ++n)
#pragma unroll
                    for (int j = 0; j < 4; ++j) { const float gg = fminf(acc[ai][0][m][n][j] * (1.0f / W8_SCALE) + (n ? g1[j] : g0[j]), 7.0f); const float uu = fminf(fmaxf(acc[ai][1][m][n][j] * (1.0f / W8_SCALE) + (n ? u1[j] : u0[j]), -7.0f), 7.0f);
                        r[n * 4 + j] = gg * sigmoidf_(1.702f * gg) * (uu + 1.0f); }
                u32x2 w; w.x = cvt_pk4_fp8(r[0], r[1], r[2], r[3]); w.y = cvt_pk4_fp8(r[4], r[5], r[6], r[7]);
                *(u32x2*)(act + (size_t)(row0 + ai * 128 + m * 16) * 1024 + col) = w; }
    }
};
struct EpiDown {
    static constexpr bool PERM = true;
    const float* bd; bf16_t* ys;
    __device__ __forceinline__ void operator()(EPI_ARGS) const {
        const int row0 = u.p0 + wr * 64 + fr, col0 = u.p1 + wc * 32 + 8 * fq;
#pragma unroll
        for (int bj = 0; bj < 2; ++bj) { const int col = col0 + bj * 128; const float* pb = bd + (size_t)u.p2 * 1024 + col; const f32x4 b0 = *(const f32x4*)pb, b1 = *(const f32x4*)(pb + 4);
#pragma unroll
            for (int ai = 0; ai < 2; ++ai)
#pragma unroll
                for (int m = 0; m < 4; ++m) { const f32x4 v0 = acc[ai][bj][m][0] * (1.0f / W8_SCALE) + b0, v1 = acc[ai][bj][m][1] * (1.0f / W8_SCALE) + b1;
                    u32x4 w; w.x = cvt_pk_bf16(v0[0], v0[1]); w.y = cvt_pk_bf16(v0[2], v0[3]); w.z = cvt_pk_bf16(v1[0], v1[1]); w.w = cvt_pk_bf16(v1[2], v1[3]);
                    *(u32x4*)(ys + (size_t)(row0 + ai * 128 + m * 16) * 1024 + col) = w; } }
    }
};
struct EpiPle {
    static constexpr bool PERM = true;
    const bf16_t* proj; float* r;
    __device__ __forceinline__ void operator()(EPI_ARGS) const {
        const int row0 = u.p0 * 256 + wr * 64 + fr, col0 = u.p1 * 256 + wc * 32 + 8 * fq;
#pragma unroll
        for (int ai = 0; ai < 2; ++ai)
#pragma unroll
            for (int m = 0; m < 4; ++m) { const size_t ro = (size_t)(row0 + ai * 128 + m * 16) * 1024 + col0;
#pragma unroll
                for (int bj = 0; bj < 2; ++bj) { const size_t o = ro + bj * 128; const u32x4 pp = *(const u32x4*)(proj + o); const f32x4 r0 = *(const f32x4*)(r + o), r1 = *(const f32x4*)(r + o + 4);
                    const f32x4 v0 = acc[ai][bj][m][0] * (1.0f / W8_SCALE), v1 = acc[ai][bj][m][1] * (1.0f / W8_SCALE);
                    f32x4 o0, o1;
                    o0[0] = r0[0] + bf_lo(pp.x) * sigmoidf_(v0[0]); o0[1] = r0[1] + bf_hi(pp.x) * sigmoidf_(v0[1]); o0[2] = r0[2] + bf_lo(pp.y) * sigmoidf_(v0[2]); o0[3] = r0[3] + bf_hi(pp.y) * sigmoidf_(v0[3]);
                    o1[0] = r1[0] + bf_lo(pp.z) * sigmoidf_(v1[0]); o1[1] = r1[1] + bf_hi(pp.z) * sigmoidf_(v1[1]); o1[2] = r1[2] + bf_lo(pp.w) * sigmoidf_(v1[2]); o1[3] = r1[3] + bf_hi(pp.w) * sigmoidf_(v1[3]);
                    *(f32x4*)(r + o) = o0; *(f32x4*)(r + o + 4) = o1; } }
    }
};

struct Args { const float* in[31]; float* out; unsigned char* ws; int ph_lo, ph_hi; unsigned char btab[128]; };
struct Frame {
    LAS unsigned char* lds; int tid, lane, wave, G, bid, gw, GW;
    unsigned char* ws; unsigned* ctl;
};
enum { I_X = 0, I_P, I_NMIX, I_NFFN, I_NPLE, I_NFINAL, I_WINAB, I_ARE, I_AIM, I_BRE, I_BIM, I_CRE, I_CIM, I_SSMD, I_LOGSTEP, I_GLUW, I_GLUB, I_WOUTAB, I_RELB, I_WINC, I_WOUTC,
       I_RW, I_RB, I_WG, I_BG, I_WU, I_BU, I_WD, I_BD, I_WPLE, I_WPLEG };

__device__ __forceinline__ void tconv(const Frame& F, const float* __restrict__ src, bf16_t* __restrict__ dst, int K, int N, int nmat) {
    LAS unsigned* T = (LAS unsigned*)(F.lds + F.wave * 8192);
    const int tk = K >> 6, tn = N >> 6; const long ntiles = (long)nmat * tk * tn;
    const int lane = F.lane, nq = lane & 15, kk = lane >> 4;
    for (long tt = F.gw; tt < ntiles; tt += F.GW) {
        const int mat = (int)(tt / (tk * tn)), rem = (int)(tt % (tk * tn)), kt = rem / tn, ntl = rem % tn;
        const float* s = src + (size_t)mat * K * N + (size_t)(kt * 64) * N + ntl * 64;
        bf16_t* d = dst + (size_t)mat * N * K + (size_t)(ntl * 64) * K + kt * 64;
#pragma unroll
        for (int it = 0; it < 8; ++it) { const int k0 = 8 * it + 2 * kk;
            const f32x4 a = *(const f32x4*)(s + (size_t)k0 * N + 4 * nq), b = *(const f32x4*)(s + (size_t)(k0 + 1) * N + 4 * nq);
#pragma unroll
            for (int j = 0; j < 4; ++j) { const int n = 4 * nq + j, kp = 4 * it + kk; T[32 * n + (kp ^ (4 * (nq & 7)))] = cvt_pk_bf16(a[j], b[j]); } }
        __builtin_amdgcn_fence(__ATOMIC_RELEASE, "wavefront"); __builtin_amdgcn_wave_barrier(); __builtin_amdgcn_fence(__ATOMIC_ACQUIRE, "wavefront");
#pragma unroll
        for (int it = 0; it < 8; ++it) { const int n = 8 * it + (lane >> 3), c = lane & 7;
            const u32x4 v = *(const LAS u32x4*)(T + 32 * n + 4 * (c ^ ((n >> 2) & 7)));
            *(u32x4*)(d + (size_t)n * K + 8 * c) = v; }
        __builtin_amdgcn_fence(__ATOMIC_RELEASE, "wavefront"); __builtin_amdgcn_wave_barrier(); __builtin_amdgcn_fence(__ATOMIC_ACQUIRE, "wavefront");
    }
}
__device__ __forceinline__ void tconv8(const Frame& F, const float* __restrict__ src, unsigned char* __restrict__ dst, int K, int N, int nmat, float sc) {
    LAS unsigned* T = (LAS unsigned*)(F.lds + F.wave * 8192);
    const int tk = K >> 6, tn = N >> 6; const long ntiles = (long)nmat * tk * tn;
    const int lane = F.lane, nq = lane & 15, kk = lane >> 4;
    for (long tt = F.gw; tt < ntiles; tt += F.GW) {
        const int mat = (int)(tt / (tk * tn)), rem = (int)(tt % (tk * tn)), kt = rem / tn, ntl = rem % tn;
        const float* s = src + (size_t)mat * K * N + (size_t)(kt * 64) * N + ntl * 64;
        unsigned char* d = dst + (size_t)mat * N * K + (size_t)(ntl * 64) * K + kt * 64;
#pragma unroll
        for (int it = 0; it < 4; ++it) { const int k0 = 16 * it + 4 * kk; f32x4 a[4];
#pragma unroll
            for (int q = 0; q < 4; ++q) a[q] = *(const f32x4*)(s + (size_t)(k0 + q) * N + 4 * nq) * sc;
#pragma unroll
            for (int j = 0; j < 4; ++j) { const int n = 4 * nq + j; T[16 * n + (((it ^ (nq & 3)) << 2) | kk)] = cvt_pk4_fp8(a[0][j], a[1][j], a[2][j], a[3][j]); } }
        __builtin_amdgcn_fence(__ATOMIC_RELEASE, "wavefront"); __builtin_amdgcn_wave_barrier(); __builtin_amdgcn_fence(__ATOMIC_ACQUIRE, "wavefront");
#pragma unroll
        for (int it = 0; it < 4; ++it) { const int n = 16 * it + (lane >> 2), c = lane & 3;
            const u32x4 v = *(const LAS u32x4*)(T + 16 * n + 4 * (c ^ ((n >> 2) & 3)));
            *(u32x4*)(d + (size_t)n * K + 16 * c) = v; }
        __builtin_amdgcn_fence(__ATOMIC_RELEASE, "wavefront"); __builtin_amdgcn_wave_barrier(); __builtin_amdgcn_fence(__ATOMIC_ACQUIRE, "wavefront");
    }
}
__device__ __forceinline__ void conv_plain(const Frame& F, const float* __restrict__ src, bf16_t* __restrict__ dst, size_t n) {
    const size_t nth = (size_t)F.G * 512;
    for (size_t i = ((size_t)F.bid * 512 + F.tid) * 8; i < n; i += nth * 8) { const f32x4 a = *(const f32x4*)(src + i), b = *(const f32x4*)(src + i + 4);
        u32x4 w; w.x = cvt_pk_bf16(a[0], a[1]); w.y = cvt_pk_bf16(a[2], a[3]); w.z = cvt_pk_bf16(b[0], b[1]); w.w = cvt_pk_bf16(b[2], b[3]); *(u32x4*)(dst + i) = w; }
}
template <bool F32OUT>
__device__ __forceinline__ void rmsnorm_rows(const Frame& F, const float* __restrict__ src, const float* __restrict__ gain, bf16_t* __restrict__ dst, float* outf, int nrows) {
    const int lane = F.lane;
    f32x4 gv[4];
#pragma unroll
    for (int j = 0; j < 4; ++j) gv[j] = *(const f32x4*)(gain + 4 * (lane + 64 * j));
    for (int row = F.gw; row < nrows; row += F.GW) {
        const float* s = src + (size_t)row * 1024; f32x4 v[4]; float ss = 0.f;
#pragma unroll
        for (int j = 0; j < 4; ++j) { v[j] = *(const f32x4*)(s + 4 * (lane + 64 * j)); ss += v[j][0] * v[j][0] + v[j][1] * v[j][1] + v[j][2] * v[j][2] + v[j][3] * v[j][3]; }
        ss = wave_sum(ss); const float rstd = rsqrtf(ss * (1.0f / 1024.0f) + RMS_EPS);
#pragma unroll
        for (int j = 0; j < 4; ++j) { const f32x4 y = v[j] * rstd * gv[j];
            if (F32OUT) *(f32x4*)(outf + (size_t)row * 1024 + 4 * (lane + 64 * j)) = y;
            else { u32x2 w; w.x = cvt_pk_bf16(y[0], y[1]); w.y = cvt_pk_bf16(y[2], y[3]); *(u32x2*)(dst + (size_t)row * 1024 + 4 * (lane + 64 * j)) = w; } }
    }
}

__device__ __forceinline__ void s5_matrices(const Frame& F, const Args& a) {
    LAS float* Pr = (LAS float*)F.lds;
    LAS float* Pi = Pr + 33 * 64;
    LAS float* Br = Pi + 33 * 64;
    LAS float* Bi = Br + 1024;
    LAS float* Cr = Bi + 1024;
    LAS float* Ci = Cr + 1024;
    LAS float* Kf = Ci + 1024;
    LAS float* coefr = Kf + 8192; LAS float* coefi = coefr + 64;
    bf16_t* WbT = (bf16_t*)(F.ws + WS_WBT); bf16_t* My = (bf16_t*)(F.ws + WS_MY);
    const int t = F.tid;
    for (int g = F.bid; g < NGRP; g += F.G) {
        __syncthreads();
        if (t < 64) { const int n = t; const float are = a.in[I_ARE][g * 64 + n], aim = a.in[I_AIM][g * 64 + n], step = __expf(a.in[I_LOGSTEP][g]);
            for (int d = 0; d <= 32; ++d) { const float mag = __expf(are * step * (float)d); float rev = aim * step * (float)d * 0.15915494309189535f; rev -= rintf(rev);
                Pr[d * 64 + n] = mag * __builtin_amdgcn_cosf(rev); Pi[d * 64 + n] = mag * __builtin_amdgcn_sinf(rev); }
            const float lr = Pr[64 + n] - 1.0f, li = Pi[64 + n], den = 1.0f / (are * are + aim * aim);
            coefr[n] = (lr * are + li * aim) * den; coefi[n] = (li * are - lr * aim) * den; }
        __syncthreads();
        for (int idx = t; idx < 1024; idx += 512) { const int n = idx >> 4; const float br = a.in[I_BRE][g * 1024 + idx], bi = a.in[I_BIM][g * 1024 + idx];
            Br[idx] = coefr[n] * br - coefi[n] * bi; Bi[idx] = coefr[n] * bi + coefi[n] * br;
            Cr[idx] = a.in[I_CRE][g * 1024 + idx]; Ci[idx] = a.in[I_CIM][g * 1024 + idx]; }
        __syncthreads();
        { const int hh = t & 255, h = hh >> 4, hp = hh & 15;
          for (int d = t >> 8; d < 32; d += 2) { float s = 0.f;
              for (int n = 0; n < 64; ++n) { const float cr = Cr[h * 64 + n], ci = Ci[h * 64 + n], pr = Pr[d * 64 + n], pi = Pi[d * 64 + n];
                  const float mr = cr * pr - ci * pi, mi = cr * pi + ci * pr; s += mr * Br[n * 16 + hp] - mi * Bi[n * 16 + hp]; }
              if (d == 0 && h == hp) s += a.in[I_SSMD][g * 16 + h];
              Kf[d * 256 + hh] = s; } }
        __syncthreads();
        for (int ch = t; ch < 256 * 64; ch += 512) { const int row = ch >> 6, k0 = (ch & 63) * 8, s = k0 >> 4, hp0 = k0 & 15; float v[8];
            if (row < 128) { const int n = row & 63; const float pr = Pr[(31 - s) * 64 + n], pi = Pi[(31 - s) * 64 + n];
#pragma unroll
                for (int j = 0; j < 8; ++j) { const float br = Br[n * 16 + hp0 + j], bi = Bi[n * 16 + hp0 + j]; v[j] = (row < 64) ? (pr * br - pi * bi) : (pr * bi + pi * br); } }
            else {
#pragma unroll
                for (int j = 0; j < 8; ++j) v[j] = 0.f; }
            u32x4 w; w.x = cvt_pk_bf16(v[0], v[1]); w.y = cvt_pk_bf16(v[2], v[3]); w.z = cvt_pk_bf16(v[4], v[5]); w.w = cvt_pk_bf16(v[6], v[7]);
            *(u32x4*)(WbT + ((size_t)g * 256 + row) * 512 + k0) = w; }
        for (int ch = t; ch < 512 * 80; ch += 512) { const int row = ch / 80, k0 = (ch % 80) * 8, tt = row >> 4, h = row & 15; float v[8];
            if (k0 < 512) { const int s = k0 >> 4, hp0 = k0 & 15;
#pragma unroll
                for (int j = 0; j < 8; ++j) v[j] = (s <= tt) ? Kf[(tt - s) * 256 + h * 16 + hp0 + j] : 0.f; }
            else { const int n0 = (k0 - 512) & 63; const bool im = k0 >= 576;
#pragma unroll
                for (int j = 0; j < 8; ++j) { const int n = n0 + j; const float cr = Cr[h * 64 + n], ci = Ci[h * 64 + n], pr = Pr[(tt + 1) * 64 + n], pi = Pi[(tt + 1) * 64 + n];
                    v[j] = im ? -(cr * pi + ci * pr) : (cr * pr - ci * pi); } }
            u32x4 w; w.x = cvt_pk_bf16(v[0], v[1]); w.y = cvt_pk_bf16(v[2], v[3]); w.z = cvt_pk_bf16(v[4], v[5]); w.w = cvt_pk_bf16(v[6], v[7]);
            *(u32x4*)(My + ((size_t)g * 512 + row) * A2LD + k0) = w; }
    }
    __syncthreads();
}

__device__ __forceinline__ void conv_moe_weights(const Frame& F, const Args& a, int layer) {
    unsigned char* W = (unsigned char*)(F.ws + WS_MOEW); const size_t L = (size_t)NEXP * 1024 * 1024;
    tconv8(F, a.in[I_WG] + layer * L, W, 1024, 1024, NEXP, W8_SCALE);
    tconv8(F, a.in[I_WU] + layer * L, W + L, 1024, 1024, NEXP, W8_SCALE);
    tconv8(F, a.in[I_WD] + layer * L, W + 2 * L, 1024, 1024, NEXP, W8_SCALE);
}

__device__ __forceinline__ void p0_prologue(const Frame& F, const Args& a) {
    s5_matrices(F, a);
    tconv(F, a.in[I_WINAB], (bf16_t*)(F.ws + WS_WINAB), 1024, 2048, 1);
    tconv(F, a.in[I_GLUW], (bf16_t*)(F.ws + WS_GLU), 512, 512, 1);
    tconv(F, a.in[I_WOUTAB], (bf16_t*)(F.ws + WS_WOUTAB), 1024, 1024, 1);
    tconv(F, a.in[I_WINC], (bf16_t*)(F.ws + WS_WINC), 1024, 3072, 1);
    tconv(F, a.in[I_WOUTC], (bf16_t*)(F.ws + WS_WOUTC), 1024, 1024, 1);
    tconv(F, a.in[I_WPLE], (bf16_t*)(F.ws + WS_WPLE), 256, 1024, 2);
    tconv8(F, a.in[I_WPLEG], (unsigned char*)(F.ws + WS_WPLEG), 1024, 1024, 2, W8_SCALE);
    conv_moe_weights(F, a, 0);
    conv_plain(F, a.in[I_P], (bf16_t*)(F.ws + WS_PB), (size_t)2 * NTOK * PLE);
    rmsnorm_rows<false>(F, a.in[I_X], a.in[I_NMIX], (bf16_t*)(F.ws + WS_H), nullptr, NTOK);
}

__device__ __forceinline__ void s5_scan(const Frame& F, const Args& a) {
    const float* S = (const float*)(F.ws + RA_SS); bf16_t* A2 = (bf16_t*)(F.ws + RA_A2);
    const int n = F.lane;
    for (int item = F.gw; item < NGRP * NBATCH; item += F.GW) {
        const int g = item >> 3, b = item & 7;
        const float are = a.in[I_ARE][g * 64 + n], aim = a.in[I_AIM][g * 64 + n], step = __expf(a.in[I_LOGSTEP][g]);
        const float mag = __expf(are * step * 32.0f); float rev = aim * step * 32.0f * 0.15915494309189535f; rev -= rintf(rev);
        const float lr = mag * __builtin_amdgcn_cosf(rev), li = mag * __builtin_amdgcn_sinf(rev);
        float xr = 0.f, xi = 0.f;
        const float* sp = S + ((size_t)g * 1024 + b * NCH) * 128 + n; bf16_t* xp = A2 + ((size_t)g * 1024 + b * NCH) * A2LD + 512 + n;
        for (int c0 = 0; c0 < NCH; c0 += 16) {
            float sr[16], si[16];
#pragma unroll
            for (int j = 0; j < 16; ++j) { sr[j] = sp[(size_t)(c0 + j) * 128]; si[j] = sp[(size_t)(c0 + j) * 128 + 64]; }
#pragma unroll
            for (int j = 0; j < 16; ++j) { xp[(size_t)(c0 + j) * A2LD] = f2bf(xr); xp[(size_t)(c0 + j) * A2LD + 64] = f2bf(xi);
                const float nr = lr * xr - li * xi + sr[j], ni = lr * xi + li * xr + si[j]; xr = nr; xi = ni; }
        }
    }
}

__device__ __forceinline__ void moba_kmean(const Frame& F) {
    const bf16_t* Kk = (const bf16_t*)(F.ws + RA_K0); float* KM = (float*)(F.ws + RB_KMEAN);
    const int lane = F.lane;
    for (int item = F.gw; item < NBATCH * MH * NMB; item += F.GW) {
        const int j = item & 15, h = (item >> 4) & 7, b = item >> 7;
        const bf16_t* p = Kk + qk_tile_off(b, h, j * MBLK, 8) + (size_t)lane * 8;
        float s[4][8];
#pragma unroll
        for (int q = 0; q < 4; ++q)
#pragma unroll
            for (int i = 0; i < 8; ++i) s[q][i] = 0.f;
        for (int it4 = 0; it4 < 8; ++it4) {
#pragma unroll
            for (int q = 0; q < 4; ++q) { const u32x4 v = *(const u32x4*)(p + (size_t)(it4 * 4 + q) * 512);
                s[q][0] += bf_lo(v.x); s[q][1] += bf_hi(v.x); s[q][2] += bf_lo(v.y); s[q][3] += bf_hi(v.y); s[q][4] += bf_lo(v.z); s[q][5] += bf_hi(v.z); s[q][6] += bf_lo(v.w); s[q][7] += bf_hi(v.w); } }
#pragma unroll
        for (int q = 0; q < 4; ++q)
#pragma unroll
            for (int i = 0; i < 8; ++i) { float v = s[q][i]; v += __shfl_xor(v, 1); v += __shfl_xor(v, 2); v += __shfl_xor(v, 4); v += __shfl_xor(v, 8); v += __shfl_xor(v, 16); s[q][i] = v; }
        if ((lane & 31) == 0) { const int hf = lane >> 5;
#pragma unroll
            for (int q = 0; q < 4; ++q)
#pragma unroll
                for (int i = 0; i < 8; ++i) KM[(size_t)item * 64 + (hf + 2 * q) * 8 + i] = s[q][i] * (1.0f / 256.0f); }
    }
}
__device__ __forceinline__ void moba_gate(const Frame& F) {
    const bf16_t* Q = (const bf16_t*)(F.ws + RA_Q0); const float* KM = (const float*)(F.ws + RB_KMEAN); int* LIST = (int*)(F.ws + RB_MOBALIST); unsigned* CNT = F.ctl + CW_MOBACNT;
    const int t = F.tid, sub = t >> 8, tq = t & 255;
    LAS float* km = (LAS float*)F.lds + sub * 1024;
    LAS int* lcnt = (LAS int*)(F.lds + 8192) + sub * 32;
    const int nitem = NBATCH * MH * 15;
    for (int it0 = F.bid * 2; it0 < nitem; it0 += F.G * 2) {
        const int item = it0 + sub; const bool act = item < nitem;
        const int i = act ? 1 + item % 15 : 1, bh = act ? item / 15 : 0, b = bh >> 3, h = bh & 7;
        __syncthreads();
        for (int x = tq; x < i * 64; x += 256) km[x] = KM[(size_t)bh * 1024 + x];
        if (tq < 32) lcnt[tq] = 0;
        __syncthreads();
        int sel[3] = {0, 0, 0}, lpos[3] = {0, 0, 0}; const int nsel = i < 3 ? i : 3;
        if (act) {
            const bf16_t* qp = Q + qk_tile_off(b, h, i * MBLK + tq, 8); float qv[64];
#pragma unroll
            for (int c = 0; c < 8; ++c) { const u32x4 v = *(const u32x4*)(qp + c * 256); qv[c * 8 + 0] = bf_lo(v.x); qv[c * 8 + 1] = bf_hi(v.x); qv[c * 8 + 2] = bf_lo(v.y); qv[c * 8 + 3] = bf_hi(v.y);
                qv[c * 8 + 4] = bf_lo(v.z); qv[c * 8 + 5] = bf_hi(v.z); qv[c * 8 + 6] = bf_lo(v.w); qv[c * 8 + 7] = bf_hi(v.w); }
            float v0 = -3.0e38f, v1 = -3.0e38f, v2 = -3.0e38f; int i0 = 0, i1 = 0, i2 = 0;
            for (int j = 0; j < i; ++j) { float gsum = 0.f;
#pragma unroll
                for (int d = 0; d < 64; ++d) gsum += qv[d] * km[j * 64 + d];
                if (gsum > v0) { v2 = v1; i2 = i1; v1 = v0; i1 = i0; v0 = gsum; i0 = j; } else if (gsum > v1) { v2 = v1; i2 = i1; v1 = gsum; i1 = j; } else if (gsum > v2) { v2 = gsum; i2 = j; } }
            sel[0] = i0; sel[1] = i1; sel[2] = i2;
#pragma unroll
            for (int s = 0; s < 3; ++s) if (s < nsel) lpos[s] = atomicAdd((int*)&lcnt[sel[s]], 1);
        }
        __syncthreads();
        if (act && tq < 16 && lcnt[tq] > 0) lcnt[16 + tq] = (int)__hip_atomic_fetch_add(CNT + bh * 16 + tq, (unsigned)lcnt[tq], __ATOMIC_RELAXED, __HIP_MEMORY_SCOPE_AGENT);
        __syncthreads();
        if (act) {
#pragma unroll
            for (int s = 0; s < 3; ++s) if (s < nsel) LIST[((size_t)bh * 16 + sel[s]) * 4096 + lcnt[16 + sel[s]] + lpos[s]] = (i * MBLK + tq) | (s << 12); }
    }
    __syncthreads();
}

__device__ __forceinline__ void stage_o_rows(LAS unsigned char* wl, const f32x16& o0, const f32x16& o1, float sc, int r, int hf) {
#pragma unroll
    for (int g = 0; g < 4; ++g) { u32x2 w0, w1; w0.x = cvt_pk_bf16(o0[4 * g] * sc, o0[4 * g + 1] * sc); w0.y = cvt_pk_bf16(o0[4 * g + 2] * sc, o0[4 * g + 3] * sc);
        w1.x = cvt_pk_bf16(o1[4 * g] * sc, o1[4 * g + 1] * sc); w1.y = cvt_pk_bf16(o1[4 * g + 2] * sc, o1[4 * g + 3] * sc);
        *(LAS u32x2*)(wl + r * 128 + ((g ^ (r & 7)) << 4) + hf * 8) = w0; *(LAS u32x2*)(wl + r * 128 + (((4 + g) ^ (r & 7)) << 4) + hf * 8) = w1; }
    __builtin_amdgcn_fence(__ATOMIC_RELEASE, "wavefront"); __builtin_amdgcn_wave_barrier(); __builtin_amdgcn_fence(__ATOMIC_ACQUIRE, "wavefront");
}
__device__ __forceinline__ u32x4 read_o_row(const LAS unsigned char* wl, int q, int c) { return *(const LAS u32x4*)(wl + q * 128 + ((c ^ (q & 7)) << 4)); }
struct KFrag { bf16x8 f[4]; };
__device__ __forceinline__ KFrag load_kfrag(const bf16_t* kp) { KFrag k;
#pragma unroll
    for (int s = 0; s < 4; ++s) k.f[s] = *(const bf16x8*)(kp + 512 * s);
    return k; }
struct VFrag { bf16x8 f[2][2]; };
__device__ __forceinline__ VFrag load_vfrag(const bf16_t* vp) { VFrag v;
#pragma unroll
    for (int db = 0; db < 2; ++db)
#pragma unroll
        for (int s = 0; s < 2; ++s) v.f[db][s] = *(const bf16x8*)(vp + (db * 2 + s) * 512);
    return v; }
template <bool OWN>
__device__ __forceinline__ void moba_task(const bf16_t* __restrict__ Q, const bf16_t* __restrict__ Kk, const bf16_t* __restrict__ Vt, bf16_t* __restrict__ PO, float* __restrict__ PML,
                                          const LAS float* tab, LAS unsigned char* wl, int b, int h, int tq, bool valid, int slot, int key_base, int ntile, int tmin, int lane) {
    const int r = lane & 31, hf = lane >> 5; const size_t tokb = (size_t)b * SEQ;
    bf16x8 qf[4];
    { const bf16_t* qp = Q + qk_tile_off(b, h, tq, 8) + hf * 256;
#pragma unroll
      for (int s = 0; s < 4; ++s) qf[s] = *(const bf16x8*)(qp + 512 * s); }
    const bf16_t* kbase = Kk + qk_tile_off(b, h, key_base, 8) + hf * 256 + r * 8;
    const bf16_t* vbase = Vt + v_tile_off(b, h, key_base >> 5, 8) + hf * 256 + r * 8;
    KFrag k0 = load_kfrag(kbase);
    VFrag v0 = load_vfrag(vbase);
    f32x16 o0, o1;
#pragma unroll
    for (int i = 0; i < 16; ++i) { o0[i] = 0.f; o1[i] = 0.f; }
    float m = -1.0e30f, l = 0.f; const float b31 = tab[h * 128 + 127];
    for (int kt = 0; kt < ntile; ++kt) {
        const int key0 = key_base + 32 * kt;
        const int kn1 = (kt + 1 < ntile) ? kt + 1 : ntile - 1;
        const KFrag k1 = load_kfrag(kbase + (size_t)kn1 * 2048);
        const VFrag v1 = load_vfrag(vbase + (size_t)kn1 * 2048);
        f32x16 x;
#pragma unroll
        for (int i = 0; i < 16; ++i) x[i] = 0.f;
#pragma unroll
        for (int s = 0; s < 4; ++s) x = mfma32(k0.f[s], qf[s], x);
        if (tmin - (key0 + 31) < 113) {
#pragma unroll
            for (int i = 0; i < 16; ++i) { const int row = (i & 3) + 8 * (i >> 2) + 4 * hf; const int dist = tq - (key0 + row); const int idx = dist < 0 ? 0 : (dist > 127 ? 127 : dist);
                x[i] += tab[h * 128 + idx]; if (OWN && dist < 0) x[i] = -1.0e30f; }
        } else {
#pragma unroll
            for (int i = 0; i < 16; ++i) x[i] += b31;
        }
        float mx = x[0];
#pragma unroll
        for (int i = 1; i < 16; ++i) mx = fmaxf(mx, x[i]);
        mx = fmaxf(mx, __shfl_xor(mx, 32));
        const float mn = fmaxf(m, mx), alpha = ex2(m - mn); m = mn;
        float ps = 0.f; unsigned pw[8];
#pragma unroll
        for (int i = 0; i < 8; ++i) { const float p0 = ex2(x[2 * i] - mn), p1 = ex2(x[2 * i + 1] - mn); ps += p0 + p1; pw[i] = cvt_pk_bf16(p0, p1); }
        l = l * alpha + ps;
        o0 *= alpha; o1 *= alpha;
#pragma unroll
        for (int s = 0; s < 2; ++s) { u32x4 pf; pf.x = pw[4 * s]; pf.y = pw[4 * s + 1]; pf.z = pw[4 * s + 2]; pf.w = pw[4 * s + 3];
            const bf16x8 pb = __builtin_bit_cast(bf16x8, pf);
            o0 = mfma32(v0.f[0][s], pb, o0); o1 = mfma32(v0.f[1][s], pb, o1); }
        k0 = k1; v0 = v1;
    }
    l += __shfl_xor(l, 32);
    const int pi = valid ? (int)(((tokb + tq) * 8 + h) * 4 + slot) : -1;
    stage_o_rows(wl, o0, o1, 1.0f / l, r, hf);
#pragma unroll
    for (int it = 0; it < 4; ++it) { const int q = it * 8 + (lane >> 3), c = lane & 7; const int pq = __shfl(pi, q); const u32x4 v = read_o_row(wl, q, c);
        if (pq >= 0) *(u32x4*)(PO + (size_t)pq * 64 + c * 8) = v; }
    if (valid && hf == 0) { f32x2 ml; ml.x = m; ml.y = l; *(f32x2*)(PML + (size_t)pi * 2) = ml; }
    __builtin_amdgcn_fence(__ATOMIC_RELEASE, "wavefront"); __builtin_amdgcn_wave_barrier(); __builtin_amdgcn_fence(__ATOMIC_ACQUIRE, "wavefront");
}

__device__ __forceinline__ void moba_attn(const Frame& F, const Args& a) {
    const bf16_t* Q = (const bf16_t*)(F.ws + RA_Q0); const bf16_t* Kk = (const bf16_t*)(F.ws + RA_K0); const bf16_t* Vt = (const bf16_t*)(F.ws + RA_VT0);
    bf16_t* PO = (bf16_t*)(F.ws + RB_PARTO); float* PML = (float*)(F.ws + RB_PARTML); const int* LIST = (const int*)(F.ws + RB_MOBALIST); unsigned* CNT = F.ctl + CW_MOBACNT;
    LAS float* tab = (LAS float*)F.lds;
    LAS int* pre = (LAS int*)(F.lds + 4096);
    LAS int* cnts = (LAS int*)(F.lds + 4096 + 4128);
    LAS int* wsum = (LAS int*)(F.lds + 4096 + 4128 + 4096);
    LAS unsigned char* wl = F.lds + 16384 + F.wave * 4096;
    const int t = F.tid, lane = F.lane;
    __syncthreads();
    for (int x = t; x < 1024; x += 512) { const int hh = x >> 7, dd = x & 127; tab[x] = a.in[I_RELB][a.btab[dd] * 8 + hh] * LOG2E; }
    { const int c0 = (int)__hip_atomic_load(CNT + 2 * t, __ATOMIC_RELAXED, __HIP_MEMORY_SCOPE_AGENT), c1 = (int)__hip_atomic_load(CNT + 2 * t + 1, __ATOMIC_RELAXED, __HIP_MEMORY_SCOPE_AGENT);
      cnts[2 * t] = c0; cnts[2 * t + 1] = c1; const int t0 = (c0 + 31) >> 5, t1 = (c1 + 31) >> 5; int s = t0 + t1, inc = s;
#pragma unroll
      for (int o = 1; o < 64; o <<= 1) { const int v = __shfl_up(inc, o); if (lane >= o) inc += v; }
      if (lane == 63) wsum[F.wave] = inc;
      __syncthreads();
      int base = 0; for (int w = 0; w < F.wave; ++w) base += wsum[w];
      const int ex = base + inc - s; pre[2 * t] = ex; pre[2 * t + 1] = ex + t0; if (t == 511) pre[1024] = ex + s; }
    __syncthreads();
    const int nsel = pre[1024], ntask = nsel + NBATCH * MH * NMB * 8;
    for (int task = F.gw; task < ntask; task += F.GW) {
        if (task < nsel) {
            int lo = 0, hi = 1023;
            while (lo < hi) { const int mid = (lo + hi + 1) >> 1; if (pre[mid] <= task) lo = mid; else hi = mid - 1; }
            const int list = lo, chunk = task - pre[list], cnt = cnts[list], bh = list >> 4, j = list & 15;
            const int idx = chunk * 32 + (lane & 31); const bool valid = idx < cnt; const int e = valid ? LIST[(size_t)list * 4096 + idx] : 4095;
            const int tq = e & 4095, slot = valid ? (e >> 12) : 0; int tmin = tq;
#pragma unroll
            for (int o = 32; o >= 1; o >>= 1) tmin = min(tmin, __shfl_xor(tmin, o));
            moba_task<false>(Q, Kk, Vt, PO, PML, tab, wl, bh >> 3, bh & 7, tq, valid, slot, j * MBLK, 8, tmin, lane);
        } else {
            const int o = task - nsel, qg = o & 7, i = (o >> 3) & 15, bh = o >> 7; const int t0 = i * MBLK + 32 * qg;
            moba_task<true>(Q, Kk, Vt, PO, PML, tab, wl, bh >> 3, bh & 7, t0 + (lane & 31), true, 3, i * MBLK, qg + 1, t0, lane);
        }
    }
    __syncthreads();
}
__device__ __forceinline__ void moba_combine(const Frame& F) {
    const bf16_t* PO = (const bf16_t*)(F.ws + RB_PARTO); const float* PML = (const float*)(F.ws + RB_PARTML); bf16_t* Y = (bf16_t*)(F.ws + RB_YCAT);
    const int lane = F.lane, h = lane >> 3, dc = lane & 7;
    for (int tok = F.gw; tok < NTOK; tok += F.GW) {
        const int i = (tok & 4095) >> 8, nsel = i < 3 ? i : 3; const size_t pb = ((size_t)tok * 8 + h) * 4;
        float mm[4], ll[4]; float M = -3.0e38f;
#pragma unroll
        for (int s = 0; s < 4; ++s) { const bool v = (s == 3) || (s < nsel); if (v) { const f32x2 ml = *(const f32x2*)(PML + (pb + s) * 2); mm[s] = ml.x; ll[s] = ml.y; M = fmaxf(M, ml.x); } else { mm[s] = -3.0e38f; ll[s] = 0.f; } }
        float acc[8], den = 0.f;
#pragma unroll
        for (int j = 0; j < 8; ++j) acc[j] = 0.f;
#pragma unroll
        for (int s = 0; s < 4; ++s) { const bool v = (s == 3) || (s < nsel); if (v) { const float w = ll[s] * ex2(mm[s] - M); den += w; const u32x4 o = *(const u32x4*)(PO + (pb + s) * 64 + dc * 8);
            acc[0] += w * bf_lo(o.x); acc[1] += w * bf_hi(o.x); acc[2] += w * bf_lo(o.y); acc[3] += w * bf_hi(o.y); acc[4] += w * bf_lo(o.z); acc[5] += w * bf_hi(o.z); acc[6] += w * bf_lo(o.w); acc[7] += w * bf_hi(o.w); } }
        const float inv = 1.0f / den;
        u32x4 w; w.x = cvt_pk_bf16(acc[0] * inv, acc[1] * inv); w.y = cvt_pk_bf16(acc[2] * inv, acc[3] * inv); w.z = cvt_pk_bf16(acc[4] * inv, acc[5] * inv); w.w = cvt_pk_bf16(acc[6] * inv, acc[7] * inv);
        *(u32x4*)(Y + (size_t)tok * 1024 + 512 + h * 64 + dc * 8) = w;
    }
}

__device__ __forceinline__ void sb_attn(const Frame& F) {
    const bf16_t* Q = (const bf16_t*)(F.ws + RA_Q1); const bf16_t* Kk = (const bf16_t*)(F.ws + RA_K1); const bf16_t* Vt = (const bf16_t*)(F.ws + RA_VT1); bf16_t* Y = (bf16_t*)(F.ws + RB_Y1);
    const int lane = F.lane, r = lane & 31, hf = lane >> 5;
    LAS unsigned char* wl = F.lds + F.wave * 4096;
    bf16x8 tri[2];
#pragma unroll
    for (int s = 0; s < 2; ++s)
#pragma unroll
        for (int j = 0; j < 8; ++j) { const int kap = 16 * s + 8 * (j >> 2) + 4 * hf + (j & 3); tri[s][j] = (kap >= r) ? (short)0x3F80 : (short)0; }
    const int ntask = NBATCH * 16 * (SEQ / 32);
    for (int task = F.gw; task < ntask; task += F.GW) {
        const int qt = task & 127, head = (task >> 7) & 15, b = task >> 11; const int t0 = qt * 32; const size_t tokb = (size_t)b * SEQ;
        bf16x8 qf[4];
        { const bf16_t* qp = Q + qk_tile_off(b, head, t0, 16) + hf * 256 + r * 8;
#pragma unroll
          for (int s = 0; s < 4; ++s) qf[s] = *(const bf16x8*)(qp + 512 * s); }
        f32x16 o0, o1;
#pragma unroll
        for (int i = 0; i < 16; ++i) { o0[i] = 0.f; o1[i] = 0.f; }
        float carry = 0.f;
        const bf16_t* kbase = Kk + qk_tile_off(b, head, 0, 16) + hf * 256 + r * 8;
        const bf16_t* vbase = Vt + v_tile_off(b, head, 0, 16) + hf * 256 + r * 8;
        KFrag k0 = load_kfrag(kbase + (size_t)qt * 2048);
        VFrag v0 = load_vfrag(vbase + (size_t)qt * 2048);
        for (int key0 = t0; key0 >= 0; key0 -= 32) {
            const bool diag = (key0 == t0);
            const int kp1 = key0 >= 32 ? key0 - 32 : 0;
            const KFrag k1 = load_kfrag(kbase + (size_t)(kp1 >> 5) * 2048);
            const VFrag v1 = load_vfrag(vbase + (size_t)(kp1 >> 5) * 2048);
            f32x16 x;
#pragma unroll
            for (int i = 0; i < 16; ++i) x[i] = 0.f;
#pragma unroll
            for (int s = 0; s < 4; ++s) x = mfma32(k0.f[s], qf[s], x);
            float sp[16];
#pragma unroll
            for (int i = 0; i < 16; ++i) { const int row = (i & 3) + 8 * (i >> 2) + 4 * hf; const float zl = x[i];
                float v = fmaxf(zl, 0.f) + lg2(1.0f + ex2(-fabsf(zl))); if (diag && row >= r) v = 0.f; sp[i] = v; }
            unsigned hw[8], lw[8];
#pragma unroll
            for (int i = 0; i < 8; ++i) { hw[i] = cvt_pk_bf16(sp[2 * i], sp[2 * i + 1]); lw[i] = cvt_pk_bf16(sp[2 * i] - bf_lo(hw[i]), sp[2 * i + 1] - bf_hi(hw[i])); }
            f32x16 y;
#pragma unroll
            for (int i = 0; i < 16; ++i) y[i] = 0.f;
#pragma unroll
            for (int s = 0; s < 2; ++s) { u32x4 a, c; a.x = hw[4 * s]; a.y = hw[4 * s + 1]; a.z = hw[4 * s + 2]; a.w = hw[4 * s + 3]; c.x = lw[4 * s]; c.y = lw[4 * s + 1]; c.z = lw[4 * s + 2]; c.w = lw[4 * s + 3];
                y = mfma32(tri[s], __builtin_bit_cast(bf16x8, a), y); y = mfma32(tri[s], __builtin_bit_cast(bf16x8, c), y); }
            unsigned pw[8];
#pragma unroll
            for (int i = 0; i < 8; ++i) { const int i0 = 2 * i, i1 = 2 * i + 1; const int row0 = (i0 & 3) + 8 * (i0 >> 2) + 4 * hf, row1 = (i1 & 3) + 8 * (i1 >> 2) + 4 * hf;
                float w0 = ex2(x[i0] - y[i0] - carry), w1 = ex2(x[i1] - y[i1] - carry); if (diag && row0 >= r) w0 = 0.f; if (diag && row1 >= r) w1 = 0.f; pw[i] = cvt_pk_bf16(w0, w1); }
#pragma unroll
            for (int s = 0; s < 2; ++s) { u32x4 pf; pf.x = pw[4 * s]; pf.y = pw[4 * s + 1]; pf.z = pw[4 * s + 2]; pf.w = pw[4 * s + 3];
                const bf16x8 pb = __builtin_bit_cast(bf16x8, pf);
                o0 = mfma32(v0.f[0][s], pb, o0); o1 = mfma32(v0.f[1][s], pb, o1); }
            carry += __shfl(y[0], r);
            if (__all(carry >= SB_THR)) break;
            k0 = k1; v0 = v1;
        }
        stage_o_rows(wl, o0, o1, 1.0f, r, hf);
#pragma unroll
        for (int it = 0; it < 4; ++it) { const int q = it * 8 + (lane >> 3), c = lane & 7; *(u32x4*)(Y + (tokb + t0 + q) * 1024 + head * 64 + c * 8) = read_o_row(wl, q, c); }
        __builtin_amdgcn_fence(__ATOMIC_RELEASE, "wavefront"); __builtin_amdgcn_wave_barrier(); __builtin_amdgcn_fence(__ATOMIC_ACQUIRE, "wavefront");
    }
}

__device__ __forceinline__ void moe_router(const Frame& F, const Args& a, int layer, const float* __restrict__ r) {
    unsigned char* H8 = (unsigned char*)(F.ws + WS_H); int* MLIST = (int*)(F.ws + WS_MLIST); int* TOKEP = (int*)(F.ws + WS_TOKEP); float* TOKG = (float*)(F.ws + WS_TOKG); unsigned* GCNT = F.ctl + CW_GCNT + layer * 64;
    const float* rw = a.in[I_RW] + (size_t)layer * 1024 * 32; const float* rb = a.in[I_RB] + layer * 32; const float* gain = a.in[I_NFFN] + layer * 1024;
    LAS float* hs = (LAS float*)F.lds;
    LAS float* part = (LAS float*)(F.lds + 32768);
    LAS float* logit = (LAS float*)(F.lds + 49152);
    LAS int* lcnt = (LAS int*)(F.lds + 50176);
    LAS int* tinfo = (LAS int*)(F.lds + 50432);
    const int t = F.tid, lane = F.lane, wave = F.wave, e = t & 31, ks = t >> 5;
    const int per = (NTOK + F.G - 1) / F.G, tok0 = F.bid * per, tok1 = min(NTOK, tok0 + per);
    float rwr[64];
#pragma unroll
    for (int i = 0; i < 64; ++i) rwr[i] = rw[(size_t)(ks * 64 + i) * 32 + e];
    f32x4 gv[4];
#pragma unroll
    for (int j = 0; j < 4; ++j) gv[j] = *(const f32x4*)(gain + 4 * (lane + 64 * j));
    __syncthreads();
    if (t < 64) lcnt[t] = 0;
    for (int base = tok0; base < tok1; base += 8) {
        const int tok = base + wave;
        if (tok < tok1) { const float* s = r + (size_t)tok * 1024; f32x4 v[4]; float ss = 0.f;
#pragma unroll
            for (int j = 0; j < 4; ++j) { v[j] = *(const f32x4*)(s + 4 * (lane + 64 * j)); ss += v[j][0] * v[j][0] + v[j][1] * v[j][1] + v[j][2] * v[j][2] + v[j][3] * v[j][3]; }
            ss = wave_sum(ss); const float rstd = rsqrtf(ss * (1.0f / 1024.0f) + RMS_EPS);
#pragma unroll
            for (int j = 0; j < 4; ++j) { const f32x4 y = v[j] * rstd * gv[j]; *(LAS f32x4*)(hs + wave * 1024 + 4 * (lane + 64 * j)) = y;
                *(unsigned*)(H8 + (size_t)tok * 1024 + 4 * (lane + 64 * j)) = cvt_pk4_fp8(y[0], y[1], y[2], y[3]); } }
        __syncthreads();
#pragma unroll
        for (int tk = 0; tk < 8; ++tk) { float acc = 0.f;
#pragma unroll
            for (int i4 = 0; i4 < 16; ++i4) { const f32x4 hv = *(const LAS f32x4*)(hs + tk * 1024 + ks * 64 + 4 * i4); acc += hv[0] * rwr[4 * i4] + hv[1] * rwr[4 * i4 + 1] + hv[2] * rwr[4 * i4 + 2] + hv[3] * rwr[4 * i4 + 3]; }
            part[(tk * 16 + ks) * 32 + e] = acc; }
        __syncthreads();
        if (t < 256) { const int tk = t >> 5; float s = rb[e];
#pragma unroll
            for (int k = 0; k < 16; ++k) s += part[(tk * 16 + k) * 32 + e];
            logit[tk * 32 + e] = s; }
        __syncthreads();
        if (t < 8 && base + t < tok1) { const int tk = t, tokk = base + t; float v0 = -3.0e38f, v1 = -3.0e38f, v2 = -3.0e38f, v3 = -3.0e38f; int i0 = 0, i1 = 0, i2 = 0, i3 = 0;
            for (int j = 0; j < 32; ++j) { const float g = logit[tk * 32 + j];
                if (g > v0) { v3 = v2; i3 = i2; v2 = v1; i2 = i1; v1 = v0; i1 = i0; v0 = g; i0 = j; } else if (g > v1) { v3 = v2; i3 = i2; v2 = v1; i2 = i1; v1 = g; i1 = j; }
                else if (g > v2) { v3 = v2; i3 = i2; v2 = g; i2 = j; } else if (g > v3) { v3 = g; i3 = j; } }
            const float e1 = __expf(v1 - v0), e2 = __expf(v2 - v0), e3 = __expf(v3 - v0), inv = 1.0f / (1.0f + e1 + e2 + e3);
            f32x4 gg; gg[0] = inv; gg[1] = e1 * inv; gg[2] = e2 * inv; gg[3] = e3 * inv; *(f32x4*)(TOKG + (size_t)tokk * 4) = gg;
            const int lt = tokk - tok0;
            tinfo[lt * 4 + 0] = (i0 << 20) | atomicAdd((int*)&lcnt[i0], 1); tinfo[lt * 4 + 1] = (i1 << 20) | atomicAdd((int*)&lcnt[i1], 1);
            tinfo[lt * 4 + 2] = (i2 << 20) | atomicAdd((int*)&lcnt[i2], 1); tinfo[lt * 4 + 3] = (i3 << 20) | atomicAdd((int*)&lcnt[i3], 1); }
    }
    __syncthreads();
    if (t < 32) lcnt[32 + t] = (int)__hip_atomic_fetch_add(GCNT + t, (unsigned)lcnt[t], __ATOMIC_RELAXED, __HIP_MEMORY_SCOPE_AGENT);
    __syncthreads();
    for (int x = t; x < (tok1 - tok0) * 4; x += 512) { const int v = tinfo[x], ee = v >> 20, pos = lcnt[32 + ee] + (v & 0xfffff), tokk = tok0 + (x >> 2);
        MLIST[(size_t)ee * NTOK + pos] = tokk; TOKEP[(size_t)tokk * 4 + (x & 3)] = (ee << 20) | pos; }
    __syncthreads();
}

struct MoeTab { LAS int* cnt; LAS int* tb; LAS int* rte; int NT; };
__device__ __forceinline__ MoeTab moe_tables(const Frame& F, int layer) {
    MoeTab T; T.cnt = (LAS int*)(F.lds + LDS_AUX + 18432); T.tb = T.cnt + 32; T.rte = T.tb + 40;
    unsigned* GCNT = F.ctl + CW_GCNT + layer * 64; const int t = F.tid;
    __syncthreads();
    if (t < 32) T.cnt[t] = (int)__hip_atomic_load(GCNT + t, __ATOMIC_RELAXED, __HIP_MEMORY_SCOPE_AGENT);
    __syncthreads();
    if (t == 0) { int s = 0; for (int e = 0; e < 32; ++e) { T.tb[e] = s; s += (T.cnt[e] + 255) >> 8; } T.tb[32] = s; }
    __syncthreads();
    T.NT = T.tb[32];
    for (int x = t; x < T.NT; x += 512) { int e = 0; for (int k = 1; k < 32; ++k) if (T.tb[k] <= x) e = k; T.rte[x] = e; }
    __syncthreads();
    return T;
}
__device__ __forceinline__ bool moe_unit(int i, int G, int c, int NT, int NPN, int& rt, int& pn) {
    const long L = (long)i * G + c;
    if ((G & 7) == 0) { const int xcd = (int)(L & 7); const long idx = L >> 3; rt = (int)(idx / NPN) * 8 + xcd; pn = (int)(idx % NPN); }
    else { rt = (int)(L / NPN); pn = (int)(L % NPN); }
    return rt < NT;
}
struct MoeUpSched {
    static constexpr bool GATHER = true;
    MoeTab T; const char* H; const char* Wg; const char* Wu; LAS int* rowtab; int G, c;
    __device__ __forceinline__ bool next(int i, GU& u) const {
        int rt, pn; if (!moe_unit(i, G, c, T.NT, 8, rt, pn)) return false;
        const int e = T.rte[rt];
        u.a0 = H; u.a1 = H; u.b0 = Wg + ((size_t)e * 1024 + pn * 128) * 1024; u.b1 = Wu + ((size_t)e * 1024 + pn * 128) * 1024;
        u.p0 = rt * 256; u.p1 = pn * 128; u.p2 = e; u.p3 = 0; return true;
    }
    __device__ __forceinline__ const LAS int* rows(int i) const { return rowtab + i * 256; }
};
struct MoeDownSched {
    static constexpr bool GATHER = false;
    MoeTab T; const char* A; const char* Wd; int G, c;
    __device__ __forceinline__ bool next(int i, GU& u) const {
        int rt, pn; if (!moe_unit(i, G, c, T.NT, 4, rt, pn)) return false;
        const int e = T.rte[rt];
        u.a0 = A + (size_t)rt * 256 * 1024; u.a1 = u.a0 + (size_t)128 * 1024; u.b0 = Wd + ((size_t)e * 1024 + pn * 256) * 1024; u.b1 = u.b0 + (size_t)128 * 1024;
        u.p0 = rt * 256; u.p1 = pn * 256; u.p2 = e; u.p3 = 0; return true;
    }
    __device__ __forceinline__ const LAS int* rows(int) const { return nullptr; }
};
__device__ __forceinline__ void moe_up(const Frame& F, const Args& a, int layer) {
    const MoeTab T = moe_tables(F, layer); const int* MLIST = (const int*)(F.ws + WS_MLIST);
    LAS int* rowtab = (LAS int*)(F.lds + LDS_AUX);
    for (int i = 0; i < 18; ++i) { int rt, pn; if (!moe_unit(i, F.G, F.bid, T.NT, 8, rt, pn)) break;
        const int e = T.rte[rt], tile = rt - T.tb[e], cnt = T.cnt[e];
        if (F.tid < 256) { const int pos = tile * 256 + F.tid; rowtab[i * 256 + F.tid] = pos < cnt ? MLIST[(size_t)e * NTOK + pos] : 0; } }
    __syncthreads();
    const char* W = (const char*)(F.ws + WS_MOEW); const size_t L = (size_t)NEXP * 1024 * 1024;
    MoeUpSched S{T, (const char*)(F.ws + WS_H), W, W + L, rowtab, F.G, F.bid};
    EpiSwiglu E{a.in[I_BG] + (size_t)layer * NEXP * 1024, a.in[I_BU] + (size_t)layer * NEXP * 1024, (unsigned char*)(F.ws + RA_ACT)};
    g8::gemm_run<EpiSwiglu, MoeUpSched, true>(F.lds, 512, 1024u, 1024u, S, E);
}
__device__ __forceinline__ void moe_down(const Frame& F, const Args& a, int layer) {
    const MoeTab T = moe_tables(F, layer);
    const char* W = (const char*)(F.ws + WS_MOEW); const size_t L = (size_t)NEXP * 1024 * 1024;
    MoeDownSched S{T, (const char*)(F.ws + RA_ACT), W + 2 * L, F.G, F.bid};
    EpiDown E{a.in[I_BD] + (size_t)layer * NEXP * 1024, (bf16_t*)(F.ws + RB_YS)};
    g8::gemm_run<EpiDown, MoeDownSched, true>(F.lds, 512, 1024u, 1024u, S, E);
}
__device__ __forceinline__ void moe_combine(const Frame& F, const Args& a, int layer, float* __restrict__ r) {
    const MoeTab T = moe_tables(F, layer);
    const bf16_t* YS = (const bf16_t*)(F.ws + RB_YS); const int* TOKEP = (const int*)(F.ws + WS_TOKEP); const float* TOKG = (const float*)(F.ws + WS_TOKG); unsigned char* H = (unsigned char*)(F.ws + WS_H);
    const float* gain = a.in[I_NPLE] + layer * 1024; const int lane = F.lane;
    f32x4 gv[2][2];
#pragma unroll
    for (int c = 0; c < 2; ++c) { gv[c][0] = *(const f32x4*)(gain + c * 512 + lane * 8); gv[c][1] = *(const f32x4*)(gain + c * 512 + lane * 8 + 4); }
    for (int tok = F.gw; tok < NTOK; tok += F.GW) {
        int slot[4]; float gt[4];
#pragma unroll
        for (int k = 0; k < 4; ++k) { const int v = TOKEP[(size_t)tok * 4 + k]; slot[k] = T.tb[v >> 20] * 256 + (v & 0xfffff); gt[k] = TOKG[(size_t)tok * 4 + k]; }
        f32x4 v[2][2]; float ss = 0.f;
#pragma unroll
        for (int c = 0; c < 2; ++c) { const size_t o = (size_t)tok * 1024 + c * 512 + lane * 8; v[c][0] = *(const f32x4*)(r + o); v[c][1] = *(const f32x4*)(r + o + 4);
#pragma unroll
            for (int k = 0; k < 4; ++k) { const u32x4 y = *(const u32x4*)(YS + (size_t)slot[k] * 1024 + c * 512 + lane * 8);
                v[c][0][0] += gt[k] * bf_lo(y.x); v[c][0][1] += gt[k] * bf_hi(y.x); v[c][0][2] += gt[k] * bf_lo(y.y); v[c][0][3] += gt[k] * bf_hi(y.y);
                v[c][1][0] += gt[k] * bf_lo(y.z); v[c][1][1] += gt[k] * bf_hi(y.z); v[c][1][2] += gt[k] * bf_lo(y.w); v[c][1][3] += gt[k] * bf_hi(y.w); }
            *(f32x4*)(r + o) = v[c][0]; *(f32x4*)(r + o + 4) = v[c][1];
#pragma unroll
            for (int q = 0; q < 2; ++q) ss += v[c][q][0] * v[c][q][0] + v[c][q][1] * v[c][q][1] + v[c][q][2] * v[c][q][2] + v[c][q][3] * v[c][q][3]; }
        ss = wave_sum(ss); const float rstd = rsqrtf(ss * (1.0f / 1024.0f) + RMS_EPS);
#pragma unroll
        for (int c = 0; c < 2; ++c) { const f32x4 y0 = v[c][0] * rstd * gv[c][0], y1 = v[c][1] * rstd * gv[c][1];
            u32x2 w; w.x = cvt_pk4_fp8(y0[0], y0[1], y0[2], y0[3]); w.y = cvt_pk4_fp8(y1[0], y1[1], y1[2], y1[3]);
            *(u32x2*)(H + (size_t)tok * 1024 + c * 512 + lane * 8) = w; }
    }
}

constexpr int N_PHASES = 22;
#ifndef DBG_DUP_MASK
#define DBG_DUP_MASK 0
#endif
#ifndef DBG_NPH
#define DBG_NPH 22
#endif
#ifndef MK_ONE_LAUNCH
#define MK_ONE_LAUNCH 1
#endif

__device__ __forceinline__ void moe_ple_phases(const Frame& F, const Args& a, int layer, int ph, float* out) {
    if (ph == 0) moe_router(F, a, layer, out);
    else if (ph == 1) moe_up(F, a, layer);
    else if (ph == 2) moe_down(F, a, layer);
    else if (ph == 3) {
        g8::DenseSched S{(const char*)(F.ws + WS_PB) + (size_t)layer * NTOK * PLE * 2, (const char*)(F.ws + WS_WPLE) + (size_t)layer * 1024 * PLE * 2, 512u, 512u, 128, 4, F.G, F.bid};
        EpiStoreBf16 E{(bf16_t*)(F.ws + RA_PROJ), 1024, 1.0f};
        g8::gemm_run<EpiStoreBf16, g8::DenseSched>(F.lds, 256, 512u, 512u, S, E);
        moe_combine(F, a, layer, out);
    } else {
        g8::DenseSched S{(const char*)(F.ws + WS_H), (const char*)(F.ws + WS_WPLEG) + (size_t)layer * 1024 * 1024, 1024u, 1024u, 128, 4, F.G, F.bid};
        EpiPle E{(const bf16_t*)(F.ws + RA_PROJ), out};
        g8::gemm_run<EpiPle, g8::DenseSched, true>(F.lds, 512, 1024u, 1024u, S, E);
    }
}

__global__ void __launch_bounds__(512, 2) fwd(Args a) {
    extern __shared__ __attribute__((aligned(16))) unsigned char lds_raw[];
    Frame F;
    F.lds = (LAS unsigned char*)lds_raw; F.tid = threadIdx.x; F.lane = F.tid & 63; F.wave = __builtin_amdgcn_readfirstlane(F.tid >> 6);
    F.G = gridDim.x; F.bid = blockIdx.x; F.gw = F.bid * 8 + F.wave; F.GW = F.G * 8; F.ws = a.ws; F.ctl = (unsigned*)(a.ws + WS_CTL);
    volatile LAS unsigned* misc = (volatile LAS unsigned*)(F.lds + LDS_MISC);
    if (F.tid < 16) misc[F.tid] = 0u;
    __syncthreads();
    XcdBarrier bar; bar.bar = F.ctl + CW_BAR; bar.x = 0; bar.st = misc;
    const int lo = a.ph_lo, hi = a.ph_hi;
    if (hi - lo > 1) bar = xcd_barrier_post(F.ctl + CW_BAR, misc);
#define IN(k) (lo <= (k) && (k) < hi)
#define SEAM(k) do { if (IN(k) && IN((k) + 1)) xcd_barrier(bar); } while (0)
    float* out = a.out;

    if (IN(0)) { p0_prologue(F, a); } SEAM(0);
    if (IN(1)) {
        { g8::DenseSched S{(const char*)(F.ws + WS_H), (const char*)(F.ws + WS_WINAB), 2048u, 2048u, 128, 6, F.G, F.bid};
          EpiInAB E{(bf16_t*)(F.ws + RA_A2), (bf16_t*)(F.ws + RA_Q0), (bf16_t*)(F.ws + RA_K0)};
          g8::gemm_run<EpiInAB, g8::DenseSched>(F.lds, 1024, 2048u, 2048u, S, E); }
        { g8::DenseSched S{(const char*)(F.ws + WS_WINAB) + (size_t)1536 * 2048, (const char*)(F.ws + WS_H), 2048u, 2048u, 2, 128, F.G, F.bid};
          EpiVt E{(bf16_t*)(F.ws + RA_VT0), 8};
          g8::gemm_run<EpiVt, g8::DenseSched>(F.lds, 1024, 2048u, 2048u, S, E); }
    } SEAM(1);
    if (IN(2)) {
        { g8::BatchSched S{(const char*)(F.ws + RA_A2), (const char*)(F.ws + WS_WBT), 1280u, 1024u, (size_t)1024 * 1280, (size_t)256 * 1024, 4, 1, NGRP, F.G, F.bid};
          EpiS E{(float*)(F.ws + RA_SS)};
          g8::gemm_run<EpiS, g8::BatchSched>(F.lds, 512, 1280u, 1024u, S, E); }
        moba_kmean(F);
    } SEAM(2);
    if (IN(3)) { s5_scan(F, a); moba_gate(F); } SEAM(3);
    if (IN(4)) {
        { g8::BatchSched S{(const char*)(F.ws + RA_A2), (const char*)(F.ws + WS_MY), 1280u, 1280u, (size_t)1024 * 1280, (size_t)512 * 1280, 4, 2, NGRP, F.G, F.bid};
          EpiY E{(bf16_t*)(F.ws + RA_Z)};
          g8::gemm_run<EpiY, g8::BatchSched>(F.lds, 640, 1280u, 1280u, S, E); }
        moba_attn(F, a);
    } SEAM(4);
    if (IN(5)) {
        { g8::DenseSched S{(const char*)(F.ws + RA_Z), (const char*)(F.ws + WS_GLU), 1024u, 1024u, 128, 2, F.G, F.bid};
          EpiGlu E{(const bf16_t*)(F.ws + RA_Z), a.in[I_GLUB], (bf16_t*)(F.ws + RB_YCAT)};
          g8::gemm_run<EpiGlu, g8::DenseSched>(F.lds, 512, 1024u, 1024u, S, E); }
        moba_combine(F);
    } SEAM(5);
    if (IN(6)) {
        g8::DenseSched S{(const char*)(F.ws + RB_YCAT), (const char*)(F.ws + WS_WOUTAB), 2048u, 2048u, 128, 4, F.G, F.bid};
        EpiRes E{a.in[I_X], out};
        g8::gemm_run<EpiRes, g8::DenseSched>(F.lds, 1024, 2048u, 2048u, S, E);
    } SEAM(6);
    if (IN(7)) moe_ple_phases(F, a, 0, 0, out); SEAM(7);
    if (IN(8)) moe_ple_phases(F, a, 0, 1, out); SEAM(8);
    if (IN(9)) moe_ple_phases(F, a, 0, 2, out); SEAM(9);
    if (IN(10)) moe_ple_phases(F, a, 0, 3, out); SEAM(10);
    if (IN(11)) moe_ple_phases(F, a, 0, 4, out); SEAM(11);
    if (IN(12)) { rmsnorm_rows<false>(F, out, a.in[I_NMIX] + 1024, (bf16_t*)(F.ws + WS_H), nullptr, NTOK); conv_moe_weights(F, a, 1); } SEAM(12);
    if (IN(13)) {
        { g8::DenseSched S{(const char*)(F.ws + WS_H), (const char*)(F.ws + WS_WINC), 2048u, 2048u, 128, 8, F.G, F.bid};
          EpiInC E{(bf16_t*)(F.ws + RA_Q1), (bf16_t*)(F.ws + RA_K1)};
          g8::gemm_run<EpiInC, g8::DenseSched>(F.lds, 1024, 2048u, 2048u, S, E); }
        { g8::DenseSched S{(const char*)(F.ws + WS_WINC) + (size_t)2048 * 2048, (const char*)(F.ws + WS_H), 2048u, 2048u, 4, 128, F.G, F.bid};
          EpiVt E{(bf16_t*)(F.ws + RA_VT1), 16};
          g8::gemm_run<EpiVt, g8::DenseSched>(F.lds, 1024, 2048u, 2048u, S, E); }
    } SEAM(13);
    if (IN(14)) sb_attn(F); SEAM(14);
    if (IN(15)) {
        g8::DenseSched S{(const char*)(F.ws + RB_Y1), (const char*)(F.ws + WS_WOUTC), 2048u, 2048u, 128, 4, F.G, F.bid};
        EpiRes E{out, out};
        g8::gemm_run<EpiRes, g8::DenseSched>(F.lds, 1024, 2048u, 2048u, S, E);
    } SEAM(15);
    if (IN(16)) moe_ple_phases(F, a, 1, 0, out); SEAM(16);
    if (IN(17)) moe_ple_phases(F, a, 1, 1, out); SEAM(17);
    if (IN(18)) moe_ple_phases(F, a, 1, 2, out); SEAM(18);
    if (IN(19)) moe_ple_phases(F, a, 1, 3, out); SEAM(19);
    if (IN(20)) moe_ple_phases(F, a, 1, 4, out); SEAM(20);
    if (IN(21)) rmsnorm_rows<true>(F, out, a.in[I_NFINAL], nullptr, out, NTOK);
#undef IN
#undef SEAM
}

extern "C" void kernel_launch(void* const* d_in, const int* in_sizes, int n_in, void* d_out, int out_size, void* d_ws, size_t ws_size, hipStream_t stream) {
    static int grid = 0;
    if (grid == 0) {
        if (n_in != 31 || out_size != NTOK * DM || ws_size < WS_END) { fprintf(stderr, "kernel_launch: unexpected shapes (n_in %d, out %d, ws %zu < %zu)\n", n_in, out_size, ws_size, (size_t)WS_END); grid = -1; return; }
        int dev = 0, cus = 0, per_cu = 0;
        if (hipGetDevice(&dev) != hipSuccess || hipDeviceGetAttribute(&cus, hipDeviceAttributeMultiprocessorCount, dev) != hipSuccess) { grid = -1; return; }
        if (hipFuncSetAttribute((const void*)fwd, hipFuncAttributeMaxDynamicSharedMemorySize, LDS_BYTES) != hipSuccess) { fprintf(stderr, "kernel_launch: hipFuncSetAttribute failed\n"); grid = -1; return; }
        if (hipOccupancyMaxActiveBlocksPerMultiprocessor(&per_cu, (const void*)fwd, 512, LDS_BYTES) != hipSuccess || per_cu < 1) fprintf(stderr, "kernel_launch: occupancy query says %d\n", per_cu);
        (void)hipGetLastError();
        grid = cus;
        if (grid != 256) fprintf(stderr, "kernel_launch: %d CUs (built for 256)\n", grid);
    }
    if (grid < 0) return;
    (void)hipMemsetAsync((char*)d_ws + WS_CTL, 0, 1 * MiB, stream);
    Args a{};
    for (int i = 0; i < 31; ++i) a.in[i] = (const float*)d_in[i];
    a.out = (float*)d_out; a.ws = (unsigned char*)d_ws;
    for (int n = 0; n < 128; ++n) { int bk; if (n < 16) bk = n; else { bk = 16 + (int)(std::log((double)n / 16.0) / std::log(8.0) * 16.0); if (bk > 31) bk = 31; } a.btab[n] = (unsigned char)bk; }
#if MK_ONE_LAUNCH
    a.ph_lo = 0; a.ph_hi = N_PHASES;
    hipLaunchKernelGGL(fwd, dim3(grid), dim3(512), LDS_BYTES, stream, a);
#else
    for (int p = 0; p < DBG_NPH; ++p) { a.ph_lo = p; a.ph_hi = p + 1; const int reps = ((DBG_DUP_MASK >> p) & 1) ? 2 : 1; for (int q = 0; q < reps; ++q) hipLaunchKernelGGL(fwd, dim3(grid), dim3(512), LDS_BYTES, stream, a); }
#endif
}
```

```cpp
#include <hip/hip_runtime.h>
#include <cstdio>
#include <cstdint>
#include <cmath>

#define LAS __attribute__((address_space(3)))
typedef unsigned short bf16_t;
typedef short bf16x8 __attribute__((ext_vector_type(8)));
typedef short bf16x4 __attribute__((ext_vector_type(4)));
typedef float f32x4 __attribute__((ext_vector_type(4)));
typedef float f32x2 __attribute__((ext_vector_type(2)));
typedef float f32x16 __attribute__((ext_vector_type(16)));
typedef unsigned u32x4 __attribute__((ext_vector_type(4)));
typedef unsigned u32x2 __attribute__((ext_vector_type(2)));
typedef int i32x4 __attribute__((ext_vector_type(4)));
typedef int i32x8 __attribute__((ext_vector_type(8)));

constexpr int NTOK = 32768, DM = 1024, SEQ = 4096, NBATCH = 8, PLE = 256;
constexpr int SSMW = 512, NGRP = 32, GH = 16, NST = 64, TCH = 32, NCH = SEQ / TCH  , A2LD = 640;
constexpr int MOBW = 512, MH = 8, MBLK = 256, NMB = 16;
constexpr int NEXP = 32;
constexpr float RMS_EPS = 1e-6f;
constexpr float LOG2E = 1.4426950408889634f;
constexpr float QSCALE = 0.125f * LOG2E;
constexpr float W8_SCALE = 32.0f;
constexpr float SB_THR = 150.0f;

constexpr size_t MiB = (size_t)1 << 20;
constexpr size_t WS_CTL = 0;
constexpr size_t WS_WINAB = 1 * MiB;
constexpr size_t WS_GLU = WS_WINAB + 4 * MiB;
constexpr size_t WS_WOUTAB = WS_GLU + MiB / 2;
constexpr size_t WS_WINC = WS_WOUTAB + 2 * MiB;
constexpr size_t WS_WOUTC = WS_WINC + 6 * MiB;
constexpr size_t WS_WPLE = WS_WOUTC + 2 * MiB;
constexpr size_t WS_WPLEG = WS_WPLE + 1 * MiB;
constexpr size_t WS_WBT = WS_WPLEG + 4 * MiB;
constexpr size_t WS_MY = WS_WBT + 8 * MiB;
constexpr size_t WS_MOEW = WS_MY + 20 * MiB;
constexpr size_t WS_R16 = WS_MOEW + 96 * MiB;
constexpr size_t WS_H = WS_MOEW + 192 * MiB;
constexpr size_t WS_PB = WS_H + 64 * MiB;
constexpr size_t WS_MLIST = WS_PB + 32 * MiB;
constexpr size_t WS_TOKEP = WS_MLIST + 4 * MiB;
constexpr size_t WS_TOKG = WS_TOKEP + MiB / 2;
constexpr size_t WS_RA = WS_TOKG + MiB / 2;
constexpr size_t WS_RB = WS_RA + 272 * MiB;
constexpr size_t WS_END = WS_RB + 272 * MiB;
constexpr size_t RA_A2 = WS_RA;
constexpr size_t RA_Q0 = RA_A2 + 40 * MiB;
constexpr size_t RA_K0 = RA_Q0 + 32 * MiB;
constexpr size_t RA_VT0 = RA_K0 + 32 * MiB;
constexpr size_t RA_Z = RA_VT0 + 32 * MiB;
constexpr size_t RA_SS = RA_Z + 32 * MiB;
constexpr size_t RA_Q1 = WS_RA;
constexpr size_t RA_K1 = RA_Q1 + 64 * MiB;
constexpr size_t RA_VT1 = RA_K1 + 64 * MiB;
constexpr size_t RA_ACT = WS_RA;
constexpr size_t RA_PROJ = WS_RA;
constexpr size_t RB_PARTO = WS_RB;
constexpr size_t RB_PARTML = RB_PARTO + 128 * MiB;
constexpr size_t RB_MOBALIST = RB_PARTML + 8 * MiB;
constexpr size_t RB_KMEAN = RB_MOBALIST + 16 * MiB;
constexpr size_t RB_YCAT = RB_KMEAN + 1 * MiB;
constexpr size_t RB_Y1 = WS_RB;
constexpr size_t RB_YS = WS_RB;
constexpr int CW_BAR = 0;
constexpr int CW_GCNT = 4096;
constexpr int CW_MOBACNT = 8192;

constexpr int LDS_BYTES = 155648;
constexpr int LDS_AUX = 131072;
constexpr int LDS_MISC = 155648 - 64;

typedef __bf16 bf16x2_t __attribute__((ext_vector_type(2)));
__device__ __forceinline__ unsigned cvt_pk_bf16(float lo, float hi) { const f32x2 v = {lo, hi}; return __builtin_bit_cast(unsigned, __builtin_convertvector(v, bf16x2_t)); }
__device__ __forceinline__ bf16_t f2bf(float x) { return (bf16_t)(cvt_pk_bf16(x, 0.f) & 0xffffu); }
__device__ __forceinline__ unsigned cvt_pk4_fp8(float x0, float x1, float x2, float x3) { int w = __builtin_amdgcn_cvt_pk_fp8_f32(x0, x1, 0, false); w = __builtin_amdgcn_cvt_pk_fp8_f32(x2, x3, w, true); return (unsigned)w; }
__device__ __forceinline__ float bf_lo(unsigned w) { return __uint_as_float(w << 16); }
__device__ __forceinline__ float bf_hi(unsigned w) { return __uint_as_float(w & 0xffff0000u); }
__device__ __forceinline__ float ex2(float x) { return __builtin_amdgcn_exp2f(x); }
__device__ __forceinline__ float lg2(float x) { return __builtin_amdgcn_logf(x); }
__device__ __forceinline__ float rcp(float x) { return __builtin_amdgcn_rcpf(x); }
__device__ __forceinline__ float sigmoidf_(float x) { return rcp(1.0f + ex2(-LOG2E * x)); }
__device__ __forceinline__ float wave_sum(float v) { v += __shfl_xor(v, 32); v += __shfl_xor(v, 16); v += __shfl_xor(v, 8); v += __shfl_xor(v, 4); v += __shfl_xor(v, 2); v += __shfl_xor(v, 1); return v; }
__device__ __forceinline__ f32x16 mfma32(bf16x8 a, bf16x8 b, f32x16 c) { return __builtin_amdgcn_mfma_f32_32x32x16_bf16(a, b, c, 0, 0, 0); }

#define XB_TMO      128
#define XB_XCNT(j)  (256  + 64 * (j))
#define XB_XSUB(j)  (1280 + 64 * (j))
#define XB_XGEN(j)  (2304 + 64 * (j))
#define XB_TOP      3328
#define XB_TOPGEN   3392
#define XCD_BAR_WORDS 3456
#define XB_SPIN_CAP (1u << 18)
__device__ __forceinline__ unsigned xb_ld(unsigned* p)              { return __hip_atomic_load(p, __ATOMIC_RELAXED, __HIP_MEMORY_SCOPE_AGENT); }
__device__ __forceinline__ unsigned xb_add(unsigned* p, unsigned v) { return __hip_atomic_fetch_add(p, v, __ATOMIC_RELAXED, __HIP_MEMORY_SCOPE_AGENT); }
__device__ __forceinline__ unsigned xb_xcc_id() { return (unsigned)__builtin_amdgcn_s_getreg((3 << 11) | 20) & 0xFu; }
#define XB_SPIN(cond, bar) do { unsigned _sp = 0; while (cond) { __builtin_amdgcn_s_sleep(1); \
    if ((++_sp & 255u) == 0u) { if (xb_ld(&(bar)[XB_TMO])) break; if (_sp > XB_SPIN_CAP) { atomicAdd(&(bar)[XB_TMO], 1u); break; } } } } while (0)
struct XcdBarrier { unsigned* bar; unsigned x; volatile LAS unsigned* st; };
__device__ __forceinline__ XcdBarrier xcd_barrier_post(unsigned* bar, volatile LAS unsigned* st) {
    XcdBarrier b; b.bar = bar; b.x = xb_xcc_id(); b.st = st;
    if (threadIdx.x == 0) (void)xb_add(&bar[XB_XCNT(b.x)], 1u);
    return b;
}
__device__ __forceinline__ void xcd_barrier_complete(unsigned* bar, unsigned x, unsigned& nloc, unsigned& nx) {
    const unsigned G = gridDim.x * gridDim.y * gridDim.z;
    unsigned sum, cnt, mine, sp = 0u;
    for (;;) {
        sum = 0u; cnt = 0u; mine = 0u;
#pragma unroll
        for (unsigned j = 0; j < 16; ++j) { const unsigned c = xb_ld(&bar[XB_XCNT(j)]); sum += c; cnt += (c > 0u) ? 1u : 0u; mine = (j == x) ? c : mine; }
        if (sum == G) break;
        __builtin_amdgcn_s_sleep(1);
        if ((++sp & 255u) == 0u) { if (xb_ld(&bar[XB_TMO])) break; if (sp > XB_SPIN_CAP) { atomicAdd(&bar[XB_TMO], 1u); break; } }
    }
    nloc = mine > 0u ? mine : 1u; nx = cnt > 0u ? cnt : 1u;
}
__device__ __forceinline__ void xcd_barrier(const XcdBarrier& b) {
    asm volatile("s_waitcnt vmcnt(0)" ::: "memory");
    __syncthreads();
    if (threadIdx.x == 0) {
        unsigned* bar = b.bar;
        __builtin_amdgcn_s_waitcnt(0);
        unsigned nloc = b.st[0], nx = b.st[1];
        if (nloc == 0u) { xcd_barrier_complete(bar, b.x, nloc, nx); b.st[0] = nloc; b.st[1] = nx; }
        const unsigned old = xb_add(&bar[XB_XSUB(b.x)], 1u);
        const unsigned gen = old / nloc;
        if (old + 1u == (gen + 1u) * nloc) {
            __builtin_amdgcn_fence(__ATOMIC_RELEASE, "agent");
            asm volatile("s_waitcnt vmcnt(0)" ::: "memory");
            const unsigned og = xb_add(&bar[XB_TOP], 1u);
            const unsigned tg = og / nx;
            if (og + 1u == (tg + 1u) * nx) xb_add(&bar[XB_TOPGEN], 1u);
            else XB_SPIN(xb_ld(&bar[XB_TOPGEN]) == tg, bar);
            __builtin_amdgcn_fence(__ATOMIC_ACQUIRE, "agent");
            xb_add(&bar[XB_XGEN(b.x)], 1u);
            asm volatile("s_waitcnt vmcnt(0)" ::: "memory");
        } else {
            XB_SPIN(xb_ld(&bar[XB_XGEN(b.x)]) == gen, bar);
            __builtin_amdgcn_fence(__ATOMIC_ACQUIRE, "agent");
            asm volatile("s_waitcnt vmcnt(0)" ::: "memory");
        }
    }
    __syncthreads();
}

namespace g8 {
constexpr int BM = 256, BK = 64, HALF = 128, HTB = HALF * BK * 2, STAGE_BYTES = 8 * HTB, NXCD = 8, WGM = 8;
__host__ __device__ __forceinline__ int lds_byte(int r, int c) { const int st = (r >> 4) * 2 + (c >> 5), rr = r & 15, cc = c & 31, ob = rr * 64 + cc * 2; return st * 1024 + (ob ^ (((ob >> 9) & 1) << 5)); }
__host__ __device__ __forceinline__ void stage_rc(int b, int& R, int& C) { const int st = b / 1024, sb = b % 1024, swz = sb ^ (((sb >> 9) & 1) << 5); R = (st >> 1) * 16 + swz / 64; C = (st & 1) * 32 + (swz % 64) / 2; }
__host__ __device__ __forceinline__ int perm32(int rho) { const int n = rho >> 4, i = rho & 15; return 8 * (i >> 2) + 4 * n + (i & 3); }

struct GU { const char *a0, *a1, *b0, *b1; int p0, p1, p2, p3; };

__device__ __forceinline__ bool static_tile(int i, int G, int c, int nM, int nN, int& pm, int& pn) {
    const int nwg = nM * nN; const long L = (long)i * G + c; if (L >= nwg) return false;
    int wgid = (int)L; { const int q = nwg / NXCD, r = nwg % NXCD, xcd = wgid % NXCD, off = wgid / NXCD; wgid = (xcd < r ? xcd * (q + 1) : r * (q + 1) + (xcd - r) * q) + off; }
    const int nig = WGM * nN, gid = wgid / nig, fm = gid * WGM, gsz = (nM - fm) < WGM ? (nM - fm) : WGM;
    pm = fm + ((wgid % nig) % gsz); pn = (wgid % nig) / gsz; return true;
}
struct DenseSched {
    const char* A; const char* B; unsigned lda2, ldb2; int nM, nN, G, c;
    static constexpr bool GATHER = false;
    __device__ __forceinline__ bool next(int i, GU& u) const {
        int pm, pn; if (!static_tile(i, G, c, nM, nN, pm, pn)) return false;
        u.a0 = A + (size_t)pm * 256 * lda2; u.a1 = u.a0 + (size_t)128 * lda2; u.b0 = B + (size_t)pn * 256 * ldb2; u.b1 = u.b0 + (size_t)128 * ldb2;
        u.p0 = pm; u.p1 = pn; u.p2 = 0; u.p3 = 0; return true;
    }
    __device__ __forceinline__ const LAS int* rows(int) const { return nullptr; }
};
struct BatchSched {
    const char* A; const char* B; unsigned lda2, ldb2; size_t sA, sB; int nM, nN, nb, G, c;
    static constexpr bool GATHER = false;
    __device__ __forceinline__ bool next(int i, GU& u) const {
        const long L = (long)i * G + c; const int per = nM * nN; if (L >= (long)per * nb) return false;
        const int g = (int)(L / per), rem = (int)(L % per), pm = rem / nN, pn = rem % nN;
        u.a0 = A + (size_t)g * sA + (size_t)pm * 256 * lda2; u.a1 = u.a0 + (size_t)128 * lda2; u.b0 = B + (size_t)g * sB + (size_t)pn * 256 * ldb2; u.b1 = u.b0 + (size_t)128 * ldb2;
        u.p0 = pm; u.p1 = pn; u.p2 = g; u.p3 = 0; return true;
    }
    __device__ __forceinline__ const LAS int* rows(int) const { return nullptr; }
};

#define G8_WAIT_V(n) asm volatile("s_waitcnt vmcnt(" #n ")" ::: "memory")
#define G8_WAIT_L(n) asm volatile("s_waitcnt lgkmcnt(" #n ")" ::: "memory")
#define G8_BAR __builtin_amdgcn_s_barrier()
#define G8_SCHED __builtin_amdgcn_sched_barrier(0)

template <class Epi, class Sched, bool F8 = false>
__device__ __forceinline__ void gemm_run(LAS unsigned char* lds, const int K, const unsigned lda2, const unsigned ldb2, const Sched& S, const Epi& E) {
    constexpr bool GATHER = Sched::GATHER;
    const int tid = threadIdx.x, wid = __builtin_amdgcn_readfirstlane(tid >> 6), lane = tid & 63, wr = wid >> 2, wc = wid & 3, fr = lane & 15, fq = lane >> 4;
    const int nt = K / BK;
    int sR[2], sC[2];
    unsigned voffB[2], vc[2][2], vn[2][2];
#pragma unroll
    for (int i = 0; i < 2; ++i) { stage_rc(tid * 16 + i * 8192, sR[i], sC[i]); const int Rb = Epi::PERM ? ((sR[i] & ~31) + perm32(sR[i] & 31)) : sR[i];
        voffB[i] = (unsigned)Rb * ldb2 + (unsigned)sC[i] * 2u; vc[0][i] = vc[1][i] = vn[0][i] = vn[1][i] = (unsigned)sR[i] * lda2 + (unsigned)sC[i] * 2u; }
    const size_t kstep = (size_t)(BK * 2);
    const unsigned ldsw = (unsigned)wid * 1024u;
    const int aoff = lds_byte(wr * 64 + fr, fq * 8), boff = lds_byte(wc * 32 + fr, fq * 8);
#define G8_SA(b, h) (((b) * 2 + (h)) * HTB)
#define G8_SB(b, h) ((4 + (b) * 2 + (h)) * HTB)
#define G8_STAGE(bufoff, gbase, v0, v1) do { \
        __builtin_amdgcn_global_load_lds((const unsigned*)((const char*)(gbase) + (v0)), (LAS unsigned*)(lds + (bufoff) + ldsw), 16, 0, 0); \
        __builtin_amdgcn_global_load_lds((const unsigned*)((const char*)(gbase) + (v1)), (LAS unsigned*)(lds + (bufoff) + ldsw + 8192), 16, 0, 0); } while (0)
#define G8_LDA(dst, b, h) do { _Pragma("unroll") for (int m = 0; m < 4; ++m) _Pragma("unroll") for (int k = 0; k < 2; ++k) dst[m][k] = *(const LAS bf16x8*)(lds + G8_SA(b, h) + aoff + m * 2048 + k * 1024); } while (0)
#define G8_LDB(dst, b, h) do { _Pragma("unroll") for (int n = 0; n < 2; ++n) _Pragma("unroll") for (int k = 0; k < 2; ++k) dst[n][k] = *(const LAS bf16x8*)(lds + G8_SB(b, h) + boff + n * 2048 + k * 1024); } while (0)
#define G8_CAT(a, b) __builtin_shufflevector(__builtin_bit_cast(i32x4, a), __builtin_bit_cast(i32x4, b), 0, 1, 2, 3, 4, 5, 6, 7)
#define G8_MMA(ai, bj, At, Bt) do { __builtin_amdgcn_s_setprio(1); \
        if constexpr (F8) { _Pragma("unroll") for (int m = 0; m < 4; ++m) _Pragma("unroll") for (int n = 0; n < 2; ++n) { const i32x8 b8_ = G8_CAT(Bt[n][0], Bt[n][1]), a8_ = G8_CAT(At[m][0], At[m][1]); \
            asm volatile("v_mfma_f32_16x16x128_f8f6f4 %0, %1, %2, %0" : "+v"(acc[ai][bj][m][n]) : "v"(b8_), "v"(a8_)); } } \
        else { _Pragma("unroll") for (int m = 0; m < 4; ++m) _Pragma("unroll") for (int n = 0; n < 2; ++n) _Pragma("unroll") for (int k = 0; k < 2; ++k) \
            acc[ai][bj][m][n] = __builtin_amdgcn_mfma_f32_16x16x32_bf16(Bt[n][k], At[m][k], acc[ai][bj][m][n], 0, 0, 0); } \
        __builtin_amdgcn_s_setprio(0); } while (0)
    GU cur, nxt; int ui = 0;
    if (!S.next(0, cur)) return;
    if constexpr (GATHER) { const LAS int* rw = S.rows(0);
#pragma unroll
        for (int h = 0; h < 2; ++h)
#pragma unroll
            for (int i = 0; i < 2; ++i) vc[h][i] = (unsigned)rw[h * 128 + sR[i]] * lda2 + (unsigned)sC[i] * 2u; }
    f32x4 acc[2][2][4][2];
#pragma unroll
    for (int a = 0; a < 2; ++a)
#pragma unroll
        for (int b = 0; b < 2; ++b)
#pragma unroll
            for (int m = 0; m < 4; ++m)
#pragma unroll
                for (int n = 0; n < 2; ++n) acc[a][b][m][n] = (f32x4){0.f, 0.f, 0.f, 0.f};
    bf16x8 At[4][2], B0[2][2], B1[2][2];
    const char* cA0 = cur.a0; const char* cA1 = cur.a1; const char* cB0 = cur.b0; const char* cB1 = cur.b1;
    G8_STAGE(G8_SB(0, 0), cB0, voffB[0], voffB[1]); G8_STAGE(G8_SA(0, 0), cA0, vc[0][0], vc[0][1]); G8_STAGE(G8_SB(0, 1), cB1, voffB[0], voffB[1]); G8_STAGE(G8_SA(0, 1), cA1, vc[1][0], vc[1][1]);
    if (wr == 1) G8_BAR;
    G8_WAIT_V(4); G8_BAR;
    G8_STAGE(G8_SB(1, 0), cB0 + kstep, voffB[0], voffB[1]); G8_STAGE(G8_SA(1, 0), cA0 + kstep, vc[0][0], vc[0][1]); G8_STAGE(G8_SB(1, 1), cB1 + kstep, voffB[0], voffB[1]);
    G8_WAIT_V(6); G8_BAR;
    for (;;) {
        const bool has_next = S.next(ui + 1, nxt);
        const char* nA0 = has_next ? nxt.a0 : cA0; const char* nA1 = has_next ? nxt.a1 : cA1; const char* nB0 = has_next ? nxt.b0 : cB0; const char* nB1 = has_next ? nxt.b1 : cB1;
        if constexpr (GATHER) {
            if (has_next) { const LAS int* rw = S.rows(ui + 1);
#pragma unroll
                for (int h = 0; h < 2; ++h)
#pragma unroll
                    for (int i = 0; i < 2; ++i) vn[h][i] = (unsigned)rw[h * 128 + sR[i]] * lda2 + (unsigned)sC[i] * 2u; }
            else {
#pragma unroll
                for (int h = 0; h < 2; ++h)
#pragma unroll
                    for (int i = 0; i < 2; ++i) vn[h][i] = vc[h][i]; }
        }
#pragma nounroll
        for (int t = 0; t < nt; t += 2) {
            const bool last = (t == nt - 2);
            const char* a1_1 = cA1 + (size_t)(t + 1) * kstep;
            const char* a2_0 = last ? nA0 : cA0 + (size_t)(t + 2) * kstep; const char* a2_1 = last ? nA1 : cA1 + (size_t)(t + 2) * kstep;
            const char* b2_0 = last ? nB0 : cB0 + (size_t)(t + 2) * kstep; const char* b2_1 = last ? nB1 : cB1 + (size_t)(t + 2) * kstep;
            unsigned w00 = vc[0][0], w01 = vc[0][1], w10 = vc[1][0], w11 = vc[1][1];
            if constexpr (GATHER) { if (last) { w00 = vn[0][0]; w01 = vn[0][1]; w10 = vn[1][0]; w11 = vn[1][1]; } }
            G8_LDB(B0, 0, 0); G8_SCHED; G8_LDA(At, 0, 0); G8_STAGE(G8_SA(1, 1), a1_1, vc[1][0], vc[1][1]);
            G8_WAIT_L(8); G8_BAR; G8_WAIT_L(0); G8_MMA(0, 0, At, B0); G8_BAR; G8_SCHED;
            G8_LDB(B1, 0, 1); G8_STAGE(G8_SB(0, 0), b2_0, voffB[0], voffB[1]);
            G8_BAR; G8_WAIT_L(0); G8_MMA(0, 1, At, B1); G8_BAR;
            G8_LDA(At, 0, 1); G8_STAGE(G8_SA(0, 0), a2_0, w00, w01);
            G8_BAR; G8_WAIT_L(0); G8_MMA(1, 0, At, B0); G8_BAR; G8_SCHED;
            G8_STAGE(G8_SB(0, 1), b2_1, voffB[0], voffB[1]);
            G8_WAIT_V(6); G8_BAR; G8_MMA(1, 1, At, B1); G8_BAR;
            G8_LDB(B0, 1, 0); G8_SCHED; G8_LDA(At, 1, 0); G8_STAGE(G8_SA(0, 1), a2_1, w10, w11);
            G8_WAIT_L(8); G8_BAR; G8_WAIT_L(0); G8_MMA(0, 0, At, B0); G8_BAR; G8_SCHED;
            G8_LDB(B1, 1, 1); G8_STAGE(G8_SB(1, 0), b2_0 + kstep, voffB[0], voffB[1]);
            G8_BAR; G8_WAIT_L(0); G8_MMA(0, 1, At, B1); G8_BAR;
            G8_LDA(At, 1, 1); G8_STAGE(G8_SA(1, 0), a2_0 + kstep, w00, w01);
            G8_BAR; G8_WAIT_L(0); G8_MMA(1, 0, At, B0); G8_BAR; G8_SCHED;
            G8_STAGE(G8_SB(1, 1), b2_1 + kstep, voffB[0], voffB[1]);
            G8_WAIT_V(6); G8_BAR; G8_MMA(1, 1, At, B1); G8_BAR;
        }
        if constexpr (F8) {
#define G8_T(a, b, m) "+v"(acc[a][b][m][0]), "+v"(acc[a][b][m][1])
            asm volatile("s_nop 15\n\ts_nop 15" : G8_T(0, 0, 0), G8_T(0, 0, 1), G8_T(0, 0, 2), G8_T(0, 0, 3), G8_T(0, 1, 0), G8_T(0, 1, 1), G8_T(0, 1, 2), G8_T(0, 1, 3));
            asm volatile("s_nop 1" : G8_T(1, 0, 0), G8_T(1, 0, 1), G8_T(1, 0, 2), G8_T(1, 0, 3), G8_T(1, 1, 0), G8_T(1, 1, 1), G8_T(1, 1, 2), G8_T(1, 1, 3));
#undef G8_T
        }
        E(acc, cur, wr, wc, fr, fq);
        if (!has_next) break;
#pragma unroll
        for (int a = 0; a < 2; ++a)
#pragma unroll
            for (int b = 0; b < 2; ++b)
#pragma unroll
                for (int m = 0; m < 4; ++m)
#pragma unroll
                    for (int n = 0; n < 2; ++n) acc[a][b][m][n] = (f32x4){0.f, 0.f, 0.f, 0.f};
        cur = nxt; cA0 = nA0; cA1 = nA1; cB0 = nB0; cB1 = nB1; ++ui;
        if constexpr (GATHER) {
#pragma unroll
            for (int h = 0; h < 2; ++h)
#pragma unroll
                for (int i = 0; i < 2; ++i) vc[h][i] = vn[h][i]; }
    }
    G8_WAIT_V(0);
    if (wr == 0) G8_BAR;
    G8_BAR;
#undef G8_SA
#undef G8_SB
#undef G8_STAGE
#undef G8_LDA
#undef G8_LDB
#undef G8_MMA
#undef G8_CAT
}
}
using g8::GU;

#define EPI_ARGS const f32x4 (&acc)[2][2][4][2], const GU& u, int wr, int wc, int fr, int fq

__device__ __forceinline__ size_t qk_tile_off(int b, int h, int t, int NH) { return ((size_t)(b * NH + h) * 128 + (t >> 5)) * 2048 + (size_t)(t & 31) * 8; }
__device__ __forceinline__ size_t v_tile_off(int b, int h, int tile, int NH) { return ((size_t)(b * NH + h) * 128 + tile) * 2048; }
struct EpiVt {
    static constexpr bool PERM = true;
    bf16_t* V; int NH;
    __device__ __forceinline__ void operator()(EPI_ARGS) const {
        const int row0 = u.p0 * 256 + wr * 64 + fr, col0 = u.p1 * 256 + wc * 32 + 8 * fq;
#pragma unroll
        for (int ai = 0; ai < 2; ++ai)
#pragma unroll
            for (int m = 0; m < 4; ++m) { const int feat = row0 + ai * 128 + m * 16, h = feat >> 6, d = feat & 63, db = d >> 5, r = d & 31;
#pragma unroll
                for (int bj = 0; bj < 2; ++bj) { const int col = col0 + bj * 128, b = col >> 12, t = col & 4095, mm = (t & 31) >> 3, sI = mm >> 1, jg = mm & 1;
                    const f32x4 v0 = acc[ai][bj][m][0], v1 = acc[ai][bj][m][1];
                    bf16_t* p = V + v_tile_off(b, h, t >> 5, NH) + (size_t)((((db * 2 + sI) * 2) * 32 + r) * 8 + jg * 4);
                    u32x2 w0, w1; w0.x = cvt_pk_bf16(v0[0], v0[1]); w0.y = cvt_pk_bf16(v0[2], v0[3]); w1.x = cvt_pk_bf16(v1[0], v1[1]); w1.y = cvt_pk_bf16(v1[2], v1[3]);
                    *(u32x2*)p = w0; *(u32x2*)(p + 256) = w1; } }
    }
};

struct EpiStoreBf16 {
    static constexpr bool PERM = true;
    bf16_t* O; size_t ld; float scale;
    __device__ __forceinline__ void operator()(EPI_ARGS) const {
        const int row0 = u.p0 * 256 + wr * 64 + fr, col0 = u.p1 * 256 + wc * 32 + 8 * fq;
#pragma unroll
        for (int ai = 0; ai < 2; ++ai)
#pragma unroll
            for (int m = 0; m < 4; ++m) { bf16_t* rowp = O + (size_t)(row0 + ai * 128 + m * 16) * ld + col0;
#pragma unroll
                for (int bj = 0; bj < 2; ++bj) { const f32x4 v0 = acc[ai][bj][m][0] * scale, v1 = acc[ai][bj][m][1] * scale;
                    u32x4 w; w.x = cvt_pk_bf16(v0[0], v0[1]); w.y = cvt_pk_bf16(v0[2], v0[3]); w.z = cvt_pk_bf16(v1[0], v1[1]); w.w = cvt_pk_bf16(v1[2], v1[3]);
                    *(u32x4*)(rowp + bj * 128) = w; } }
    }
};
struct EpiInAB {
    static constexpr bool PERM = true;
    bf16_t* A2; bf16_t* Q; bf16_t* Kk;
    __device__ __forceinline__ void operator()(EPI_ARGS) const {
        const int row0 = u.p0 * 256 + wr * 64 + fr, colt = u.p1 * 256 + wc * 32 + 8 * fq; const int kind = u.p1 >> 1;
        const float sc = (kind == 1) ? QSCALE : 1.0f;
#pragma unroll
        for (int ai = 0; ai < 2; ++ai)
#pragma unroll
            for (int m = 0; m < 4; ++m) { const int row = row0 + ai * 128 + m * 16;
#pragma unroll
                for (int bj = 0; bj < 2; ++bj) { const f32x4 v0 = acc[ai][bj][m][0] * sc, v1 = acc[ai][bj][m][1] * sc; const int col = colt + bj * 128;
                    u32x4 w; w.x = cvt_pk_bf16(v0[0], v0[1]); w.y = cvt_pk_bf16(v0[2], v0[3]); w.z = cvt_pk_bf16(v1[0], v1[1]); w.w = cvt_pk_bf16(v1[2], v1[3]);
                    bf16_t* p;
                    if (kind == 0) { const int g = col >> 4, hp = col & 15, b = row >> 12, l = row & 4095; p = A2 + ((size_t)(g * 1024 + b * NCH + (l >> 5)) * A2LD + (l & 31) * 16 + hp); }
                    else { const int cc = col - (kind == 1 ? 512 : 1024); p = (kind == 1 ? Q : Kk) + qk_tile_off(row >> 12, cc >> 6, row & 4095, 8) + (size_t)((cc & 63) >> 3) * 256; }
                    *(u32x4*)p = w; } }
    }
};
struct EpiInC {
    static constexpr bool PERM = true;
    bf16_t* Q; bf16_t* Kk;
    __device__ __forceinline__ void operator()(EPI_ARGS) const {
        const int row0 = u.p0 * 256 + wr * 64 + fr; const bool isq = u.p1 < 4; const int col0 = (u.p1 & 3) * 256 + wc * 32 + 8 * fq;
        const float sc = isq ? QSCALE : 1.0f; bf16_t* base = isq ? Q : Kk;
#pragma unroll
        for (int ai = 0; ai < 2; ++ai)
#pragma unroll
            for (int m = 0; m < 4; ++m) { const int row = row0 + ai * 128 + m * 16;
#pragma unroll
                for (int bj = 0; bj < 2; ++bj) { const f32x4 v0 = acc[ai][bj][m][0] * sc, v1 = acc[ai][bj][m][1] * sc; const int col = col0 + bj * 128;
                    u32x4 w; w.x = cvt_pk_bf16(v0[0], v0[1]); w.y = cvt_pk_bf16(v0[2], v0[3]); w.z = cvt_pk_bf16(v1[0], v1[1]); w.w = cvt_pk_bf16(v1[2], v1[3]);
                    *(u32x4*)(base + qk_tile_off(row >> 12, col >> 6, row & 4095, 16) + (size_t)((col & 63) >> 3) * 256) = w; } }
    }
};
struct EpiS {
    static constexpr bool PERM = false;
    float* S;
    __device__ __forceinline__ void operator()(EPI_ARGS) const {
        const int row0 = u.p0 * 256 + wr * 64 + fr, col0 = wc * 32 + 4 * fq; float* base = S + (size_t)u.p2 * 1024 * 128;
#pragma unroll
        for (int ai = 0; ai < 2; ++ai)
#pragma unroll
            for (int m = 0; m < 4; ++m) { float* rowp = base + (size_t)(row0 + ai * 128 + m * 16) * 128 + col0;
#pragma unroll
                for (int n = 0; n < 2; ++n) *(f32x4*)(rowp + n * 16) = acc[ai][0][m][n]; }
    }
};
__device__ __forceinline__ float gelu_tanh(float x) { const float a = 0.7978845608f * (x + 0.044715f * x * x * x); return x * rcp(1.0f + ex2(-2.0f * LOG2E * a)); }
struct EpiY {
    static constexpr bool PERM = true;
    bf16_t* Z;
    __device__ __forceinline__ void operator()(EPI_ARGS) const {
        const int row0 = u.p0 * 256 + wr * 64 + fr, col0 = u.p1 * 256 + wc * 32 + 8 * fq, g = u.p2;
#pragma unroll
        for (int ai = 0; ai < 2; ++ai)
#pragma unroll
            for (int m = 0; m < 4; ++m) { const int row = row0 + ai * 128 + m * 16, b = row >> 7, ch = row & 127;
#pragma unroll
                for (int bj = 0; bj < 2; ++bj) { const int col = col0 + bj * 128, t = col >> 4, h = col & 15; const f32x4 v0 = acc[ai][bj][m][0], v1 = acc[ai][bj][m][1];
                    u32x4 w; w.x = cvt_pk_bf16(gelu_tanh(v0[0]), gelu_tanh(v0[1])); w.y = cvt_pk_bf16(gelu_tanh(v0[2]), gelu_tanh(v0[3]));
                    w.z = cvt_pk_bf16(gelu_tanh(v1[0]), gelu_tanh(v1[1])); w.w = cvt_pk_bf16(gelu_tanh(v1[2]), gelu_tanh(v1[3]));
                    *(u32x4*)(Z + (size_t)(b * SEQ + ch * TCH + t) * 512 + g * 16 + h) = w; } }
    }
};
struct EpiGlu {
    static constexpr bool PERM = true;
    const bf16_t* Z; const float* bias; bf16_t* Y;
    __device__ __forceinline__ void operator()(EPI_ARGS) const {
        const int row0 = u.p0 * 256 + wr * 64 + fr, col0 = u.p1 * 256 + wc * 32 + 8 * fq;
#pragma unroll
        for (int bj = 0; bj < 2; ++bj) { const int col = col0 + bj * 128; const f32x4 b0 = *(const f32x4*)(bias + col), b1 = *(const f32x4*)(bias + col + 4);
#pragma unroll
            for (int ai = 0; ai < 2; ++ai)
#pragma unroll
                for (int m = 0; m < 4; ++m) { const int row = row0 + ai * 128 + m * 16; const u32x4 zz = *(const u32x4*)(Z + (size_t)row * 512 + col);
                    const f32x4 v0 = acc[ai][bj][m][0] + b0, v1 = acc[ai][bj][m][1] + b1;
                    u32x4 w; w.x = cvt_pk_bf16(bf_lo(zz.x) * sigmoidf_(v0[0]), bf_hi(zz.x) * sigmoidf_(v0[1])); w.y = cvt_pk_bf16(bf_lo(zz.y) * sigmoidf_(v0[2]), bf_hi(zz.y) * sigmoidf_(v0[3]));
                    w.z = cvt_pk_bf16(bf_lo(zz.z) * sigmoidf_(v1[0]), bf_hi(zz.z) * sigmoidf_(v1[1])); w.w = cvt_pk_bf16(bf_lo(zz.w) * sigmoidf_(v1[2]), bf_hi(zz.w) * sigmoidf_(v1[3]));
                    *(u32x4*)(Y + (size_t)row * 1024 + col) = w; } }
    }
};
template <bool RES_F32> struct EpiRes {
    static constexpr bool PERM = true;
    const void* res; bf16_t* out;
    __device__ __forceinline__ void operator()(EPI_ARGS) const {
        const int row0 = u.p0 * 256 + wr * 64 + fr, col0 = u.p1 * 256 + wc * 32 + 8 * fq;
#pragma unroll
        for (int ai = 0; ai < 2; ++ai)
#pragma unroll
            for (int m = 0; m < 4; ++m) { const size_t ro = (size_t)(row0 + ai * 128 + m * 16) * 1024 + col0;
#pragma unroll
                for (int bj = 0; bj < 2; ++bj) { const size_t o = ro + bj * 128; f32x4 r0, r1;
                    if (RES_F32) { r0 = *(const f32x4*)((const float*)res + o); r1 = *(const f32x4*)((const float*)res + o + 4); }
                    else { const u32x4 rr = *(const u32x4*)((const bf16_t*)res + o); r0 = (f32x4){bf_lo(rr.x), bf_hi(rr.x), bf_lo(rr.y), bf_hi(rr.y)}; r1 = (f32x4){bf_lo(rr.z), bf_hi(rr.z), bf_lo(rr.w), bf_hi(rr.w)}; }
                    const f32x4 v0 = r0 + acc[ai][bj][m][0], v1 = r1 + acc[ai][bj][m][1];
                    u32x4 w; w.x = cvt_pk_bf16(v0[0], v0[1]); w.y = cvt_pk_bf16(v0[2], v0[3]); w.z = cvt_pk_bf16(v1[0], v1[1]); w.w = cvt_pk_bf16(v1[2], v1[3]);
                    *(u32x4*)(out + o) = w; } }
    }
};
struct EpiSwiglu {
    static constexpr bool PERM = true;
    const float* bg; const float* bu; unsigned char* act;
    __device__ __forceinline__ void operator()(EPI_ARGS) const {
        const int row0 = u.p0 + wr * 64 + fr, col = u.p1 + wc * 32 + 8 * fq; const float* pg = bg + (size_t)u.p2 * 1024 + col; const float* pu = bu + (size_t)u.p2 * 1024 + col;
        const f32x4 g0 = *(const f32x4*)pg, g1 = *(const f32x4*)(pg + 4), u0 = *(const f32x4*)pu, u1 = *(const f32x4*)(pu + 4);
#pragma unroll
        for (int ai = 0; ai < 2; ++ai)
#pragma unroll
            for (int m = 0; m < 4; ++m) { float r[8];
#pragma unroll
                for (int n = 0; n < 2; ++n)
#pragma unroll
                    for (int j = 0; j < 4; ++j) { const float gg = fminf(acc[ai][0][m][n][j] * (1.0f / W8_SCALE) + (n ? g1[j] : g0[j]), 7.0f); const float uu = fminf(fmaxf(acc[ai][1][m][n][j] * (1.0f / W8_SCALE) + (n ? u1[j] : u0[j]), -7.0f), 7.0f);
                        r[n * 4 + j] = gg * sigmoidf_(1.702f * gg) * (uu + 1.0f); }
                u32x2 w; w.x = cvt_pk4_fp8(r[0], r[1], r[2], r[3]); w.y = cvt_pk4_fp8(r[4], r[5], r[6], r[7]);
                *(u32x2*)(act + (size_t)(row0 + ai * 128 + m * 16) * 1024 + col) = w; }
    }
};
struct EpiDown {
    static constexpr bool PERM = true;
    const float* bd; bf16_t* ys;
    __device__ __forceinline__ void operator()(EPI_ARGS) const {
        const int row0 = u.p0 + wr * 64 + fr, col0 = u.p1 + wc * 32 + 8 * fq;
#pragma unroll
        for (int bj = 0; bj < 2; ++bj) { const int col = col0 + bj * 128; const float* pb = bd + (size_t)u.p2 * 1024 + col; const f32x4 b0 = *(const f32x4*)pb, b1 = *(const f32x4*)(pb + 4);
#pragma unroll
            for (int ai = 0; ai < 2; ++ai)
#pragma unroll
                for (int m = 0; m < 4; ++m) { const f32x4 v0 = acc[ai][bj][m][0] * (1.0f / W8_SCALE) + b0, v1 = acc[ai][bj][m][1] * (1.0f / W8_SCALE) + b1;
                    u32x4 w; w.x = cvt_pk_bf16(v0[0], v0[1]); w.y = cvt_pk_bf16(v0[2], v0[3]); w.z = cvt_pk_bf16(v1[0], v1[1]); w.w = cvt_pk_bf16(v1[2], v1[3]);
                    *(u32x4*)(ys + (size_t)(row0 + ai * 128 + m * 16) * 1024 + col) = w; } }
    }
};
struct EpiPle {
    static constexpr bool PERM = true;
    const bf16_t* proj; bf16_t* r;
    __device__ __forceinline__ void operator()(EPI_ARGS) const {
        const int row0 = u.p0 * 256 + wr * 64 + fr, col0 = u.p1 * 256 + wc * 32 + 8 * fq;
#pragma unroll
        for (int ai = 0; ai < 2; ++ai)
#pragma unroll
            for (int m = 0; m < 4; ++m) { const size_t ro = (size_t)(row0 + ai * 128 + m * 16) * 1024 + col0;
#pragma unroll
                for (int bj = 0; bj < 2; ++bj) { const size_t o = ro + bj * 128; const u32x4 pp = *(const u32x4*)(proj + o); const u32x4 rr = *(const u32x4*)(r + o); const f32x4 r0 = {bf_lo(rr.x), bf_hi(rr.x), bf_lo(rr.y), bf_hi(rr.y)}, r1 = {bf_lo(rr.z), bf_hi(rr.z), bf_lo(rr.w), bf_hi(rr.w)};
                    const f32x4 v0 = acc[ai][bj][m][0] * (1.0f / W8_SCALE), v1 = acc[ai][bj][m][1] * (1.0f / W8_SCALE);
                    f32x4 o0, o1;
                    o0[0] = r0[0] + bf_lo(pp.x) * sigmoidf_(v0[0]); o0[1] = r0[1] + bf_hi(pp.x) * sigmoidf_(v0[1]); o0[2] = r0[2] + bf_lo(pp.y) * sigmoidf_(v0[2]); o0[3] = r0[3] + bf_hi(pp.y) * sigmoidf_(v0[3]);
                    o1[0] = r1[0] + bf_lo(pp.z) * sigmoidf_(v1[0]); o1[1] = r1[1] + bf_hi(pp.z) * sigmoidf_(v1[1]); o1[2] = r1[2] + bf_lo(pp.w) * sigmoidf_(v1[2]); o1[3] = r1[3] + bf_hi(pp.w) * sigmoidf_(v1[3]);
                    u32x4 w; w.x = cvt_pk_bf16(o0[0], o0[1]); w.y = cvt_pk_bf16(o0[2], o0[3]); w.z = cvt_pk_bf16(o1[0], o1[1]); w.w = cvt_pk_bf16(o1[2], o1[3]);
                    *(u32x4*)(r + o) = w; } }
    }
};

struct Args { const float* in[31]; float* out; unsigned char* ws; int ph_lo, ph_hi; unsigned char btab[128]; };
struct Frame {
    LAS unsigned char* lds; int tid, lane, wave, G, bid, gw, GW;
    unsigned char* ws; unsigned* ctl;
};
enum { I_X = 0, I_P, I_NMIX, I_NFFN, I_NPLE, I_NFINAL, I_WINAB, I_ARE, I_AIM, I_BRE, I_BIM, I_CRE, I_CIM, I_SSMD, I_LOGSTEP, I_GLUW, I_GLUB, I_WOUTAB, I_RELB, I_WINC, I_WOUTC,
       I_RW, I_RB, I_WG, I_BG, I_WU, I_BU, I_WD, I_BD, I_WPLE, I_WPLEG };

__device__ __forceinline__ void tconv(const Frame& F, const float* __restrict__ src, bf16_t* __restrict__ dst, int K, int N, int nmat) {
    LAS unsigned* T = (LAS unsigned*)(F.lds + F.wave * 8192);
    const int tk = K >> 6, tn = N >> 6; const long ntiles = (long)nmat * tk * tn;
    const int lane = F.lane, nq = lane & 15, kk = lane >> 4;
    for (long tt = F.gw; tt < ntiles; tt += F.GW) {
        const int mat = (int)(tt / (tk * tn)), rem = (int)(tt % (tk * tn)), kt = rem / tn, ntl = rem % tn;
        const float* s = src + (size_t)mat * K * N + (size_t)(kt * 64) * N + ntl * 64;
        bf16_t* d = dst + (size_t)mat * N * K + (size_t)(ntl * 64) * K + kt * 64;
#pragma unroll
        for (int it = 0; it < 8; ++it) { const int k0 = 8 * it + 2 * kk;
            const f32x4 a = *(const f32x4*)(s + (size_t)k0 * N + 4 * nq), b = *(const f32x4*)(s + (size_t)(k0 + 1) * N + 4 * nq);
#pragma unroll
            for (int j = 0; j < 4; ++j) { const int n = 4 * nq + j, kp = 4 * it + kk; T[32 * n + (kp ^ (4 * (nq & 7)))] = cvt_pk_bf16(a[j], b[j]); } }
        __builtin_amdgcn_fence(__ATOMIC_RELEASE, "wavefront"); __builtin_amdgcn_wave_barrier(); __builtin_amdgcn_fence(__ATOMIC_ACQUIRE, "wavefront");
#pragma unroll
        for (int it = 0; it < 8; ++it) { const int n = 8 * it + (lane >> 3), c = lane & 7;
            const u32x4 v = *(const LAS u32x4*)(T + 32 * n + 4 * (c ^ ((n >> 2) & 7)));
            *(u32x4*)(d + (size_t)n * K + 8 * c) = v; }
        __builtin_amdgcn_fence(__ATOMIC_RELEASE, "wavefront"); __builtin_amdgcn_wave_barrier(); __builtin_amdgcn_fence(__ATOMIC_ACQUIRE, "wavefront");
    }
}
__device__ __forceinline__ void tconv8(const Frame& F, const float* __restrict__ src, unsigned char* __restrict__ dst, int K, int N, int nmat, float sc) {
    LAS unsigned* T = (LAS unsigned*)(F.lds + F.wave * 8192);
    const int tk = K >> 6, tn = N >> 6; const long ntiles = (long)nmat * tk * tn;
    const int lane = F.lane, nq = lane & 15, kk = lane >> 4;
    for (long tt = F.gw; tt < ntiles; tt += F.GW) {
        const int mat = (int)(tt / (tk * tn)), rem = (int)(tt % (tk * tn)), kt = rem / tn, ntl = rem % tn;
        const float* s = src + (size_t)mat * K * N + (size_t)(kt * 64) * N + ntl * 64;
        unsigned char* d = dst + (size_t)mat * N * K + (size_t)(ntl * 64) * K + kt * 64;
#pragma unroll
        for (int it = 0; it < 4; ++it) { const int k0 = 16 * it + 4 * kk; f32x4 a[4];
#pragma unroll
            for (int q = 0; q < 4; ++q) a[q] = *(const f32x4*)(s + (size_t)(k0 + q) * N + 4 * nq) * sc;
#pragma unroll
            for (int j = 0; j < 4; ++j) { const int n = 4 * nq + j; T[16 * n + (((it ^ (nq & 3)) << 2) | kk)] = cvt_pk4_fp8(a[0][j], a[1][j], a[2][j], a[3][j]); } }
        __builtin_amdgcn_fence(__ATOMIC_RELEASE, "wavefront"); __builtin_amdgcn_wave_barrier(); __builtin_amdgcn_fence(__ATOMIC_ACQUIRE, "wavefront");
#pragma unroll
        for (int it = 0; it < 4; ++it) { const int n = 16 * it + (lane >> 2), c = lane & 3;
            const u32x4 v = *(const LAS u32x4*)(T + 16 * n + 4 * (c ^ ((n >> 2) & 3)));
            *(u32x4*)(d + (size_t)n * K + 16 * c) = v; }
        __builtin_amdgcn_fence(__ATOMIC_RELEASE, "wavefront"); __builtin_amdgcn_wave_barrier(); __builtin_amdgcn_fence(__ATOMIC_ACQUIRE, "wavefront");
    }
}
__device__ __forceinline__ void conv_plain(const Frame& F, const float* __restrict__ src, bf16_t* __restrict__ dst, size_t n) {
    const size_t nth = (size_t)F.G * 512;
    for (size_t i = ((size_t)F.bid * 512 + F.tid) * 8; i < n; i += nth * 8) { const f32x4 a = *(const f32x4*)(src + i), b = *(const f32x4*)(src + i + 4);
        u32x4 w; w.x = cvt_pk_bf16(a[0], a[1]); w.y = cvt_pk_bf16(a[2], a[3]); w.z = cvt_pk_bf16(b[0], b[1]); w.w = cvt_pk_bf16(b[2], b[3]); *(u32x4*)(dst + i) = w; }
}
template <int MODE, bool SRC16>
__device__ __forceinline__ void rmsnorm_rows(const Frame& F, const void* __restrict__ src, const float* __restrict__ gain, bf16_t* __restrict__ dst, float* __restrict__ outf, int nrows) {
    const int lane = F.lane;
    f32x4 gv[4];
#pragma unroll
    for (int j = 0; j < 4; ++j) gv[j] = *(const f32x4*)(gain + 4 * (lane + 64 * j));
    for (int row = F.gw; row < nrows; row += F.GW) {
        f32x4 v[4]; float ss = 0.f;
#pragma unroll
        for (int j = 0; j < 4; ++j) {
            if (SRC16) { const u32x2 w = *(const u32x2*)((const bf16_t*)src + (size_t)row * 1024 + 4 * (lane + 64 * j)); v[j] = (f32x4){bf_lo(w.x), bf_hi(w.x), bf_lo(w.y), bf_hi(w.y)}; }
            else v[j] = *(const f32x4*)((const float*)src + (size_t)row * 1024 + 4 * (lane + 64 * j));
            ss += v[j][0] * v[j][0] + v[j][1] * v[j][1] + v[j][2] * v[j][2] + v[j][3] * v[j][3]; }
        ss = wave_sum(ss); const float rstd = rsqrtf(ss * (1.0f / 1024.0f) + RMS_EPS);
#pragma unroll
        for (int j = 0; j < 4; ++j) { const f32x4 y = v[j] * rstd * gv[j];
            if (MODE == 1) *(f32x4*)(outf + (size_t)row * 1024 + 4 * (lane + 64 * j)) = y;
            else { u32x2 w; w.x = cvt_pk_bf16(y[0], y[1]); w.y = cvt_pk_bf16(y[2], y[3]); *(u32x2*)(dst + (size_t)row * 1024 + 4 * (lane + 64 * j)) = w; } }
    }
}

__device__ __forceinline__ void s5_matrices(const Frame& F, const Args& a) {
    LAS float* Pr = (LAS float*)F.lds;
    LAS float* Pi = Pr + 33 * 64;
    LAS float* Br = Pi + 33 * 64;
    LAS float* Bi = Br + 1024;
    LAS float* Cr = Bi + 1024;
    LAS float* Ci = Cr + 1024;
    LAS float* Kf = Ci + 1024;
    LAS float* coefr = Kf + 8192; LAS float* coefi = coefr + 64;
    bf16_t* WbT = (bf16_t*)(F.ws + WS_WBT); bf16_t* My = (bf16_t*)(F.ws + WS_MY);
    const int t = F.tid;
    for (int g = F.bid; g < NGRP; g += F.G) {
        __syncthreads();
        if (t < 64) { const int n = t; const float are = a.in[I_ARE][g * 64 + n], aim = a.in[I_AIM][g * 64 + n], step = __expf(a.in[I_LOGSTEP][g]);
            for (int d = 0; d <= 32; ++d) { const float mag = __expf(are * step * (float)d); float rev = aim * step * (float)d * 0.15915494309189535f; rev -= rintf(rev);
                Pr[d * 64 + n] = mag * __builtin_amdgcn_cosf(rev); Pi[d * 64 + n] = mag * __builtin_amdgcn_sinf(rev); }
            const float lr = Pr[64 + n] - 1.0f, li = Pi[64 + n], den = 1.0f / (are * are + aim * aim);
            coefr[n] = (lr * are + li * aim) * den; coefi[n] = (li * are - lr * aim) * den; }
        __syncthreads();
        for (int idx = t; idx < 1024; idx += 512) { const int n = idx >> 4; const float br = a.in[I_BRE][g * 1024 + idx], bi = a.in[I_BIM][g * 1024 + idx];
            Br[idx] = coefr[n] * br - coefi[n] * bi; Bi[idx] = coefr[n] * bi + coefi[n] * br;
            Cr[idx] = a.in[I_CRE][g * 1024 + idx]; Ci[idx] = a.in[I_CIM][g * 1024 + idx]; }
        __syncthreads();
        { const int hh = t & 255, h = hh >> 4, hp = hh & 15;
          for (int d = t >> 8; d < 32; d += 2) { float s = 0.f;
              for (int n = 0; n < 64; ++n) { const float cr = Cr[h * 64 + n], ci = Ci[h * 64 + n], pr = Pr[d * 64 + n], pi = Pi[d * 64 + n];
                  const float mr = cr * pr - ci * pi, mi = cr * pi + ci * pr; s += mr * Br[n * 16 + hp] - mi * Bi[n * 16 + hp]; }
              if (d == 0 && h == hp) s += a.in[I_SSMD][g * 16 + h];
              Kf[d * 256 + hh] = s; } }
        __syncthreads();
        for (int ch = t; ch < 256 * 64; ch += 512) { const int row = ch >> 6, k0 = (ch & 63) * 8, s = k0 >> 4, hp0 = k0 & 15; float v[8];
            if (row < 128) { const int n = row & 63; const float pr = Pr[(31 - s) * 64 + n], pi = Pi[(31 - s) * 64 + n];
#pragma unroll
                for (int j = 0; j < 8; ++j) { const float br = Br[n * 16 + hp0 + j], bi = Bi[n * 16 + hp0 + j]; v[j] = (row < 64) ? (pr * br - pi * bi) : (pr * bi + pi * br); } }
            else {
#pragma unroll
                for (int j = 0; j < 8; ++j) v[j] = 0.f; }
            u32x4 w; w.x = cvt_pk_bf16(v[0], v[1]); w.y = cvt_pk_bf16(v[2], v[3]); w.z = cvt_pk_bf16(v[4], v[5]); w.w = cvt_pk_bf16(v[6], v[7]);
            *(u32x4*)(WbT + ((size_t)g * 256 + row) * 512 + k0) = w; }
        for (int ch = t; ch < 512 * 80; ch += 512) { const int row = ch / 80, k0 = (ch % 80) * 8, tt = row >> 4, h = row & 15; float v[8];
            if (k0 < 512) { const int s = k0 >> 4, hp0 = k0 & 15;
#pragma unroll
                for (int j = 0; j < 8; ++j) v[j] = (s <= tt) ? Kf[(tt - s) * 256 + h * 16 + hp0 + j] : 0.f; }
            else { const int n0 = (k0 - 512) & 63; const bool im = k0 >= 576;
#pragma unroll
                for (int j = 0; j < 8; ++j) { const int n = n0 + j; const float cr = Cr[h * 64 + n], ci = Ci[h * 64 + n], pr = Pr[(tt + 1) * 64 + n], pi = Pi[(tt + 1) * 64 + n];
                    v[j] = im ? -(cr * pi + ci * pr) : (cr * pr - ci * pi); } }
            u32x4 w; w.x = cvt_pk_bf16(v[0], v[1]); w.y = cvt_pk_bf16(v[2], v[3]); w.z = cvt_pk_bf16(v[4], v[5]); w.w = cvt_pk_bf16(v[6], v[7]);
            *(u32x4*)(My + ((size_t)g * 512 + row) * A2LD + k0) = w; }
    }
    __syncthreads();
}

__device__ __forceinline__ void conv_moe_weights(const Frame& F, const Args& a, int layer) {
    unsigned char* W = (unsigned char*)(F.ws + WS_MOEW); const size_t L = (size_t)NEXP * 1024 * 1024;
    tconv8(F, a.in[I_WG] + layer * L, W, 1024, 1024, NEXP, W8_SCALE);
    tconv8(F, a.in[I_WU] + layer * L, W + L, 1024, 1024, NEXP, W8_SCALE);
    tconv8(F, a.in[I_WD] + layer * L, W + 2 * L, 1024, 1024, NEXP, W8_SCALE);
}

__device__ __forceinline__ void p0_prologue(const Frame& F, const Args& a) {
    s5_matrices(F, a);
    tconv(F, a.in[I_WINAB], (bf16_t*)(F.ws + WS_WINAB), 1024, 2048, 1);
    tconv(F, a.in[I_GLUW], (bf16_t*)(F.ws + WS_GLU), 512, 512, 1);
    tconv(F, a.in[I_WOUTAB], (bf16_t*)(F.ws + WS_WOUTAB), 1024, 1024, 1);
    tconv(F, a.in[I_WINC], (bf16_t*)(F.ws + WS_WINC), 1024, 3072, 1);
    tconv(F, a.in[I_WOUTC], (bf16_t*)(F.ws + WS_WOUTC), 1024, 1024, 1);
    tconv(F, a.in[I_WPLE], (bf16_t*)(F.ws + WS_WPLE), 256, 1024, 2);
    tconv8(F, a.in[I_WPLEG], (unsigned char*)(F.ws + WS_WPLEG), 1024, 1024, 2, W8_SCALE);
    conv_moe_weights(F, a, 0);
    conv_plain(F, a.in[I_P], (bf16_t*)(F.ws + WS_PB), (size_t)2 * NTOK * PLE);
    rmsnorm_rows<0, false>(F, a.in[I_X], a.in[I_NMIX], (bf16_t*)(F.ws + WS_H), nullptr, NTOK);
}

__device__ __forceinline__ void s5_scan(const Frame& F, const Args& a) {
    const float* S = (const float*)(F.ws + RA_SS); bf16_t* A2 = (bf16_t*)(F.ws + RA_A2);
    const int n = F.lane;
    for (int item = F.gw; item < NGRP * NBATCH; item += F.GW) {
        const int g = item >> 3, b = item & 7;
        const float are = a.in[I_ARE][g * 64 + n], aim = a.in[I_AIM][g * 64 + n], step = __expf(a.in[I_LOGSTEP][g]);
        const float mag = __expf(are * step * 32.0f); float rev = aim * step * 32.0f * 0.15915494309189535f; rev -= rintf(rev);
        const float lr = mag * __builtin_amdgcn_cosf(rev), li = mag * __builtin_amdgcn_sinf(rev);
        float xr = 0.f, xi = 0.f;
        const float* sp = S + ((size_t)g * 1024 + b * NCH) * 128 + n; bf16_t* xp = A2 + ((size_t)g * 1024 + b * NCH) * A2LD + 512 + n;
        for (int c0 = 0; c0 < NCH; c0 += 16) {
            float sr[16], si[16];
#pragma unroll
            for (int j = 0; j < 16; ++j) { sr[j] = sp[(size_t)(c0 + j) * 128]; si[j] = sp[(size_t)(c0 + j) * 128 + 64]; }
#pragma unroll
            for (int j = 0; j < 16; ++j) { xp[(size_t)(c0 + j) * A2LD] = f2bf(xr); xp[(size_t)(c0 + j) * A2LD + 64] = f2bf(xi);
                const float nr = lr * xr - li * xi + sr[j], ni = lr * xi + li * xr + si[j]; xr = nr; xi = ni; }
        }
    }
}

__device__ __forceinline__ void moba_kmean(const Frame& F) {
    const bf16_t* Kk = (const bf16_t*)(F.ws + RA_K0); float* KM = (float*)(F.ws + RB_KMEAN);
    const int lane = F.lane;
    for (int item = F.gw; item < NBATCH * MH * NMB; item += F.GW) {
        const int j = item & 15, h = (item >> 4) & 7, b = item >> 7;
        const bf16_t* p = Kk + qk_tile_off(b, h, j * MBLK, 8) + (size_t)lane * 8;
        float s[4][8];
#pragma unroll
        for (int q = 0; q < 4; ++q)
#pragma unroll
            for (int i = 0; i < 8; ++i) s[q][i] = 0.f;
        for (int it4 = 0; it4 < 8; ++it4) {
#pragma unroll
            for (int q = 0; q < 4; ++q) { const u32x4 v = *(const u32x4*)(p + (size_t)(it4 * 4 + q) * 512);
                s[q][0] += bf_lo(v.x); s[q][1] += bf_hi(v.x); s[q][2] += bf_lo(v.y); s[q][3] += bf_hi(v.y); s[q][4] += bf_lo(v.z); s[q][5] += bf_hi(v.z); s[q][6] += bf_lo(v.w); s[q][7] += bf_hi(v.w); } }
#pragma unroll
        for (int q = 0; q < 4; ++q)
#pragma unroll
            for (int i = 0; i < 8; ++i) { float v = s[q][i]; v += __shfl_xor(v, 1); v += __shfl_xor(v, 2); v += __shfl_xor(v, 4); v += __shfl_xor(v, 8); v += __shfl_xor(v, 16); s[q][i] = v; }
        if ((lane & 31) == 0) { const int hf = lane >> 5;
#pragma unroll
            for (int q = 0; q < 4; ++q)
#pragma unroll
                for (int i = 0; i < 8; ++i) KM[(size_t)item * 64 + (hf + 2 * q) * 8 + i] = s[q][i] * (1.0f / 256.0f); }
    }
}
__device__ __forceinline__ void moba_gate(const Frame& F) {
    const bf16_t* Q = (const bf16_t*)(F.ws + RA_Q0); const float* KM = (const float*)(F.ws + RB_KMEAN); int* LIST = (int*)(F.ws + RB_MOBALIST); unsigned* CNT = F.ctl + CW_MOBACNT;
    const int t = F.tid, sub = t >> 8, tq = t & 255;
    LAS float* km = (LAS float*)F.lds + sub * 1024;
    LAS int* lcnt = (LAS int*)(F.lds + 8192) + sub * 32;
    const int nitem = NBATCH * MH * 15;
    for (int it0 = F.bid * 2; it0 < nitem; it0 += F.G * 2) {
        const int item = it0 + sub; const bool act = item < nitem;
        const int i = act ? 1 + item % 15 : 1, bh = act ? item / 15 : 0, b = bh >> 3, h = bh & 7;
        __syncthreads();
        for (int x = tq; x < i * 64; x += 256) km[x] = KM[(size_t)bh * 1024 + x];
        if (tq < 32) lcnt[tq] = 0;
        __syncthreads();
        int sel[3] = {0, 0, 0}, lpos[3] = {0, 0, 0}; const int nsel = i < 3 ? i : 3;
        if (act) {
            const bf16_t* qp = Q + qk_tile_off(b, h, i * MBLK + tq, 8); float qv[64];
#pragma unroll
            for (int c = 0; c < 8; ++c) { const u32x4 v = *(const u32x4*)(qp + c * 256); qv[c * 8 + 0] = bf_lo(v.x); qv[c * 8 + 1] = bf_hi(v.x); qv[c * 8 + 2] = bf_lo(v.y); qv[c * 8 + 3] = bf_hi(v.y);
                qv[c * 8 + 4] = bf_lo(v.z); qv[c * 8 + 5] = bf_hi(v.z); qv[c * 8 + 6] = bf_lo(v.w); qv[c * 8 + 7] = bf_hi(v.w); }
            float v0 = -3.0e38f, v1 = -3.0e38f, v2 = -3.0e38f; int i0 = 0, i1 = 0, i2 = 0;
            for (int j = 0; j < i; ++j) { float gsum = 0.f;
#pragma unroll
                for (int d = 0; d < 64; ++d) gsum += qv[d] * km[j * 64 + d];
                if (gsum > v0) { v2 = v1; i2 = i1; v1 = v0; i1 = i0; v0 = gsum; i0 = j; } else if (gsum > v1) { v2 = v1; i2 = i1; v1 = gsum; i1 = j; } else if (gsum > v2) { v2 = gsum; i2 = j; } }
            sel[0] = i0; sel[1] = i1; sel[2] = i2;
#pragma unroll
            for (int s = 0; s < 3; ++s) if (s < nsel) lpos[s] = atomicAdd((int*)&lcnt[sel[s]], 1);
        }
        __syncthreads();
        if (act && tq < 16 && lcnt[tq] > 0) lcnt[16 + tq] = (int)__hip_atomic_fetch_add(CNT + bh * 16 + tq, (unsigned)lcnt[tq], __ATOMIC_RELAXED, __HIP_MEMORY_SCOPE_AGENT);
        __syncthreads();
        if (act) {
#pragma unroll
            for (int s = 0; s < 3; ++s) if (s < nsel) LIST[((size_t)bh * 16 + sel[s]) * 4096 + lcnt[16 + sel[s]] + lpos[s]] = (i * MBLK + tq) | (s << 12); }
    }
    __syncthreads();
}

__device__ __forceinline__ void stage_o_rows(LAS unsigned char* wl, const f32x16& o0, const f32x16& o1, float sc, int r, int hf) {
#pragma unroll
    for (int g = 0; g < 4; ++g) { u32x2 w0, w1; w0.x = cvt_pk_bf16(o0[4 * g] * sc, o0[4 * g + 1] * sc); w0.y = cvt_pk_bf16(o0[4 * g + 2] * sc, o0[4 * g + 3] * sc);
        w1.x = cvt_pk_bf16(o1[4 * g] * sc, o1[4 * g + 1] * sc); w1.y = cvt_pk_bf16(o1[4 * g + 2] * sc, o1[4 * g + 3] * sc);
        *(LAS u32x2*)(wl + r * 128 + ((g ^ (r & 7)) << 4) + hf * 8) = w0; *(LAS u32x2*)(wl + r * 128 + (((4 + g) ^ (r & 7)) << 4) + hf * 8) = w1; }
    __builtin_amdgcn_fence(__ATOMIC_RELEASE, "wavefront"); __builtin_amdgcn_wave_barrier(); __builtin_amdgcn_fence(__ATOMIC_ACQUIRE, "wavefront");
}
__device__ __forceinline__ u32x4 read_o_row(const LAS unsigned char* wl, int q, int c) { return *(const LAS u32x4*)(wl + q * 128 + ((c ^ (q & 7)) << 4)); }
struct KFrag { bf16x8 f[4]; };
__device__ __forceinline__ KFrag load_kfrag(const bf16_t* kp) { KFrag k;
#pragma unroll
    for (int s = 0; s < 4; ++s) k.f[s] = *(const bf16x8*)(kp + 512 * s);
    return k; }
struct VFrag { bf16x8 f[2][2]; };
__device__ __forceinline__ VFrag load_vfrag(const bf16_t* vp) { VFrag v;
#pragma unroll
    for (int db = 0; db < 2; ++db)
#pragma unroll
        for (int s = 0; s < 2; ++s) v.f[db][s] = *(const bf16x8*)(vp + (db * 2 + s) * 512);
    return v; }
template <bool OWN>
__device__ __forceinline__ void moba_task(const bf16_t* __restrict__ Q, const bf16_t* __restrict__ Kk, const bf16_t* __restrict__ Vt, bf16_t* __restrict__ PO, float* __restrict__ PML,
                                          const LAS float* tab, LAS unsigned char* wl, int b, int h, int tq, bool valid, int slot, int key_base, int ntile, int tmin, int lane) {
    const int r = lane & 31, hf = lane >> 5; const size_t tokb = (size_t)b * SEQ;
    bf16x8 qf[4];
    { const bf16_t* qp = Q + qk_tile_off(b, h, tq, 8) + hf * 256;
#pragma unroll
      for (int s = 0; s < 4; ++s) qf[s] = *(const bf16x8*)(qp + 512 * s); }
    const bf16_t* kbase = Kk + qk_tile_off(b, h, key_base, 8) + hf * 256 + r * 8;
    const bf16_t* vbase = Vt + v_tile_off(b, h, key_base >> 5, 8) + hf * 256 + r * 8;
    KFrag k0 = load_kfrag(kbase);
    VFrag v0 = load_vfrag(vbase);
    f32x16 o0, o1;
#pragma unroll
    for (int i = 0; i < 16; ++i) { o0[i] = 0.f; o1[i] = 0.f; }
    float m = -1.0e30f, l = 0.f; const float b31 = tab[h * 128 + 127];
    for (int kt = 0; kt < ntile; ++kt) {
        const int key0 = key_base + 32 * kt;
        const int kn1 = (kt + 1 < ntile) ? kt + 1 : ntile - 1;
        const KFrag k1 = load_kfrag(kbase + (size_t)kn1 * 2048);
        const VFrag v1 = load_vfrag(vbase + (size_t)kn1 * 2048);
        f32x16 x;
#pragma unroll
        for (int i = 0; i < 16; ++i) x[i] = 0.f;
#pragma unroll
        for (int s = 0; s < 4; ++s) x = mfma32(k0.f[s], qf[s], x);
        if (tmin - (key0 + 31) < 113) {
#pragma unroll
            for (int i = 0; i < 16; ++i) { const int row = (i & 3) + 8 * (i >> 2) + 4 * hf; const int dist = tq - (key0 + row); const int idx = dist < 0 ? 0 : (dist > 127 ? 127 : dist);
                x[i] += tab[h * 128 + idx]; if (OWN && dist < 0) x[i] = -1.0e30f; }
        } else {
#pragma unroll
            for (int i = 0; i < 16; ++i) x[i] += b31;
        }
        float mx = x[0];
#pragma unroll
        for (int i = 1; i < 16; ++i) mx = fmaxf(mx, x[i]);
        mx = fmaxf(mx, __shfl_xor(mx, 32));
        const float mn = fmaxf(m, mx), alpha = ex2(m - mn); m = mn;
        float ps = 0.f; unsigned pw[8];
#pragma unroll
        for (int i = 0; i < 8; ++i) { const float p0 = ex2(x[2 * i] - mn), p1 = ex2(x[2 * i + 1] - mn); ps += p0 + p1; pw[i] = cvt_pk_bf16(p0, p1); }
        l = l * alpha + ps;
        o0 *= alpha; o1 *= alpha;
#pragma unroll
        for (int s = 0; s < 2; ++s) { u32x4 pf; pf.x = pw[4 * s]; pf.y = pw[4 * s + 1]; pf.z = pw[4 * s + 2]; pf.w = pw[4 * s + 3];
            const bf16x8 pb = __builtin_bit_cast(bf16x8, pf);
            o0 = mfma32(v0.f[0][s], pb, o0); o1 = mfma32(v0.f[1][s], pb, o1); }
        k0 = k1; v0 = v1;
    }
    l += __shfl_xor(l, 32);
    const int pi = valid ? (int)(((tokb + tq) * 8 + h) * 4 + slot) : -1;
    stage_o_rows(wl, o0, o1, 1.0f / l, r, hf);
#pragma unroll
    for (int it = 0; it < 4; ++it) { const int q = it * 8 + (lane >> 3), c = lane & 7; const int pq = __shfl(pi, q); const u32x4 v = read_o_row(wl, q, c);
        if (pq >= 0) *(u32x4*)(PO + (size_t)pq * 64 + c * 8) = v; }
    if (valid && hf == 0) { f32x2 ml; ml.x = m; ml.y = l; *(f32x2*)(PML + (size_t)pi * 2) = ml; }
    __builtin_amdgcn_fence(__ATOMIC_RELEASE, "wavefront"); __builtin_amdgcn_wave_barrier(); __builtin_amdgcn_fence(__ATOMIC_ACQUIRE, "wavefront");
}

__device__ __forceinline__ void moba_attn(const Frame& F, const Args& a) {
    const bf16_t* Q = (const bf16_t*)(F.ws + RA_Q0); const bf16_t* Kk = (const bf16_t*)(F.ws + RA_K0); const bf16_t* Vt = (const bf16_t*)(F.ws + RA_VT0);
    bf16_t* PO = (bf16_t*)(F.ws + RB_PARTO); float* PML = (float*)(F.ws + RB_PARTML); const int* LIST = (const int*)(F.ws + RB_MOBALIST); unsigned* CNT = F.ctl + CW_MOBACNT;
    LAS float* tab = (LAS float*)F.lds;
    LAS int* pre = (LAS int*)(F.lds + 4096);
    LAS int* cnts = (LAS int*)(F.lds + 4096 + 4128);
    LAS int* wsum = (LAS int*)(F.lds + 4096 + 4128 + 4096);
    LAS unsigned char* wl = F.lds + 16384 + F.wave * 4096;
    const int t = F.tid, lane = F.lane;
    __syncthreads();
    for (int x = t; x < 1024; x += 512) { const int hh = x >> 7, dd = x & 127; tab[x] = a.in[I_RELB][a.btab[dd] * 8 + hh] * LOG2E; }
    { const int c0 = (int)__hip_atomic_load(CNT + 2 * t, __ATOMIC_RELAXED, __HIP_MEMORY_SCOPE_AGENT), c1 = (int)__hip_atomic_load(CNT + 2 * t + 1, __ATOMIC_RELAXED, __HIP_MEMORY_SCOPE_AGENT);
      cnts[2 * t] = c0; cnts[2 * t + 1] = c1; const int t0 = (c0 + 31) >> 5, t1 = (c1 + 31) >> 5; int s = t0 + t1, inc = s;
#pragma unroll
      for (int o = 1; o < 64; o <<= 1) { const int v = __shfl_up(inc, o); if (lane >= o) inc += v; }
      if (lane == 63) wsum[F.wave] = inc;
      __syncthreads();
      int base = 0; for (int w = 0; w < F.wave; ++w) base += wsum[w];
      const int ex = base + inc - s; pre[2 * t] = ex; pre[2 * t + 1] = ex + t0; if (t == 511) pre[1024] = ex + s; }
    __syncthreads();
    const int nsel = pre[1024], ntask = nsel + NBATCH * MH * NMB * 8;
    for (int task = F.gw; task < ntask; task += F.GW) {
        if (task < nsel) {
            int lo = 0, hi = 1023;
            while (lo < hi) { const int mid = (lo + hi + 1) >> 1; if (pre[mid] <= task) lo = mid; else hi = mid - 1; }
            const int list = lo, chunk = task - pre[list], cnt = cnts[list], bh = list >> 4, j = list & 15;
            const int idx = chunk * 32 + (lane & 31); const bool valid = idx < cnt; const int e = valid ? LIST[(size_t)list * 4096 + idx] : 4095;
            const int tq = e & 4095, slot = valid ? (e >> 12) : 0; int tmin = tq;
#pragma unroll
            for (int o = 32; o >= 1; o >>= 1) tmin = min(tmin, __shfl_xor(tmin, o));
            moba_task<false>(Q, Kk, Vt, PO, PML, tab, wl, bh >> 3, bh & 7, tq, valid, slot, j * MBLK, 8, tmin, lane);
        } else {
            const int o = task - nsel, qg = o & 7, i = (o >> 3) & 15, bh = o >> 7; const int t0 = i * MBLK + 32 * qg;
            moba_task<true>(Q, Kk, Vt, PO, PML, tab, wl, bh >> 3, bh & 7, t0 + (lane & 31), true, 3, i * MBLK, qg + 1, t0, lane);
        }
    }
    __syncthreads();
}
__device__ __forceinline__ void moba_combine(const Frame& F) {
    const bf16_t* PO = (const bf16_t*)(F.ws + RB_PARTO); const float* PML = (const float*)(F.ws + RB_PARTML); bf16_t* Y = (bf16_t*)(F.ws + RB_YCAT);
    const int lane = F.lane, h = lane >> 3, dc = lane & 7;
    for (int tok = F.gw; tok < NTOK; tok += F.GW) {
        const int i = (tok & 4095) >> 8, nsel = i < 3 ? i : 3; const size_t pb = ((size_t)tok * 8 + h) * 4;
        float mm[4], ll[4]; float M = -3.0e38f;
#pragma unroll
        for (int s = 0; s < 4; ++s) { const bool v = (s == 3) || (s < nsel); if (v) { const f32x2 ml = *(const f32x2*)(PML + (pb + s) * 2); mm[s] = ml.x; ll[s] = ml.y; M = fmaxf(M, ml.x); } else { mm[s] = -3.0e38f; ll[s] = 0.f; } }
        float acc[8], den = 0.f;
#pragma unroll
        for (int j = 0; j < 8; ++j) acc[j] = 0.f;
#pragma unroll
        for (int s = 0; s < 4; ++s) { const bool v = (s == 3) || (s < nsel); if (v) { const float w = ll[s] * ex2(mm[s] - M); den += w; const u32x4 o = *(const u32x4*)(PO + (pb + s) * 64 + dc * 8);
            acc[0] += w * bf_lo(o.x); acc[1] += w * bf_hi(o.x); acc[2] += w * bf_lo(o.y); acc[3] += w * bf_hi(o.y); acc[4] += w * bf_lo(o.z); acc[5] += w * bf_hi(o.z); acc[6] += w * bf_lo(o.w); acc[7] += w * bf_hi(o.w); } }
        const float inv = 1.0f / den;
        u32x4 w; w.x = cvt_pk_bf16(acc[0] * inv, acc[1] * inv); w.y = cvt_pk_bf16(acc[2] * inv, acc[3] * inv); w.z = cvt_pk_bf16(acc[4] * inv, acc[5] * inv); w.w = cvt_pk_bf16(acc[6] * inv, acc[7] * inv);
        *(u32x4*)(Y + (size_t)tok * 1024 + 512 + h * 64 + dc * 8) = w;
    }
}

__device__ __forceinline__ void sb_attn(const Frame& F) {
    const bf16_t* Q = (const bf16_t*)(F.ws + RA_Q1); const bf16_t* Kk = (const bf16_t*)(F.ws + RA_K1); const bf16_t* Vt = (const bf16_t*)(F.ws + RA_VT1); bf16_t* Y = (bf16_t*)(F.ws + RB_Y1);
    const int lane = F.lane, r = lane & 31, hf = lane >> 5;
    LAS unsigned char* wl = F.lds + F.wave * 4096;
    bf16x8 tri[2];
#pragma unroll
    for (int s = 0; s < 2; ++s)
#pragma unroll
        for (int j = 0; j < 8; ++j) { const int kap = 16 * s + 8 * (j >> 2) + 4 * hf + (j & 3); tri[s][j] = (kap >= r) ? (short)0x3F80 : (short)0; }
    const int ntask = NBATCH * 16 * (SEQ / 32);
    for (int task = F.gw; task < ntask; task += F.GW) {
        const int qt = task & 127, head = (task >> 7) & 15, b = task >> 11; const int t0 = qt * 32; const size_t tokb = (size_t)b * SEQ;
        bf16x8 qf[4];
        { const bf16_t* qp = Q + qk_tile_off(b, head, t0, 16) + hf * 256 + r * 8;
#pragma unroll
          for (int s = 0; s < 4; ++s) qf[s] = *(const bf16x8*)(qp + 512 * s); }
        f32x16 o0, o1;
#pragma unroll
        for (int i = 0; i < 16; ++i) { o0[i] = 0.f; o1[i] = 0.f; }
        float carry = 0.f;
        const bf16_t* kbase = Kk + qk_tile_off(b, head, 0, 16) + hf * 256 + r * 8;
        const bf16_t* vbase = Vt + v_tile_off(b, head, 0, 16) + hf * 256 + r * 8;
        KFrag k0 = load_kfrag(kbase + (size_t)qt * 2048);
        VFrag v0 = load_vfrag(vbase + (size_t)qt * 2048);
        for (int key0 = t0; key0 >= 0; key0 -= 32) {
            const bool diag = (key0 == t0);
            const int kp1 = key0 >= 32 ? key0 - 32 : 0;
            const KFrag k1 = load_kfrag(kbase + (size_t)(kp1 >> 5) * 2048);
            const VFrag v1 = load_vfrag(vbase + (size_t)(kp1 >> 5) * 2048);
            f32x16 x;
#pragma unroll
            for (int i = 0; i < 16; ++i) x[i] = 0.f;
#pragma unroll
            for (int s = 0; s < 4; ++s) x = mfma32(k0.f[s], qf[s], x);
            float sp[16];
#pragma unroll
            for (int i = 0; i < 16; ++i) { const int row = (i & 3) + 8 * (i >> 2) + 4 * hf; const float zl = x[i];
                float v = fmaxf(zl, 0.f) + lg2(1.0f + ex2(-fabsf(zl))); if (diag && row >= r) v = 0.f; sp[i] = v; }
            unsigned hw[8], lw[8];
#pragma unroll
            for (int i = 0; i < 8; ++i) { hw[i] = cvt_pk_bf16(sp[2 * i], sp[2 * i + 1]); lw[i] = cvt_pk_bf16(sp[2 * i] - bf_lo(hw[i]), sp[2 * i + 1] - bf_hi(hw[i])); }
            f32x16 y;
#pragma unroll
            for (int i = 0; i < 16; ++i) y[i] = 0.f;
#pragma unroll
            for (int s = 0; s < 2; ++s) { u32x4 a, c; a.x = hw[4 * s]; a.y = hw[4 * s + 1]; a.z = hw[4 * s + 2]; a.w = hw[4 * s + 3]; c.x = lw[4 * s]; c.y = lw[4 * s + 1]; c.z = lw[4 * s + 2]; c.w = lw[4 * s + 3];
                y = mfma32(tri[s], __builtin_bit_cast(bf16x8, a), y); y = mfma32(tri[s], __builtin_bit_cast(bf16x8, c), y); }
            unsigned pw[8];
#pragma unroll
            for (int i = 0; i < 8; ++i) { const int i0 = 2 * i, i1 = 2 * i + 1; const int row0 = (i0 & 3) + 8 * (i0 >> 2) + 4 * hf, row1 = (i1 & 3) + 8 * (i1 >> 2) + 4 * hf;
                float w0 = ex2(x[i0] - y[i0] - carry), w1 = ex2(x[i1] - y[i1] - carry); if (diag && row0 >= r) w0 = 0.f; if (diag && row1 >= r) w1 = 0.f; pw[i] = cvt_pk_bf16(w0, w1); }
#pragma unroll
            for (int s = 0; s < 2; ++s) { u32x4 pf; pf.x = pw[4 * s]; pf.y = pw[4 * s + 1]; pf.z = pw[4 * s + 2]; pf.w = pw[4 * s + 3];
                const bf16x8 pb = __builtin_bit_cast(bf16x8, pf);
                o0 = mfma32(v0.f[0][s], pb, o0); o1 = mfma32(v0.f[1][s], pb, o1); }
            carry += __shfl(y[0], r);
            if (__all(carry >= SB_THR)) break;
            k0 = k1; v0 = v1;
        }
        stage_o_rows(wl, o0, o1, 1.0f, r, hf);
#pragma unroll
        for (int it = 0; it < 4; ++it) { const int q = it * 8 + (lane >> 3), c = lane & 7; *(u32x4*)(Y + (tokb + t0 + q) * 1024 + head * 64 + c * 8) = read_o_row(wl, q, c); }
        __builtin_amdgcn_fence(__ATOMIC_RELEASE, "wavefront"); __builtin_amdgcn_wave_barrier(); __builtin_amdgcn_fence(__ATOMIC_ACQUIRE, "wavefront");
    }
}

__device__ __forceinline__ void moe_router(const Frame& F, const Args& a, int layer, const bf16_t* __restrict__ r) {
    unsigned char* H8 = (unsigned char*)(F.ws + WS_H); int* MLIST = (int*)(F.ws + WS_MLIST); int* TOKEP = (int*)(F.ws + WS_TOKEP); float* TOKG = (float*)(F.ws + WS_TOKG); unsigned* GCNT = F.ctl + CW_GCNT + layer * 64;
    const float* rw = a.in[I_RW] + (size_t)layer * 1024 * 32; const float* rb = a.in[I_RB] + layer * 32; const float* gain = a.in[I_NFFN] + layer * 1024;
    LAS float* hs = (LAS float*)F.lds;
    LAS float* part = (LAS float*)(F.lds + 32768);
    LAS float* logit = (LAS float*)(F.lds + 49152);
    LAS int* lcnt = (LAS int*)(F.lds + 50176);
    LAS int* tinfo = (LAS int*)(F.lds + 50432);
    const int t = F.tid, lane = F.lane, wave = F.wave, e = t & 31, ks = t >> 5;
    const int per = (NTOK + F.G - 1) / F.G, tok0 = F.bid * per, tok1 = min(NTOK, tok0 + per);
    float rwr[64];
#pragma unroll
    for (int i = 0; i < 64; ++i) rwr[i] = rw[(size_t)(ks * 64 + i) * 32 + e];
    f32x4 gv[4];
#pragma unroll
    for (int j = 0; j < 4; ++j) gv[j] = *(const f32x4*)(gain + 4 * (lane + 64 * j));
    __syncthreads();
    if (t < 64) lcnt[t] = 0;
    for (int base = tok0; base < tok1; base += 8) {
        const int tok = base + wave;
        if (tok < tok1) { const bf16_t* s = r + (size_t)tok * 1024; f32x4 v[4]; float ss = 0.f;
#pragma unroll
            for (int j = 0; j < 4; ++j) { const u32x2 w = *(const u32x2*)(s + 4 * (lane + 64 * j)); v[j] = (f32x4){bf_lo(w.x), bf_hi(w.x), bf_lo(w.y), bf_hi(w.y)}; ss += v[j][0] * v[j][0] + v[j][1] * v[j][1] + v[j][2] * v[j][2] + v[j][3] * v[j][3]; }
            ss = wave_sum(ss); const float rstd = rsqrtf(ss * (1.0f / 1024.0f) + RMS_EPS);
#pragma unroll
            for (int j = 0; j < 4; ++j) { const f32x4 y = v[j] * rstd * gv[j]; *(LAS f32x4*)(hs + wave * 1024 + 4 * (lane + 64 * j)) = y;
                *(unsigned*)(H8 + (size_t)tok * 1024 + 4 * (lane + 64 * j)) = cvt_pk4_fp8(y[0], y[1], y[2], y[3]); } }
        __syncthreads();
#pragma unroll
        for (int tk = 0; tk < 8; ++tk) { float acc = 0.f;
#pragma unroll
            for (int i4 = 0; i4 < 16; ++i4) { const f32x4 hv = *(const LAS f32x4*)(hs + tk * 1024 + ks * 64 + 4 * i4); acc += hv[0] * rwr[4 * i4] + hv[1] * rwr[4 * i4 + 1] + hv[2] * rwr[4 * i4 + 2] + hv[3] * rwr[4 * i4 + 3]; }
            part[(tk * 16 + ks) * 32 + e] = acc; }
        __syncthreads();
        if (t < 256) { const int tk = t >> 5; float s = rb[e];
#pragma unroll
            for (int k = 0; k < 16; ++k) s += part[(tk * 16 + k) * 32 + e];
            logit[tk * 32 + e] = s; }
        __syncthreads();
        if (t < 8 && base + t < tok1) { const int tk = t, tokk = base + t; float v0 = -3.0e38f, v1 = -3.0e38f, v2 = -3.0e38f, v3 = -3.0e38f; int i0 = 0, i1 = 0, i2 = 0, i3 = 0;
            for (int j = 0; j < 32; ++j) { const float g = logit[tk * 32 + j];
                if (g > v0) { v3 = v2; i3 = i2; v2 = v1; i2 = i1; v1 = v0; i1 = i0; v0 = g; i0 = j; } else if (g > v1) { v3 = v2; i3 = i2; v2 = v1; i2 = i1; v1 = g; i1 = j; }
                else if (g > v2) { v3 = v2; i3 = i2; v2 = g; i2 = j; } else if (g > v3) { v3 = g; i3 = j; } }
            const float e1 = __expf(v1 - v0), e2 = __expf(v2 - v0), e3 = __expf(v3 - v0), inv = 1.0f / (1.0f + e1 + e2 + e3);
            f32x4 gg; gg[0] = inv; gg[1] = e1 * inv; gg[2] = e2 * inv; gg[3] = e3 * inv; *(f32x4*)(TOKG + (size_t)tokk * 4) = gg;
            const int lt = tokk - tok0;
            tinfo[lt * 4 + 0] = (i0 << 20) | atomicAdd((int*)&lcnt[i0], 1); tinfo[lt * 4 + 1] = (i1 << 20) | atomicAdd((int*)&lcnt[i1], 1);
            tinfo[lt * 4 + 2] = (i2 << 20) | atomicAdd((int*)&lcnt[i2], 1); tinfo[lt * 4 + 3] = (i3 << 20) | atomicAdd((int*)&lcnt[i3], 1); }
    }
    __syncthreads();
    if (t < 32) lcnt[32 + t] = (int)__hip_atomic_fetch_add(GCNT + t, (unsigned)lcnt[t], __ATOMIC_RELAXED, __HIP_MEMORY_SCOPE_AGENT);
    __syncthreads();
    for (int x = t; x < (tok1 - tok0) * 4; x += 512) { const int v = tinfo[x], ee = v >> 20, pos = lcnt[32 + ee] + (v & 0xfffff), tokk = tok0 + (x >> 2);
        MLIST[(size_t)ee * NTOK + pos] = tokk; TOKEP[(size_t)tokk * 4 + (x & 3)] = (ee << 20) | pos; }
    __syncthreads();
}

struct MoeTab { LAS int* cnt; LAS int* tb; LAS int* rte; int NT; };
__device__ __forceinline__ MoeTab moe_tables(const Frame& F, int layer) {
    MoeTab T; T.cnt = (LAS int*)(F.lds + LDS_AUX + 18432); T.tb = T.cnt + 32; T.rte = T.tb + 40;
    unsigned* GCNT = F.ctl + CW_GCNT + layer * 64; const int t = F.tid;
    __syncthreads();
    if (t < 32) T.cnt[t] = (int)__hip_atomic_load(GCNT + t, __ATOMIC_RELAXED, __HIP_MEMORY_SCOPE_AGENT);
    __syncthreads();
    if (t == 0) { int s = 0; for (int e = 0; e < 32; ++e) { T.tb[e] = s; s += (T.cnt[e] + 255) >> 8; } T.tb[32] = s; }
    __syncthreads();
    T.NT = T.tb[32];
    for (int x = t; x < T.NT; x += 512) { int e = 0; for (int k = 1; k < 32; ++k) if (T.tb[k] <= x) e = k; T.rte[x] = e; }
    __syncthreads();
    return T;
}
__device__ __forceinline__ bool moe_unit(int i, int G, int c, int NT, int NPN, int& rt, int& pn) {
    const long L = (long)i * G + c;
    if ((G & 7) == 0) { const int xcd = (int)(L & 7); const long idx = L >> 3; rt = (int)(idx / NPN) * 8 + xcd; pn = (int)(idx % NPN); }
    else { rt = (int)(L / NPN); pn = (int)(L % NPN); }
    return rt < NT;
}
struct MoeUpSched {
    static constexpr bool GATHER = true;
    MoeTab T; const char* H; const char* Wg; const char* Wu; LAS int* rowtab; int G, c;
    __device__ __forceinline__ bool next(int i, GU& u) const {
        int rt, pn; if (!moe_unit(i, G, c, T.NT, 8, rt, pn)) return false;
        const int e = T.rte[rt];
        u.a0 = H; u.a1 = H; u.b0 = Wg + ((size_t)e * 1024 + pn * 128) * 1024; u.b1 = Wu + ((size_t)e * 1024 + pn * 128) * 1024;
        u.p0 = rt * 256; u.p1 = pn * 128; u.p2 = e; u.p3 = 0; return true;
    }
    __device__ __forceinline__ const LAS int* rows(int i) const { return rowtab + i * 256; }
};
struct MoeDownSched {
    static constexpr bool GATHER = false;
    MoeTab T; const char* A; const char* Wd; int G, c;
    __device__ __forceinline__ bool next(int i, GU& u) const {
        int rt, pn; if (!moe_unit(i, G, c, T.NT, 4, rt, pn)) return false;
        const int e = T.rte[rt];
        u.a0 = A + (size_t)rt * 256 * 1024; u.a1 = u.a0 + (size_t)128 * 1024; u.b0 = Wd + ((size_t)e * 1024 + pn * 256) * 1024; u.b1 = u.b0 + (size_t)128 * 1024;
        u.p0 = rt * 256; u.p1 = pn * 256; u.p2 = e; u.p3 = 0; return true;
    }
    __device__ __forceinline__ const LAS int* rows(int) const { return nullptr; }
};
__device__ __forceinline__ void moe_up(const Frame& F, const Args& a, int layer) {
    const MoeTab T = moe_tables(F, layer); const int* MLIST = (const int*)(F.ws + WS_MLIST);
    LAS int* rowtab = (LAS int*)(F.lds + LDS_AUX);
    for (int i = 0; i < 18; ++i) { int rt, pn; if (!moe_unit(i, F.G, F.bid, T.NT, 8, rt, pn)) break;
        const int e = T.rte[rt], tile = rt - T.tb[e], cnt = T.cnt[e];
        if (F.tid < 256) { const int pos = tile * 256 + F.tid; rowtab[i * 256 + F.tid] = pos < cnt ? MLIST[(size_t)e * NTOK + pos] : 0; } }
    __syncthreads();
    const char* W = (const char*)(F.ws + WS_MOEW); const size_t L = (size_t)NEXP * 1024 * 1024;
    MoeUpSched S{T, (const char*)(F.ws + WS_H), W, W + L, rowtab, F.G, F.bid};
    EpiSwiglu E{a.in[I_BG] + (size_t)layer * NEXP * 1024, a.in[I_BU] + (size_t)layer * NEXP * 1024, (unsigned char*)(F.ws + RA_ACT)};
    g8::gemm_run<EpiSwiglu, MoeUpSched, true>(F.lds, 512, 1024u, 1024u, S, E);
}
__device__ __forceinline__ void moe_down(const Frame& F, const Args& a, int layer) {
    const MoeTab T = moe_tables(F, layer);
    const char* W = (const char*)(F.ws + WS_MOEW); const size_t L = (size_t)NEXP * 1024 * 1024;
    MoeDownSched S{T, (const char*)(F.ws + RA_ACT), W + 2 * L, F.G, F.bid};
    EpiDown E{a.in[I_BD] + (size_t)layer * NEXP * 1024, (bf16_t*)(F.ws + RB_YS)};
    g8::gemm_run<EpiDown, MoeDownSched, true>(F.lds, 512, 1024u, 1024u, S, E);
}
__device__ __forceinline__ void moe_combine(const Frame& F, const Args& a, int layer, bf16_t* __restrict__ r) {
    const MoeTab T = moe_tables(F, layer);
    const bf16_t* YS = (const bf16_t*)(F.ws + RB_YS); const int* TOKEP = (const int*)(F.ws + WS_TOKEP); const float* TOKG = (const float*)(F.ws + WS_TOKG); unsigned char* H = (unsigned char*)(F.ws + WS_H);
    const float* gain = a.in[I_NPLE] + layer * 1024; const int lane = F.lane;
    f32x4 gv[2][2];
#pragma unroll
    for (int c = 0; c < 2; ++c) { gv[c][0] = *(const f32x4*)(gain + c * 512 + lane * 8); gv[c][1] = *(const f32x4*)(gain + c * 512 + lane * 8 + 4); }
    for (int tok = F.gw; tok < NTOK; tok += F.GW) {
        int slot[4]; float gt[4];
#pragma unroll
        for (int k = 0; k < 4; ++k) { const int v = TOKEP[(size_t)tok * 4 + k]; slot[k] = T.tb[v >> 20] * 256 + (v & 0xfffff); gt[k] = TOKG[(size_t)tok * 4 + k]; }
        f32x4 v[2][2]; float ss = 0.f;
#pragma unroll
        for (int c = 0; c < 2; ++c) { const size_t o = (size_t)tok * 1024 + c * 512 + lane * 8; { const u32x4 rr = *(const u32x4*)(r + o); v[c][0] = (f32x4){bf_lo(rr.x), bf_hi(rr.x), bf_lo(rr.y), bf_hi(rr.y)}; v[c][1] = (f32x4){bf_lo(rr.z), bf_hi(rr.z), bf_lo(rr.w), bf_hi(rr.w)}; }
#pragma unroll
            for (int k = 0; k < 4; ++k) { const u32x4 y = *(const u32x4*)(YS + (size_t)slot[k] * 1024 + c * 512 + lane * 8);
                v[c][0][0] += gt[k] * bf_lo(y.x); v[c][0][1] += gt[k] * bf_hi(y.x); v[c][0][2] += gt[k] * bf_lo(y.y); v[c][0][3] += gt[k] * bf_hi(y.y);
                v[c][1][0] += gt[k] * bf_lo(y.z); v[c][1][1] += gt[k] * bf_hi(y.z); v[c][1][2] += gt[k] * bf_lo(y.w); v[c][1][3] += gt[k] * bf_hi(y.w); }
            { u32x4 w; w.x = cvt_pk_bf16(v[c][0][0], v[c][0][1]); w.y = cvt_pk_bf16(v[c][0][2], v[c][0][3]); w.z = cvt_pk_bf16(v[c][1][0], v[c][1][1]); w.w = cvt_pk_bf16(v[c][1][2], v[c][1][3]); *(u32x4*)(r + o) = w; }
#pragma unroll
            for (int q = 0; q < 2; ++q) ss += v[c][q][0] * v[c][q][0] + v[c][q][1] * v[c][q][1] + v[c][q][2] * v[c][q][2] + v[c][q][3] * v[c][q][3]; }
        ss = wave_sum(ss); const float rstd = rsqrtf(ss * (1.0f / 1024.0f) + RMS_EPS);
#pragma unroll
        for (int c = 0; c < 2; ++c) { const f32x4 y0 = v[c][0] * rstd * gv[c][0], y1 = v[c][1] * rstd * gv[c][1];
            u32x2 w; w.x = cvt_pk4_fp8(y0[0], y0[1], y0[2], y0[3]); w.y = cvt_pk4_fp8(y1[0], y1[1], y1[2], y1[3]);
            *(u32x2*)(H + (size_t)tok * 1024 + c * 512 + lane * 8) = w; }
    }
}

constexpr int N_PHASES = 22;
#ifndef DBG_DUP_MASK
#define DBG_DUP_MASK 0
#endif
#ifndef DBG_NPH
#define DBG_NPH 22
#endif
#ifndef MK_ONE_LAUNCH
#define MK_ONE_LAUNCH 1
#endif

__device__ __forceinline__ void moe_ple_phases(const Frame& F, const Args& a, int layer, int ph, bf16_t* out) {
    if (ph == 0) moe_router(F, a, layer, out);
    else if (ph == 1) moe_up(F, a, layer);
    else if (ph == 2) moe_down(F, a, layer);
    else if (ph == 3) {
        g8::DenseSched S{(const char*)(F.ws + WS_PB) + (size_t)layer * NTOK * PLE * 2, (const char*)(F.ws + WS_WPLE) + (size_t)layer * 1024 * PLE * 2, 512u, 512u, 128, 4, F.G, F.bid};
        EpiStoreBf16 E{(bf16_t*)(F.ws + RA_PROJ), 1024, 1.0f};
        g8::gemm_run<EpiStoreBf16, g8::DenseSched>(F.lds, 256, 512u, 512u, S, E);
        moe_combine(F, a, layer, out);
    } else {
        g8::DenseSched S{(const char*)(F.ws + WS_H), (const char*)(F.ws + WS_WPLEG) + (size_t)layer * 1024 * 1024, 1024u, 1024u, 128, 4, F.G, F.bid};
        EpiPle E{(const bf16_t*)(F.ws + RA_PROJ), out};
        g8::gemm_run<EpiPle, g8::DenseSched, true>(F.lds, 512, 1024u, 1024u, S, E);
    }
}

__global__ void __launch_bounds__(512, 2) fwd(Args a) {
    extern __shared__ __attribute__((aligned(16))) unsigned char lds_raw[];
    Frame F;
    F.lds = (LAS unsigned char*)lds_raw; F.tid = threadIdx.x; F.lane = F.tid & 63; F.wave = __builtin_amdgcn_readfirstlane(F.tid >> 6);
    F.G = gridDim.x; F.bid = blockIdx.x; F.gw = F.bid * 8 + F.wave; F.GW = F.G * 8; F.ws = a.ws; F.ctl = (unsigned*)(a.ws + WS_CTL);
    volatile LAS unsigned* misc = (volatile LAS unsigned*)(F.lds + LDS_MISC);
    if (F.tid < 16) misc[F.tid] = 0u;
    __syncthreads();
    XcdBarrier bar; bar.bar = F.ctl + CW_BAR; bar.x = 0; bar.st = misc;
    const int lo = a.ph_lo, hi = a.ph_hi;
    if (hi - lo > 1) bar = xcd_barrier_post(F.ctl + CW_BAR, misc);
#define IN(k) (lo <= (k) && (k) < hi)
#define SEAM(k) do { if (IN(k) && IN((k) + 1)) xcd_barrier(bar); } while (0)
    bf16_t* r16 = (bf16_t*)(F.ws + WS_R16);

    if (IN(0)) { p0_prologue(F, a); } SEAM(0);
    if (IN(1)) {
        { g8::DenseSched S{(const char*)(F.ws + WS_H), (const char*)(F.ws + WS_WINAB), 2048u, 2048u, 128, 6, F.G, F.bid};
          EpiInAB E{(bf16_t*)(F.ws + RA_A2), (bf16_t*)(F.ws + RA_Q0), (bf16_t*)(F.ws + RA_K0)};
          g8::gemm_run<EpiInAB, g8::DenseSched>(F.lds, 1024, 2048u, 2048u, S, E); }
        { g8::DenseSched S{(const char*)(F.ws + WS_WINAB) + (size_t)1536 * 2048, (const char*)(F.ws + WS_H), 2048u, 2048u, 2, 128, F.G, F.bid};
          EpiVt E{(bf16_t*)(F.ws + RA_VT0), 8};
          g8::gemm_run<EpiVt, g8::DenseSched>(F.lds, 1024, 2048u, 2048u, S, E); }
    } SEAM(1);
    if (IN(2)) {
        { g8::BatchSched S{(const char*)(F.ws + RA_A2), (const char*)(F.ws + WS_WBT), 1280u, 1024u, (size_t)1024 * 1280, (size_t)256 * 1024, 4, 1, NGRP, F.G, F.bid};
          EpiS E{(float*)(F.ws + RA_SS)};
          g8::gemm_run<EpiS, g8::BatchSched>(F.lds, 512, 1280u, 1024u, S, E); }
        moba_kmean(F);
    } SEAM(2);
    if (IN(3)) { s5_scan(F, a); moba_gate(F); } SEAM(3);
    if (IN(4)) {
        { g8::BatchSched S{(const char*)(F.ws + RA_A2), (const char*)(F.ws + WS_MY), 1280u, 1280u, (size_t)1024 * 1280, (size_t)512 * 1280, 4, 2, NGRP, F.G, F.bid};
          EpiY E{(bf16_t*)(F.ws + RA_Z)};
          g8::gemm_run<EpiY, g8::BatchSched>(F.lds, 640, 1280u, 1280u, S, E); }
        moba_attn(F, a);
    } SEAM(4);
    if (IN(5)) {
        { g8::DenseSched S{(const char*)(F.ws + RA_Z), (const char*)(F.ws + WS_GLU), 1024u, 1024u, 128, 2, F.G, F.bid};
          EpiGlu E{(const bf16_t*)(F.ws + RA_Z), a.in[I_GLUB], (bf16_t*)(F.ws + RB_YCAT)};
          g8::gemm_run<EpiGlu, g8::DenseSched>(F.lds, 512, 1024u, 1024u, S, E); }
        moba_combine(F);
    } SEAM(5);
    if (IN(6)) {
        g8::DenseSched S{(const char*)(F.ws + RB_YCAT), (const char*)(F.ws + WS_WOUTAB), 2048u, 2048u, 128, 4, F.G, F.bid};
        EpiRes<true> E{a.in[I_X], r16};
        g8::gemm_run<EpiRes<true>, g8::DenseSched>(F.lds, 1024, 2048u, 2048u, S, E);
    } SEAM(6);
    if (IN(7)) moe_ple_phases(F, a, 0, 0, r16); SEAM(7);
    if (IN(8)) moe_ple_phases(F, a, 0, 1, r16); SEAM(8);
    if (IN(9)) moe_ple_phases(F, a, 0, 2, r16); SEAM(9);
    if (IN(10)) moe_ple_phases(F, a, 0, 3, r16); SEAM(10);
    if (IN(11)) moe_ple_phases(F, a, 0, 4, r16); SEAM(11);
    if (IN(12)) { rmsnorm_rows<0, true>(F, r16, a.in[I_NMIX] + 1024, (bf16_t*)(F.ws + WS_H), nullptr, NTOK); conv_moe_weights(F, a, 1); } SEAM(12);
    if (IN(13)) {
        { g8::DenseSched S{(const char*)(F.ws + WS_H), (const char*)(F.ws + WS_WINC), 2048u, 2048u, 128, 8, F.G, F.bid};
          EpiInC E{(bf16_t*)(F.ws + RA_Q1), (bf16_t*)(F.ws + RA_K1)};
          g8::gemm_run<EpiInC, g8::DenseSched>(F.lds, 1024, 2048u, 2048u, S, E); }
        { g8::DenseSched S{(const char*)(F.ws + WS_WINC) + (size_t)2048 * 2048, (const char*)(F.ws + WS_H), 2048u, 2048u, 4, 128, F.G, F.bid};
          EpiVt E{(bf16_t*)(F.ws + RA_VT1), 16};
          g8::gemm_run<EpiVt, g8::DenseSched>(F.lds, 1024, 2048u, 2048u, S, E); }
    } SEAM(13);
    if (IN(14)) sb_attn(F); SEAM(14);
    if (IN(15)) {
        g8::DenseSched S{(const char*)(F.ws + RB_Y1), (const char*)(F.ws + WS_WOUTC), 2048u, 2048u, 128, 4, F.G, F.bid};
        EpiRes<false> E{r16, r16};
        g8::gemm_run<EpiRes<false>, g8::DenseSched>(F.lds, 1024, 2048u, 2048u, S, E);
    } SEAM(15);
    if (IN(16)) moe_ple_phases(F, a, 1, 0, r16); SEAM(16);
    if (IN(17)) moe_ple_phases(F, a, 1, 1, r16); SEAM(17);
    if (IN(18)) moe_ple_phases(F, a, 1, 2, r16); SEAM(18);
    if (IN(19)) moe_ple_phases(F, a, 1, 3, r16); SEAM(19);
    if (IN(20)) moe_ple_phases(F, a, 1, 4, r16); SEAM(20);
    if (IN(21)) rmsnorm_rows<1, true>(F, r16, a.in[I_NFINAL], nullptr, a.out, NTOK);
#undef IN
#undef SEAM
}

extern "C" void kernel_launch(void* const* d_in, const int* in_sizes, int n_in, void* d_out, int out_size, void* d_ws, size_t ws_size, hipStream_t stream) {
    static int grid = 0;
    if (grid == 0) {
        if (n_in != 31 || out_size != NTOK * DM || ws_size < WS_END) { fprintf(stderr, "kernel_launch: unexpected shapes (n_in %d, out %d, ws %zu < %zu)\n", n_in, out_size, ws_size, (size_t)WS_END); grid = -1; return; }
        int dev = 0, cus = 0, per_cu = 0;
        if (hipGetDevice(&dev) != hipSuccess || hipDeviceGetAttribute(&cus, hipDeviceAttributeMultiprocessorCount, dev) != hipSuccess) { grid = -1; return; }
        if (hipFuncSetAttribute((const void*)fwd, hipFuncAttributeMaxDynamicSharedMemorySize, LDS_BYTES) != hipSuccess) { fprintf(stderr, "kernel_launch: hipFuncSetAttribute failed\n"); grid = -1; return; }
        if (hipOccupancyMaxActiveBlocksPerMultiprocessor(&per_cu, (const void*)fwd, 512, LDS_BYTES) != hipSuccess || per_cu < 1) fprintf(stderr, "kernel_launch: occupancy query says %d\n", per_cu);
        (void)hipGetLastError();
        grid = cus;
        if (grid != 256) fprintf(stderr, "kernel_launch: %d CUs (built for 256)\n", grid);
    }
    if (grid < 0) return;
    (void)hipMemsetAsync((char*)d_ws + WS_CTL, 0, 1 * MiB, stream);
    Args a{};
    for (int i = 0; i < 31; ++i) a.in[i] = (const float*)d_in[i];
    a.out = (float*)d_out; a.ws = (unsigned char*)d_ws;
    for (int n = 0; n < 128; ++n) { int bk; if (n < 16) bk = n; else { bk = 16 + (int)(std::log((double)n / 16.0) / std::log(8.0) * 16.0); if (bk > 31) bk = 31; } a.btab[n] = (unsigned char)bk; }
#if MK_ONE_LAUNCH
    a.ph_lo = 0; a.ph_hi = N_PHASES;
    hipLaunchKernelGGL(fwd, dim3(grid), dim3(512), LDS_BYTES, stream, a);
#else
    for (int p = 0; p < DBG_NPH; ++p) { a.ph_lo = p; a.ph_hi = p + 1; const int reps = ((DBG_DUP_MASK >> p) & 1) ? 2 : 1; for (int q = 0; q < reps; ++q) hipLaunchKernelGGL(fwd, dim3(grid), dim3(512), LDS_BYTES, stream, a); }
#endif
}
```
